# Optimizing an MI355X kernel written in HIP

```python
import jax, jax.numpy as jnp
from jax import lax
import numpy as np

D_MODEL = 1024
BATCH = 4
SEQ = 4096
DEPTH = 2

MLA_HEADS = 8
QK_NOPE = 64
QK_ROPE = 32
V_HEAD = 64
Q_RANK = 256
KV_RANK = 128
ROPE_THETA = 10000.0
Q_BLOCK = 128
MLA_OUT = MLA_HEADS * V_HEAD
FNET_GROUPS = 8
FNET_GROUP_DIM = 64
FNET_WIDTH = FNET_GROUPS * FNET_GROUP_DIM
PROJ_A = Q_RANK + KV_RANK + QK_ROPE + FNET_WIDTH
D_MIX_A = MLA_OUT + FNET_WIDTH
CONV_WIDTH = 3
D_CONV = D_MODEL
N_EXPERTS = 32
TOP_K = 4
D_EXPERT = D_MODEL
SWIGLU_LIMIT = 7.0
SWIGLU_ALPHA = 1.702
MOE_BLOCK = 128
DEEPNORM_ALPHA = (2 * DEPTH) ** 0.25
DEEPNORM_BETA = (8 * DEPTH) ** -0.25
N_EVEN = (DEPTH + 1) // 2
N_ODD = DEPTH // 2
LN_EPS = 1e-5
MOD_EPS = 1e-6
RMS_EPS = 1e-6

kernel_name = "hybrid_mla_fnet_shortconv_moe_deepnorm_adaln"


def layer_norm(x, g=None, b=None, eps=LN_EPS):
    xf = x.astype(jnp.float32)
    mu = jnp.mean(xf, axis=-1, keepdims=True)
    var = jnp.mean(jnp.square(xf - mu), axis=-1, keepdims=True)
    y = (xf - mu) * lax.rsqrt(var + eps)
    if g is not None:
        y = y * g.astype(jnp.float32) + b.astype(jnp.float32)
    return y.astype(x.dtype)


def rms_norm(x, g, eps=RMS_EPS):
    xf = x.astype(jnp.float32)
    y = xf * lax.rsqrt(jnp.mean(jnp.square(xf), axis=-1, keepdims=True) + eps)
    return (y * g.astype(jnp.float32)).astype(x.dtype)


def rope_tables(positions, dtype):
    inv_freq = ROPE_THETA ** (-jnp.arange(0, QK_ROPE, 2, dtype=jnp.float32) / QK_ROPE)
    ang = positions.astype(jnp.float32)[..., None] * inv_freq
    return jnp.cos(ang).astype(dtype), jnp.sin(ang).astype(dtype)


def apply_rope(t, cos, sin):
    t1, t2 = jnp.split(t, 2, axis=-1)
    return jnp.concatenate([t1 * cos - t2 * sin, t2 * cos + t1 * sin], axis=-1)


def mla_attention(c_q, c_kv, k_r, cos, sin, q_norm_g, kv_norm_g, w_uq, w_uk, w_uv):
    B, S = c_q.shape[:2]
    q = (rms_norm(c_q, q_norm_g) @ w_uq).reshape(B, S, MLA_HEADS, QK_NOPE + QK_ROPE)
    scale = (QK_NOPE + QK_ROPE) ** -0.5
    q_nope = q[..., :QK_NOPE] * scale
    q_pe = apply_rope(q[..., QK_NOPE:], cos[:, :, None, :], sin[:, :, None, :]) * scale
    ckv = rms_norm(c_kv, kv_norm_g)
    k_nope = (ckv @ w_uk).reshape(B, S, MLA_HEADS, QK_NOPE)
    v = (ckv @ w_uv).reshape(B, S, MLA_HEADS, V_HEAD)
    k_pe = apply_rope(k_r, cos, sin)
    nb = S // Q_BLOCK

    def to_blocks(t):
        return jnp.swapaxes(t.reshape((B, nb, Q_BLOCK) + t.shape[2:]), 0, 1)

    def attend(blk):
        qn, qp = blk
        s = (jnp.einsum('bqhd,bkhd->bhqk', qn, k_nope)
             + jnp.einsum('bqhr,bkr->bhqk', qp, k_pe))
        p = jax.nn.softmax(s.astype(jnp.float32), axis=-1).astype(v.dtype)
        return jnp.einsum('bhqk,bkhd->bqhd', p, v)

    o = lax.map(attend, (to_blocks(q_nope), to_blocks(q_pe)))
    return jnp.swapaxes(o, 0, 1).reshape(B, S, MLA_OUT)


def fnet_mix(u):
    B, S = u.shape[:2]
    ug = u.reshape(B, S, FNET_GROUPS, FNET_GROUP_DIM).astype(jnp.float32)
    f = jnp.real(jnp.fft.fft2(ug, axes=(1, 3), norm='ortho'))
    return f.reshape(B, S, FNET_WIDTH).astype(u.dtype)


def short_conv(u, w):
    S = u.shape[1]
    half = CONV_WIDTH // 2
    up = jnp.pad(u, ((0, 0), (half, CONV_WIDTH - 1 - half), (0, 0)))
    return sum(up[:, j:j + S] * w[j] for j in range(CONV_WIDTH))


def clamped_swiglu(g, l):
    g = jnp.minimum(g, SWIGLU_LIMIT)
    l = jnp.clip(l, -SWIGLU_LIMIT, SWIGLU_LIMIT)
    return g * jax.nn.sigmoid(SWIGLU_ALPHA * g) * (l + 1.0)


def moe(h, w_router, b_router, w_glu, b_glu, w_lin, b_lin, w_down, b_down):
    B, S, D = h.shape
    T = B * S
    hf = h.reshape(T, D)
    logits = hf.astype(jnp.float32) @ w_router.astype(jnp.float32) + b_router.astype(jnp.float32)
    top_v, top_i = lax.top_k(logits, TOP_K)
    gates = jax.nn.softmax(top_v, axis=-1)
    N = T * TOP_K
    flat_e = top_i.reshape(N).astype(jnp.int32)
    flat_tok = jnp.repeat(jnp.arange(T, dtype=jnp.int32), TOP_K)
    flat_w = gates.reshape(N)
    order = jnp.argsort(flat_e, stable=True)
    se, stok, sw = flat_e[order], flat_tok[order], flat_w[order]
    counts = jnp.bincount(flat_e, length=N_EXPERTS).astype(jnp.int32)
    start = jnp.cumsum(counts) - counts
    padded = (counts + MOE_BLOCK - 1) // MOE_BLOCK * MOE_BLOCK
    pend = jnp.cumsum(padded)
    pstart = pend - padded
    dest = pstart[se] + jnp.arange(N, dtype=jnp.int32) - start[se]
    NP = (N + MOE_BLOCK - 1) // MOE_BLOCK * MOE_BLOCK + N_EXPERTS * MOE_BLOCK
    NB = NP // MOE_BLOCK
    buf_tok = jnp.zeros((NP,), jnp.int32).at[dest].set(stok)
    buf_w = jnp.zeros((NP,), jnp.float32).at[dest].set(sw)
    block_e = jnp.clip(jnp.searchsorted(pend, jnp.arange(NB, dtype=jnp.int32) * MOE_BLOCK, side='right'),
                       0, N_EXPERTS - 1)

    def expert_block(args):
        tok, wt, e = args
        xb = hf[tok]
        a = clamped_swiglu(xb @ w_glu[e] + b_glu[e], xb @ w_lin[e] + b_lin[e])
        y = a @ w_down[e] + b_down[e]
        return y.astype(jnp.float32) * wt[:, None]

    y = lax.map(expert_block, (buf_tok.reshape(NB, MOE_BLOCK), buf_w.reshape(NB, MOE_BLOCK), block_e))
    out = jnp.zeros((T, D), jnp.float32).at[buf_tok].add(y.reshape(NP, D))
    return out.astype(h.dtype).reshape(B, S, D)


def setup_inputs(seed: int = 0) -> dict:
    key = jax.random.key(seed)
    ks = iter(jax.random.split(key, 40))
    f32 = jnp.float32

    def nrm(shape, scale):
        return jax.random.normal(next(ks), shape, f32) * scale

    return {
        "x": nrm((BATCH, SEQ, D_MODEL), 1.0),
        "c": nrm((BATCH, D_MODEL), 1.0),
        "positions": jnp.broadcast_to(jnp.arange(SEQ, dtype=jnp.int32), (BATCH, SEQ)),
        "ada_w": nrm((DEPTH, D_MODEL, 6 * D_MODEL), D_MODEL ** -0.5),
        "ada_b": nrm((DEPTH, 6 * D_MODEL), 0.02),
        "ln_mix_g": 1.0 + nrm((DEPTH, D_MODEL), 0.02),
        "ln_mix_b": nrm((DEPTH, D_MODEL), 0.02),
        "ln_ffn_g": 1.0 + nrm((DEPTH, D_MODEL), 0.02),
        "ln_ffn_b": nrm((DEPTH, D_MODEL), 0.02),
        "mla_w_in": nrm((N_EVEN, D_MODEL, PROJ_A), D_MODEL ** -0.5),
        "mla_q_norm_g": 1.0 + nrm((N_EVEN, Q_RANK), 0.02),
        "mla_kv_norm_g": 1.0 + nrm((N_EVEN, KV_RANK), 0.02),
        "mla_w_uq": nrm((N_EVEN, Q_RANK, MLA_HEADS * (QK_NOPE + QK_ROPE)), Q_RANK ** -0.5),
        "mla_w_uk": nrm((N_EVEN, KV_RANK, MLA_HEADS * QK_NOPE), KV_RANK ** -0.5),
        "mla_w_uv": nrm((N_EVEN, KV_RANK, MLA_HEADS * V_HEAD), KV_RANK ** -0.5),
        "mix_a_w_out": nrm((N_EVEN, D_MIX_A, D_MODEL), DEEPNORM_BETA * D_MIX_A ** -0.5),
        "conv_w_in": nrm((N_ODD, D_MODEL, 3 * D_CONV), D_MODEL ** -0.5),
        "conv_w": nrm((N_ODD, CONV_WIDTH, D_CONV), CONV_WIDTH ** -0.5),
        "conv_w_out": nrm((N_ODD, D_CONV, D_MODEL), DEEPNORM_BETA * D_CONV ** -0.5),
        "moe_w_router": nrm((DEPTH, D_MODEL, N_EXPERTS), D_MODEL ** -0.5),
        "moe_b_router": nrm((DEPTH, N_EXPERTS), 0.01),
        "moe_w_glu": nrm((DEPTH, N_EXPERTS, D_MODEL, D_EXPERT), D_MODEL ** -0.5),
        "moe_b_glu": nrm((DEPTH, N_EXPERTS, D_EXPERT), 0.01),
        "moe_w_lin": nrm((DEPTH, N_EXPERTS, D_MODEL, D_EXPERT), D_MODEL ** -0.5),
        "moe_b_lin": nrm((DEPTH, N_EXPERTS, D_EXPERT), 0.01),
        "moe_w_down": nrm((DEPTH, N_EXPERTS, D_EXPERT, D_MODEL), DEEPNORM_BETA * D_EXPERT ** -0.5),
        "moe_b_down": nrm((DEPTH, N_EXPERTS, D_MODEL), 0.01),
    }


def reference(x, c, positions, ada_w, ada_b, ln_mix_g, ln_mix_b, ln_ffn_g, ln_ffn_b,
              mla_w_in, mla_q_norm_g, mla_kv_norm_g, mla_w_uq, mla_w_uk, mla_w_uv, mix_a_w_out,
              conv_w_in, conv_w, conv_w_out,
              moe_w_router, moe_b_router, moe_w_glu, moe_b_glu, moe_w_lin, moe_b_lin,
              moe_w_down, moe_b_down):
    cond = jax.nn.silu(c)
    cos, sin = rope_tables(positions, x.dtype)
    split_a = [Q_RANK, Q_RANK + KV_RANK, Q_RANK + KV_RANK + QK_ROPE]
    for l in range(DEPTH):
        mod = cond @ ada_w[l] + ada_b[l]
        sh_m, sc_m, g_m, sh_f, sc_f, g_f = [m[:, None, :] for m in jnp.split(mod, 6, axis=-1)]
        h = layer_norm(x, eps=MOD_EPS) * (1.0 + sc_m) + sh_m
        i = l // 2
        if l % 2 == 0:
            p = h @ mla_w_in[i]
            c_q, c_kv, k_r, u_f = jnp.split(p, split_a, axis=-1)
            o_a = mla_attention(c_q, c_kv, k_r, cos, sin, mla_q_norm_g[i], mla_kv_norm_g[i],
                                mla_w_uq[i], mla_w_uk[i], mla_w_uv[i])
            o_b = fnet_mix(u_f)
            o = jnp.concatenate([o_a, o_b], axis=-1) @ mix_a_w_out[i]
        else:
            p = h @ conv_w_in[i]
            gate_b, gate_c, xv = jnp.split(p, 3, axis=-1)
            o = (gate_b * short_conv(gate_c * xv, conv_w[i])) @ conv_w_out[i]
        x = layer_norm(DEEPNORM_ALPHA * x + g_m * o, ln_mix_g[l], ln_mix_b[l])
        h = layer_norm(x, eps=MOD_EPS) * (1.0 + sc_f) + sh_f
        o = moe(h, moe_w_router[l], moe_b_router[l], moe_w_glu[l], moe_b_glu[l],
                moe_w_lin[l], moe_b_lin[l], moe_w_down[l], moe_b_down[l])
        x = layer_norm(DEEPNORM_ALPHA * x + g_f * o, ln_ffn_g[l], ln_ffn_b[l])
    return x
```

```cpp
#include <hip/hip_runtime.h>
#include <cstdio>
#include <cstdint>

#ifndef MODE
#define MODE 31
#endif
#define HYBRID (!(MODE & 16))

constexpr int NB = 4, NS = 4096, DM = 1024, NT = NB * NS;
constexpr int NH = 8, QKN = 64, QKR = 32, QKD = 96, VH = 64, QRANK = 256, KVRANK = 128;
constexpr int PROJ_A = 928;
constexpr int NE = 32, TOPK = 4;
constexpr float ALPHA = 1.4142135623730951f;
constexpr float SWL = 7.0f, SWA = 1.702f;
constexpr int SLOTS = NT * TOPK + NE * 256;

typedef unsigned short bf16;
__device__ __forceinline__ float bf2f(bf16 v) { return __uint_as_float(((unsigned)v) << 16); }
__device__ __forceinline__ bf16 f2bf(float f) { unsigned u = __float_as_uint(f); return (bf16)((u + 0x7fffu + ((u >> 16) & 1u)) >> 16); }
__device__ __forceinline__ float tof(float v) { return v; }
__device__ __forceinline__ float tof(bf16 v) { return bf2f(v); }

constexpr size_t MiB = 1u << 20;
constexpr size_t WS_CTL = 0;
constexpr size_t CTL_BYTES = 1 * MiB;
constexpr size_t WS_MOD = 1 * MiB;
constexpr size_t WS_ROPE = 2 * MiB;
constexpr size_t WS_RQ = 4 * MiB;
constexpr size_t WS_TOPI = 5 * MiB;
constexpr size_t WS_TPOS = 6 * MiB;
constexpr size_t WS_GATE = 7 * MiB;
constexpr size_t WS_LIST = 8 * MiB;
constexpr size_t WS_H = 16 * MiB;
constexpr size_t WS_O = 48 * MiB;
constexpr size_t WS_XA = 112 * MiB;
constexpr size_t WS_XB = 176 * MiB;
constexpr size_t WS_CQ = 240 * MiB;
constexpr size_t WS_CKV = 248 * MiB;
constexpr size_t WS_KPE = 252 * MiB;
constexpr size_t WS_UF = 256 * MiB;
constexpr size_t WS_Q = 272 * MiB;
constexpr size_t WS_K = 296 * MiB;
constexpr size_t WS_V = 320 * MiB;
constexpr size_t WS_UCS = 336 * MiB;
constexpr size_t WS_DMAT = 368 * MiB;
constexpr size_t WS_OCAT = 432 * MiB;
constexpr size_t WS_TMP = 464 * MiB;
constexpr size_t WS_PC = 240 * MiB;
constexpr size_t WS_YC = 336 * MiB;
constexpr size_t WS_AACT = 240 * MiB;
constexpr size_t WS_Y = 384 * MiB;
constexpr size_t WS_END = 528 * MiB;
constexpr int CW_CNT = 64;

template <int CTRL> __device__ __forceinline__ float dppf(float v) { return __int_as_float(__builtin_amdgcn_update_dpp(0, __float_as_int(v), CTRL, 0xf, 0xf, false)); }
__device__ __forceinline__ float wsum(float v) {
    v += dppf<0xB1>(v); v += dppf<0x4E>(v); v += dppf<0x141>(v); v += dppf<0x140>(v);
    { auto rr = __builtin_amdgcn_permlane16_swap(__float_as_uint(v), __float_as_uint(v), false, false); v = __uint_as_float(rr[0]) + __uint_as_float(rr[1]); }
    { auto rr = __builtin_amdgcn_permlane32_swap(__float_as_uint(v), __float_as_uint(v), false, false); v = __uint_as_float(rr[0]) + __uint_as_float(rr[1]); }
    return v;
}
__device__ __forceinline__ float swiglu(float g, float l) {
    g = fminf(g, SWL); l = fminf(fmaxf(l, -SWL), SWL);
    const float e = __builtin_amdgcn_exp2f(g * (-SWA * 1.4426950408889634f));
    return g * __builtin_amdgcn_rcpf(1.f + e) * (l + 1.f);
}

#if HYBRID
__global__ void __launch_bounds__(256) n_mod(const float* __restrict__ c, const float* __restrict__ ada_w, const float* __restrict__ ada_b, float* __restrict__ mod) {
    __shared__ float cond[4][1024];
    const int tid = threadIdx.x, n = blockIdx.x * 256 + tid, l = blockIdx.y;
    for (int i = tid; i < 4096; i += 256) { float v = c[i]; cond[i >> 10][i & 1023] = v / (1.f + expf(-v)); }
    __syncthreads();
    float a0 = 0.f, a1 = 0.f, a2 = 0.f, a3 = 0.f;
    const float* w = ada_w + (size_t)l * 1024 * 6144 + n;
    for (int k = 0; k < 1024; ++k) { float wv = w[(size_t)k * 6144]; a0 += cond[0][k] * wv; a1 += cond[1][k] * wv; a2 += cond[2][k] * wv; a3 += cond[3][k] * wv; }
    float bb = ada_b[l * 6144 + n];
    mod[(l * 4 + 0) * 6144 + n] = a0 + bb; mod[(l * 4 + 1) * 6144 + n] = a1 + bb; mod[(l * 4 + 2) * 6144 + n] = a2 + bb; mod[(l * 4 + 3) * 6144 + n] = a3 + bb;
}

__global__ void __launch_bounds__(256) n_rope(const int* __restrict__ pos, float* __restrict__ rope) {
    const int i = blockIdx.x * 256 + threadIdx.x;
    if (i >= NT * 16) return;
    const int t = i >> 4, j = i & 15;
    const float inv = exp2f(-(float)j * (13.287712379549449f / 16.f));
    const float ang = (float)pos[t] * inv;
    const double rev = (double)ang * 0.15915494309189535;
    const float fr = (float)(rev - rint(rev));
    rope[i] = __builtin_amdgcn_cosf(fr);
    rope[NT * 16 + i] = __builtin_amdgcn_sinf(fr);
}

__global__ void __launch_bounds__(256) n_dmat(bf16* __restrict__ dm) {
    const size_t i = (size_t)blockIdx.x * 256 + threadIdx.x;
    const int sp = (int)(i >> 13), k = (int)(i & 8191), s = k & 4095;
    const float fr = (float)((sp * s) & 4095) * (1.f / 4096.f);
    const float v = (k < 4096) ? __builtin_amdgcn_cosf(fr) : -__builtin_amdgcn_sinf(fr);
    dm[i] = f2bf(v * (1.f / 512.f));
}

#endif
__device__ __forceinline__ void ld_row(const float* p, int lane, float4 (&v)[4]) {
#pragma unroll
    for (int j = 0; j < 4; ++j) v[j] = ((const float4*)p)[lane + 64 * j];
}
__device__ __forceinline__ void st_row(float* p, int lane, const float4 (&v)[4]) {
#pragma unroll
    for (int j = 0; j < 4; ++j) ((float4*)p)[lane + 64 * j] = v[j];
}
__device__ __forceinline__ void ld_row_bf(const bf16* p, int lane, float4 (&v)[4]) {
#pragma unroll
    for (int j = 0; j < 4; ++j) { uint2 u = ((const uint2*)p)[lane + 64 * j];
        v[j].x = __uint_as_float(u.x << 16); v[j].y = __uint_as_float(u.x & 0xffff0000u); v[j].z = __uint_as_float(u.y << 16); v[j].w = __uint_as_float(u.y & 0xffff0000u); }
}
typedef __bf16 nbf2_t __attribute__((ext_vector_type(2))); typedef float nf2_t __attribute__((ext_vector_type(2)));
__device__ __forceinline__ unsigned pkbf(float lo, float hi) { nf2_t v = {lo, hi}; nbf2_t b = __builtin_convertvector(v, nbf2_t); return __builtin_bit_cast(unsigned, b); }
__device__ __forceinline__ void st_row_bf(bf16* p, int lane, const float4 (&v)[4]) {
#pragma unroll
    for (int j = 0; j < 4; ++j) { uint2 u; u.x = pkbf(v[j].x, v[j].y); u.y = pkbf(v[j].z, v[j].w); ((uint2*)p)[lane + 64 * j] = u; }
}
__device__ __forceinline__ unsigned pack_fp8x4(float a, float b, float c, float d) { int w = __builtin_amdgcn_cvt_pk_fp8_f32(a, b, 0, false); w = __builtin_amdgcn_cvt_pk_fp8_f32(c, d, w, true); return (unsigned)w; }
__device__ __forceinline__ void st_row_fp8(unsigned char* p, int lane, const float4 (&v)[4]) {
#pragma unroll
    for (int j = 0; j < 4; ++j) ((unsigned*)p)[lane + 64 * j] = pack_fp8x4(v[j].x, v[j].y, v[j].z, v[j].w);
}
__device__ __forceinline__ void ln_inplace(float4 (&v)[4], float eps) {
    float s = 0.f;
#pragma unroll
    for (int j = 0; j < 4; ++j) s += (v[j].x + v[j].y) + (v[j].z + v[j].w);
    const float mean = wsum(s) * (1.f / 1024.f);
    float s2 = 0.f;
#pragma unroll
    for (int j = 0; j < 4; ++j) { v[j].x -= mean; v[j].y -= mean; v[j].z -= mean; v[j].w -= mean; s2 += (v[j].x * v[j].x + v[j].y * v[j].y) + (v[j].z * v[j].z + v[j].w * v[j].w); }
    const float rstd = rsqrtf(wsum(s2) * (1.f / 1024.f) + eps);
#pragma unroll
    for (int j = 0; j < 4; ++j) { v[j].x *= rstd; v[j].y *= rstd; v[j].z *= rstd; v[j].w *= rstd; }
}
struct PVec { float4 v[4]; };
__device__ __forceinline__ void ld_pvec(const float* p, int lane, PVec& o) {
#pragma unroll
    for (int j = 0; j < 4; ++j) o.v[j] = ((const float4*)p)[lane + 64 * j];
}
__device__ __forceinline__ void modulate(float4 (&v)[4], const PVec& sc, const PVec& sh) {
#pragma unroll
    for (int j = 0; j < 4; ++j) { const float4 a = sc.v[j], b = sh.v[j];
        v[j].x = v[j].x * (1.f + a.x) + b.x; v[j].y = v[j].y * (1.f + a.y) + b.y; v[j].z = v[j].z * (1.f + a.z) + b.z; v[j].w = v[j].w * (1.f + a.w) + b.w; }
}
__device__ __forceinline__ void resid_ln(float4 (&x)[4], const float4 (&o)[4], const PVec& g, const PVec& gamma, const PVec& beta) {
#pragma unroll
    for (int j = 0; j < 4; ++j) { const float4 a = g.v[j];
        x[j].x = ALPHA * x[j].x + a.x * o[j].x; x[j].y = ALPHA * x[j].y + a.y * o[j].y; x[j].z = ALPHA * x[j].z + a.z * o[j].z; x[j].w = ALPHA * x[j].w + a.w * o[j].w; }
    ln_inplace(x, 1e-5f);
#pragma unroll
    for (int j = 0; j < 4; ++j) { const float4 a = gamma.v[j], b = beta.v[j];
        x[j].x = x[j].x * a.x + b.x; x[j].y = x[j].y * a.y + b.y; x[j].z = x[j].z * a.z + b.z; x[j].w = x[j].w * a.w + b.w; }
}

__device__ __forceinline__ float wmax(float v) {
    v = fmaxf(v, dppf<0xB1>(v)); v = fmaxf(v, dppf<0x4E>(v)); v = fmaxf(v, dppf<0x141>(v)); v = fmaxf(v, dppf<0x140>(v));
    { auto rr = __builtin_amdgcn_permlane16_swap(__float_as_uint(v), __float_as_uint(v), false, false); v = fmaxf(__uint_as_float(rr[0]), __uint_as_float(rr[1])); }
    { auto rr = __builtin_amdgcn_permlane32_swap(__float_as_uint(v), __float_as_uint(v), false, false); v = fmaxf(__uint_as_float(rr[0]), __uint_as_float(rr[1])); }
    return v;
}
__device__ __forceinline__ float xpose_reduce32(const float (&p)[32], int lane) {
    const bool b5 = (lane & 32) != 0, b4 = (lane & 16) != 0, b3 = (lane & 8) != 0, b2 = (lane & 4) != 0, b1 = (lane & 2) != 0;
    float q[16];
#pragma unroll
    for (int e = 0; e < 16; ++e) { const float send = b5 ? p[e] : p[e + 16], keep = b5 ? p[e + 16] : p[e];
        auto rr = __builtin_amdgcn_permlane32_swap(__float_as_uint(send), __float_as_uint(send), false, false);
        q[e] = keep + (b5 ? __uint_as_float(rr[0]) : __uint_as_float(rr[1])); }
    float r8[8];
#pragma unroll
    for (int e = 0; e < 8; ++e) { const float send = b4 ? q[e] : q[e + 8], keep = b4 ? q[e + 8] : q[e];
        auto rr = __builtin_amdgcn_permlane16_swap(__float_as_uint(send), __float_as_uint(send), false, false);
        r8[e] = keep + (b4 ? __uint_as_float(rr[0]) : __uint_as_float(rr[1])); }
    float r4[4];
#pragma unroll
    for (int e = 0; e < 4; ++e) { const float send = b3 ? r8[e] : r8[e + 4], keep = b3 ? r8[e + 4] : r8[e]; r4[e] = keep + dppf<0x128>(send); }
    float r2[2];
#pragma unroll
    for (int e = 0; e < 2; ++e) { const float send = b2 ? r4[e] : r4[e + 2], keep = b2 ? r4[e + 2] : r4[e]; r2[e] = keep + __shfl_xor(send, 4); }
    float r1;
    { const float send = b1 ? r2[0] : r2[1], keep = b1 ? r2[1] : r2[0]; r1 = keep + dppf<0x4E>(send); }
    r1 += dppf<0xB1>(r1);
    return r1;
}
__device__ __forceinline__ void top4_gates(float lg, int lane, int (&ei)[4], float (&gv)[4]) {
    float tv[4];
#pragma unroll
    for (int k = 0; k < 4; ++k) { const float m = wmax(lg); const unsigned long long bal = __ballot(lg == m); const int e = (__builtin_ctzll(bal) >> 1) & 31;
        ei[k] = e; tv[k] = m; lg = (((lane >> 1) & 31) == e) ? -3.0e38f : lg; }
    float s = 0.f;
#pragma unroll
    for (int k = 0; k < 4; ++k) { gv[k] = expf(tv[k] - tv[0]); s += gv[k]; }
    const float inv = 1.f / s;
#pragma unroll
    for (int k = 0; k < 4; ++k) gv[k] *= inv;
}
__device__ __forceinline__ void route_rows2(const float4 (&h0)[4], const float4 (&h1)[4], const float* wl, const float* __restrict__ br, int lane, int (&ei0)[4], float (&gv0)[4], int (&ei1)[4], float (&gv1)[4]) {
    float p0[32], p1[32];
#pragma unroll
    for (int e = 0; e < 32; ++e) { const float4* w = (const float4*)(wl + e * 1024); float a0 = 0.f, a1 = 0.f;
#pragma unroll
        for (int j = 0; j < 4; ++j) { const float4 ww = w[lane + 64 * j];
            a0 += (h0[j].x * ww.x + h0[j].y * ww.y) + (h0[j].z * ww.z + h0[j].w * ww.w);
            a1 += (h1[j].x * ww.x + h1[j].y * ww.y) + (h1[j].z * ww.z + h1[j].w * ww.w); }
        p0[e] = a0; p1[e] = a1; }
    const float bias = br[(lane >> 1) & 31];
    const float l0 = xpose_reduce32(p0, lane) + bias, l1 = xpose_reduce32(p1, lane) + bias;
    top4_gates(l0, lane, ei0, gv0); top4_gates(l1, lane, ei1, gv1);
}

struct RowArgs {
    const float* xin;
    const float* o;
    float* xout;
    bf16* h;
    const float* mod;
    const float* mod_next;
    const float* gamma; const float* beta;
    const float* wr; const float* br;
    int* topi; int* tpos; float* gate; int* list; unsigned* cnt;
    const bf16* y; const unsigned* cntc;
    unsigned char* h8;
    const bf16* xin_bf; bf16* xout_bf; const bf16* o_bf;
    int final_; int pad;
};

constexpr int RP_LDS_W = 32 * 1024 * 4;
constexpr int RP_LDS_BYTES = RP_LDS_W + 2048 + 512;

__device__ __forceinline__ void rp_a_chunk(const RowArgs& a, int chunk, int wave, int lane) {
    const int b = (chunk * 64) >> 12; PVec sc, sh; ld_pvec(a.mod + b * 6144 + 1024, lane, sc); ld_pvec(a.mod + b * 6144, lane, sh);
    for (int i0 = wave; i0 < 64; i0 += 16) {
        float4 v[2][4];
#pragma unroll
        for (int u = 0; u < 2; ++u) ld_row(a.xin + (size_t)(chunk * 64 + i0 + 8 * u) * DM, lane, v[u]);
#pragma unroll
        for (int u = 0; u < 2; ++u) { ln_inplace(v[u], 1e-6f); modulate(v[u], sc, sh); st_row_bf(a.h + (size_t)(chunk * 64 + i0 + 8 * u) * DM, lane, v[u]); } }
}
__device__ __forceinline__ void rp_b_chunk(const RowArgs& a, int chunk, int wave, int lane, char* lds) {
    const float* wl = (const float*)lds;
    int* se = (int*)(lds + RP_LDS_W); int* sp = se + 256; int* lcnt = sp + 256; int* base = lcnt + 32;
    const int tid = wave * 64 + lane;
    if (tid < 32) lcnt[tid] = 0;
    __syncthreads();
    const float* mb = a.mod + ((chunk * 64) >> 12) * 6144;
    for (int i0 = wave; i0 < 64; i0 += 16) {
        float4 x[2][4], o[2][4];
#pragma unroll
        for (int u = 0; u < 2; ++u) { const int r = chunk * 64 + i0 + 8 * u;
            if (a.xin_bf) ld_row_bf(a.xin_bf + (size_t)r * DM, lane, x[u]); else ld_row(a.xin + (size_t)r * DM, lane, x[u]);
            if (a.o_bf) ld_row_bf(a.o_bf + (size_t)r * DM, lane, o[u]); else ld_row(a.o + (size_t)r * DM, lane, o[u]); }
        PVec pg, pgam, pbet, psc, psh; ld_pvec(mb + 2048, lane, pg); ld_pvec(a.gamma, lane, pgam); ld_pvec(a.beta, lane, pbet); ld_pvec(mb + 4096, lane, psc); ld_pvec(mb + 3072, lane, psh);
#pragma unroll
        for (int u = 0; u < 2; ++u) { const int r = chunk * 64 + i0 + 8 * u;
            resid_ln(x[u], o[u], pg, pgam, pbet);
            if (a.xout_bf) st_row_bf(a.xout_bf + (size_t)r * DM, lane, x[u]); else st_row(a.xout + (size_t)r * DM, lane, x[u]);
            ln_inplace(x[u], 1e-6f);
            modulate(x[u], psc, psh);
            if (a.h) st_row_bf(a.h + (size_t)r * DM, lane, x[u]);
            if (a.h8) st_row_fp8(a.h8 + (size_t)r * DM, lane, x[u]); }
        int ei[2][4]; float gv[2][4]; route_rows2(x[0], x[1], wl, a.br, lane, ei[0], gv[0], ei[1], gv[1]);
#pragma unroll
        for (int u = 0; u < 2; ++u) { const int i = i0 + 8 * u, r = chunk * 64 + i;
            if (lane < 4) { const int e = (lane == 0) ? ei[u][0] : (lane == 1) ? ei[u][1] : (lane == 2) ? ei[u][2] : ei[u][3];
                const float g = (lane == 0) ? gv[u][0] : (lane == 1) ? gv[u][1] : (lane == 2) ? gv[u][2] : gv[u][3];
                const int lp = atomicAdd(&lcnt[e], 1);
                se[i * 4 + lane] = e; sp[i * 4 + lane] = lp;
                a.topi[r * 4 + lane] = e; a.gate[r * 4 + lane] = g; } }
    }
    __syncthreads();
    if (tid < 32) base[tid] = (int)atomicAdd(&a.cnt[tid], (unsigned)lcnt[tid]);
    __syncthreads();
    if (tid < 256) { const int r = chunk * 64 + (tid >> 2), e = se[tid], pos = base[e] + sp[tid];
        a.tpos[r * 4 + (tid & 3)] = pos; a.list[e * NT + pos] = r; }
    __syncthreads();
}
__device__ __forceinline__ void rp_c_chunk(const RowArgs& a, int chunk, int wave, int lane, const int* poff, bool final_) {
    int myslot = 0; float myg = 0.f;
    if (lane < 32) { const int r = chunk * 64 + wave + 8 * (lane >> 2), k = lane & 3; const int e = a.topi[r * 4 + k]; myslot = poff[e] + a.tpos[r * 4 + k]; myg = a.gate[r * 4 + k]; }
    const float* mb = a.mod + ((chunk * 64) >> 12) * 6144;
    PVec pg, pgam, pbet, psc, psh; ld_pvec(mb + 5120, lane, pg); ld_pvec(a.gamma, lane, pgam); ld_pvec(a.beta, lane, pbet);
    if (!final_) { const float* mn = a.mod_next + ((chunk * 64) >> 12) * 6144; ld_pvec(mn + 1024, lane, psc); ld_pvec(mn, lane, psh); }
    for (int it = 0; it < 8; it += 2) {
        float4 x[2][4]; uint2 yr[2][4][4]; float g[2][4];
#pragma unroll
        for (int u = 0; u < 2; ++u) { const int r = chunk * 64 + wave + 8 * (it + u);
            if (a.xin_bf) ld_row_bf(a.xin_bf + (size_t)r * DM, lane, x[u]); else ld_row(a.xin + (size_t)r * DM, lane, x[u]);
#pragma unroll
            for (int k = 0; k < 4; ++k) { const int slot = __builtin_amdgcn_readlane(myslot, 4 * (it + u) + k); g[u][k] = __int_as_float(__builtin_amdgcn_readlane(__float_as_int(myg), 4 * (it + u) + k));
                const uint2* yp = (const uint2*)(a.y + (size_t)slot * DM);
#pragma unroll
                for (int j = 0; j < 4; ++j) yr[u][k][j] = yp[lane + 64 * j]; } }
#pragma unroll
        for (int u = 0; u < 2; ++u) { const int r = chunk * 64 + wave + 8 * (it + u);
            float4 o[4];
#pragma unroll
            for (int j = 0; j < 4; ++j) { o[j] = make_float4(0.f, 0.f, 0.f, 0.f);
#pragma unroll
                for (int k = 0; k < 4; ++k) { const uint2 w = yr[u][k][j]; const float gg = g[u][k];
                    o[j].x += gg * __uint_as_float(w.x << 16); o[j].y += gg * __uint_as_float(w.x & 0xffff0000u); o[j].z += gg * __uint_as_float(w.y << 16); o[j].w += gg * __uint_as_float(w.y & 0xffff0000u); } }
            resid_ln(x[u], o, pg, pgam, pbet);
            if (a.xout_bf) st_row_bf(a.xout_bf + (size_t)r * DM, lane, x[u]); else st_row(a.xout + (size_t)r * DM, lane, x[u]);
            if (!final_) { ln_inplace(x[u], 1e-6f); modulate(x[u], psc, psh); st_row_bf(a.h + (size_t)r * DM, lane, x[u]); } }
    }
}
__device__ __forceinline__ void compute_poff(const unsigned* cnt, int* poff, int tid) {
    if (tid < 64) { const int v = (tid < 32) ? (((int)cnt[tid] + 255) & ~255) : 0; int x = v;
#pragma unroll
        for (int o = 1; o < 32; o <<= 1) { const int y = __shfl_up(x, o); if (tid >= o) x += y; }
        if (tid < 32) poff[tid] = x - v;
        if (tid == 31) poff[32] = x; }
}
__device__ __forceinline__ void load_wl(const float* wr, char* lds, int tid) {
    float* wl = (float*)lds; float4 v[16];
#pragma unroll
    for (int k = 0; k < 16; ++k) v[k] = ((const float4*)wr)[tid + 512 * k];
#pragma unroll
    for (int k = 0; k < 16; ++k) { const int i4 = tid + 512 * k, c = i4 >> 3, e0 = (i4 & 7) * 4;
        wl[(e0 + 0) * 1024 + c] = v[k].x; wl[(e0 + 1) * 1024 + c] = v[k].y; wl[(e0 + 2) * 1024 + c] = v[k].z; wl[(e0 + 3) * 1024 + c] = v[k].w; }
}

#if HYBRID
__global__ void __launch_bounds__(512) k_rp_a(RowArgs a) {
    const int wave = threadIdx.x >> 6, lane = threadIdx.x & 63;
    for (int ch = blockIdx.x; ch < NT / 64; ch += gridDim.x) rp_a_chunk(a, ch, wave, lane);
}
__global__ void __launch_bounds__(512) k_rp_b(RowArgs a) {
    extern __shared__ __attribute__((aligned(16))) char lds[];
    const int wave = threadIdx.x >> 6, lane = threadIdx.x & 63;
    load_wl(a.wr, lds, threadIdx.x);
    __syncthreads();
    for (int ch = blockIdx.x; ch < NT / 64; ch += gridDim.x) rp_b_chunk(a, ch, wave, lane, lds);
}
__global__ void __launch_bounds__(512) k_rp_c(RowArgs a) {
    __shared__ int poff[36];
    const int wave = threadIdx.x >> 6, lane = threadIdx.x & 63;
    compute_poff(a.cntc, poff, threadIdx.x);
    __syncthreads();
    for (int ch = blockIdx.x; ch < NT / 64; ch += gridDim.x) rp_c_chunk(a, ch, wave, lane, poff, a.final_ != 0);
}

#endif
#if HYBRID
struct EpiF32 { float* C; int ldc; int pad; __device__ void operator()(int r, int c, float v) const { C[(size_t)r * ldc + c] = v; } };
struct EpiBf { bf16* C; int ldc; int pad; __device__ void operator()(int r, int c, float v) const { C[(size_t)r * ldc + c] = f2bf(v); } };
struct EpiP2 { bf16* cq; bf16* ckv; float* kr; bf16* uf;
    __device__ void operator()(int r, int c, float v) const {
        if (c < 256) cq[(size_t)r * 256 + c] = f2bf(v); else if (c < 384) ckv[(size_t)r * 128 + c - 256] = f2bf(v);
        else if (c < 416) kr[(size_t)r * 32 + c - 384] = v; else uf[(size_t)r * 512 + c - 416] = f2bf(v); } };
struct EpiQ { float* tq; const float* rq; __device__ void operator()(int r, int c, float v) const { tq[(size_t)r * 768 + c] = v * rq[r] * 0.10206207261596575f; } };
struct EpiKV { bf16* o; const float* rkv; int hd; int pad;
    __device__ void operator()(int r, int c, float v) const { const int b = r >> 12, s = r & 4095, h = c >> 6, d = c & 63;
        o[(((size_t)(b * NH + h)) * NS + s) * hd + d] = f2bf(v * rkv[r]); } };
struct EpiFnet { bf16* ocat;
    __device__ void operator()(int r, int c, float v) const { const int b = c >> 9, cc = c & 511; ocat[((size_t)(b * NS + r)) * DM + 512 + cc] = f2bf(v); } };

template <typename TA, bool BNT, typename Epi>
__global__ void __launch_bounds__(256) n_gemm(const TA* __restrict__ A, const void* __restrict__ Bp, const float* __restrict__ ascale, Epi epi, int lda, int ldb, int M, int N, int K, int pad_) {
    __shared__ float As[16][68];
    __shared__ float Bs[16][68];
    const int tid = threadIdx.x, tx = tid & 15, ty = tid >> 4, m0 = blockIdx.y * 64, n0 = blockIdx.x * 64;
    float acc[4][4];
#pragma unroll
    for (int i = 0; i < 4; ++i)
#pragma unroll
        for (int j = 0; j < 4; ++j) acc[i][j] = 0.f;
    for (int k0 = 0; k0 < K; k0 += 16) {
        { const int r = tid >> 2, kk = (tid & 3) * 4, gr = m0 + r;
#pragma unroll
          for (int i = 0; i < 4; ++i) { float v = 0.f; if (gr < M) { v = tof(A[(size_t)gr * lda + k0 + kk + i]); if (ascale) v *= ascale[k0 + kk + i]; } As[kk + i][r] = v; } }
        if (!BNT) { const float* B = (const float*)Bp; const int kk = tid >> 4, n = (tid & 15) * 4;
#pragma unroll
          for (int i = 0; i < 4; ++i) Bs[kk][n + i] = (n0 + n + i < N) ? B[(size_t)(k0 + kk) * ldb + n0 + n + i] : 0.f; }
        else { const bf16* B = (const bf16*)Bp; const int n = tid >> 2, kk = (tid & 3) * 4;
#pragma unroll
          for (int i = 0; i < 4; ++i) Bs[kk + i][n] = (n0 + n < N) ? bf2f(B[(size_t)(n0 + n) * ldb + k0 + kk + i]) : 0.f; }
        __syncthreads();
#pragma unroll
        for (int kk = 0; kk < 16; ++kk) { float a[4], b[4];
#pragma unroll
            for (int i = 0; i < 4; ++i) { a[i] = As[kk][ty * 4 + i]; b[i] = Bs[kk][tx * 4 + i]; }
#pragma unroll
            for (int i = 0; i < 4; ++i)
#pragma unroll
                for (int j = 0; j < 4; ++j) acc[i][j] += a[i] * b[j]; }
        __syncthreads();
    }
#pragma unroll
    for (int i = 0; i < 4; ++i)
#pragma unroll
        for (int j = 0; j < 4; ++j) { const int r = m0 + ty * 4 + i, c = n0 + tx * 4 + j; if (r < M && c < N) epi(r, c, acc[i][j]); }
}

__global__ void __launch_bounds__(256) n_moe_up(const bf16* __restrict__ H, const float* __restrict__ wg, const float* __restrict__ bg, const float* __restrict__ wlin, const float* __restrict__ blin,
                                               const int* __restrict__ list, const unsigned* __restrict__ cnt, bf16* __restrict__ aact) {
    __shared__ float As[16][68];
    __shared__ float Bg[16][68];
    __shared__ float Bl[16][68];
    __shared__ int poff[36];
    const int e = blockIdx.z, M = (int)cnt[e], m0 = blockIdx.y * 64, n0 = blockIdx.x * 64;
    if (m0 >= M) return;
    const int tid = threadIdx.x, tx = tid & 15, ty = tid >> 4;
    compute_poff(cnt, poff, tid);
    const float* W1 = wg + (size_t)e * DM * DM; const float* W2 = wlin + (size_t)e * DM * DM;
    float ag[4][4], al[4][4];
#pragma unroll
    for (int i = 0; i < 4; ++i)
#pragma unroll
        for (int j = 0; j < 4; ++j) { ag[i][j] = 0.f; al[i][j] = 0.f; }
    const int r = tid >> 2, gr = m0 + r; const int src = (gr < M) ? list[e * NT + gr] : 0;
    for (int k0 = 0; k0 < DM; k0 += 16) {
        { const int kk = (tid & 3) * 4;
#pragma unroll
          for (int i = 0; i < 4; ++i) As[kk + i][r] = (gr < M) ? bf2f(H[(size_t)src * DM + k0 + kk + i]) : 0.f; }
        { const int kk = tid >> 4, n = (tid & 15) * 4;
#pragma unroll
          for (int i = 0; i < 4; ++i) { Bg[kk][n + i] = W1[(size_t)(k0 + kk) * DM + n0 + n + i]; Bl[kk][n + i] = W2[(size_t)(k0 + kk) * DM + n0 + n + i]; } }
        __syncthreads();
#pragma unroll
        for (int kk = 0; kk < 16; ++kk) { float a[4], b1[4], b2[4];
#pragma unroll
            for (int i = 0; i < 4; ++i) { a[i] = As[kk][ty * 4 + i]; b1[i] = Bg[kk][tx * 4 + i]; b2[i] = Bl[kk][tx * 4 + i]; }
#pragma unroll
            for (int i = 0; i < 4; ++i)
#pragma unroll
                for (int j = 0; j < 4; ++j) { ag[i][j] += a[i] * b1[j]; al[i][j] += a[i] * b2[j]; } }
        __syncthreads();
    }
    const int po = poff[e];
#pragma unroll
    for (int i = 0; i < 4; ++i)
#pragma unroll
        for (int j = 0; j < 4; ++j) { const int rr = m0 + ty * 4 + i, c = n0 + tx * 4 + j;
            if (rr < M) aact[(size_t)(po + rr) * DM + c] = f2bf(swiglu(ag[i][j] + bg[e * DM + c], al[i][j] + blin[e * DM + c])); }
}
__global__ void __launch_bounds__(256) n_moe_down(const bf16* __restrict__ aact, const float* __restrict__ wd, const float* __restrict__ bd, const unsigned* __restrict__ cnt, bf16* __restrict__ Y) {
    __shared__ float As[16][68];
    __shared__ float Bs[16][68];
    __shared__ int poff[36];
    const int e = blockIdx.z, M = (int)cnt[e], m0 = blockIdx.y * 64, n0 = blockIdx.x * 64;
    if (m0 >= M) return;
    const int tid = threadIdx.x, tx = tid & 15, ty = tid >> 4;
    compute_poff(cnt, poff, tid);
    __syncthreads();
    const int po = poff[e];
    const float* W = wd + (size_t)e * DM * DM;
    float acc[4][4];
#pragma unroll
    for (int i = 0; i < 4; ++i)
#pragma unroll
        for (int j = 0; j < 4; ++j) acc[i][j] = 0.f;
    const int r = tid >> 2, gr = m0 + r;
    for (int k0 = 0; k0 < DM; k0 += 16) {
        { const int kk = (tid & 3) * 4;
#pragma unroll
          for (int i = 0; i < 4; ++i) As[kk + i][r] = (gr < M) ? bf2f(aact[(size_t)(po + gr) * DM + k0 + kk + i]) : 0.f; }
        { const int kk = tid >> 4, n = (tid & 15) * 4;
#pragma unroll
          for (int i = 0; i < 4; ++i) Bs[kk][n + i] = W[(size_t)(k0 + kk) * DM + n0 + n + i]; }
        __syncthreads();
#pragma unroll
        for (int kk = 0; kk < 16; ++kk) { float a[4], b[4];
#pragma unroll
            for (int i = 0; i < 4; ++i) { a[i] = As[kk][ty * 4 + i]; b[i] = Bs[kk][tx * 4 + i]; }
#pragma unroll
            for (int i = 0; i < 4; ++i)
#pragma unroll
                for (int j = 0; j < 4; ++j) acc[i][j] += a[i] * b[j]; }
        __syncthreads();
    }
#pragma unroll
    for (int i = 0; i < 4; ++i)
#pragma unroll
        for (int j = 0; j < 4; ++j) { const int rr = m0 + ty * 4 + i, c = n0 + tx * 4 + j;
            if (rr < M) Y[(size_t)(po + rr) * DM + c] = f2bf(acc[i][j] + bd[e * DM + c]); }
}

__global__ void __launch_bounds__(256) n_kpe(const float* __restrict__ kr, const float* __restrict__ rope, bf16* __restrict__ kpe) {
    const int i = blockIdx.x * 256 + threadIdx.x; if (i >= NT * 16) return;
    const int t = i >> 4, j = i & 15; const float c = rope[i], s = rope[NT * 16 + i];
    const float t1 = kr[t * 32 + j], t2 = kr[t * 32 + 16 + j];
    kpe[t * 32 + j] = f2bf(t1 * c - t2 * s); kpe[t * 32 + 16 + j] = f2bf(t2 * c + t1 * s);
}
__global__ void __launch_bounds__(256) n_rms(const bf16* __restrict__ cq, const bf16* __restrict__ ckv, float* __restrict__ rq, float* __restrict__ rkv) {
    const int t = blockIdx.x * 256 + threadIdx.x; if (t >= NT) return;
    float s = 0.f; for (int k = 0; k < 256; ++k) { float v = bf2f(cq[(size_t)t * 256 + k]); s += v * v; }
    rq[t] = rsqrtf(s * (1.f / 256.f) + 1e-6f);
    s = 0.f; for (int k = 0; k < 128; ++k) { float v = bf2f(ckv[(size_t)t * 128 + k]); s += v * v; }
    rkv[t] = rsqrtf(s * (1.f / 128.f) + 1e-6f);
}
__global__ void __launch_bounds__(256) n_qfin(const float* __restrict__ tq, const float* __restrict__ rope, bf16* __restrict__ Q) {
    const int i = blockIdx.x * 256 + threadIdx.x; if (i >= NT * 768) return;
    const int t = i / 768, c = i % 768, h = c / 96, d = c % 96, b = t >> 12, s = t & 4095;
    float v;
    if (d < 64) v = tq[i];
    else { const int j = (d - 64) & 15; const float cs = rope[t * 16 + j], sn = rope[NT * 16 + t * 16 + j];
        const float t1 = tq[(size_t)t * 768 + h * 96 + 64 + j], t2 = tq[(size_t)t * 768 + h * 96 + 80 + j];
        v = (d < 80) ? (t1 * cs - t2 * sn) : (t2 * cs + t1 * sn); }
    Q[(((size_t)(b * NH + h)) * NS + s) * QKD + d] = f2bf(v);
}
__global__ void __launch_bounds__(256) n_kcopy(const bf16* __restrict__ kpe, bf16* __restrict__ K) {
    const int i = blockIdx.x * 256 + threadIdx.x; if (i >= NT * NH * 32) return;
    const int j = i & 31, h = (i >> 5) & 7, t = i >> 8, b = t >> 12, s = t & 4095;
    K[(((size_t)(b * NH + h)) * NS + s) * QKD + 64 + j] = kpe[t * 32 + j];
}
__global__ void __launch_bounds__(256) n_fnet_ch(const bf16* __restrict__ uf, bf16* __restrict__ ucs) {
    const int s = blockIdx.x * 256 + threadIdx.x, j = blockIdx.y, b = blockIdx.z, g = j >> 6, jj = j & 63, t = b * NS + s;
    float uc = 0.f, us = 0.f;
    for (int c = 0; c < 64; ++c) { const float fr = (float)((c * jj) & 63) * (1.f / 64.f); const float u = bf2f(uf[(size_t)t * 512 + g * 64 + c]);
        uc += u * __builtin_amdgcn_cosf(fr); us += u * __builtin_amdgcn_sinf(fr); }
    ucs[((size_t)(b * 512 + j)) * 8192 + s] = f2bf(uc); ucs[((size_t)(b * 512 + j)) * 8192 + 4096 + s] = f2bf(us);
}
__global__ void __launch_bounds__(256) n_attn(const bf16* __restrict__ Q, const bf16* __restrict__ K, const bf16* __restrict__ V, bf16* __restrict__ ocat) {
    __shared__ float Ks[32][96];
    __shared__ float Vs[32][64];
    const int tid = threadIdx.x, b = blockIdx.z, h = blockIdx.y, s = blockIdx.x * 256 + tid;
    const size_t bh = (size_t)(b * NH + h) * NS;
    float q[96], o[64];
#pragma unroll
    for (int d = 0; d < 96; ++d) q[d] = bf2f(Q[(bh + s) * QKD + d]);
#pragma unroll
    for (int d = 0; d < 64; ++d) o[d] = 0.f;
    float m = -1e30f, l = 0.f;
    for (int kt = 0; kt < NS / 32; ++kt) {
        __syncthreads();
        for (int i = tid; i < 32 * 96; i += 256) Ks[i / 96][i % 96] = bf2f(K[(bh + kt * 32) * QKD + i]);
        for (int i = tid; i < 32 * 64; i += 256) Vs[i >> 6][i & 63] = bf2f(V[(bh + kt * 32) * VH + i]);
        __syncthreads();
        for (int j = 0; j < 32; ++j) {
            float sc = 0.f;
#pragma unroll
            for (int d = 0; d < 96; ++d) sc += q[d] * Ks[j][d];
            if (sc > m) { const float a = __expf(m - sc); l *= a;
#pragma unroll
                for (int d = 0; d < 64; ++d) o[d] *= a;
                m = sc; }
            const float p = __expf(sc - m); l += p;
#pragma unroll
            for (int d = 0; d < 64; ++d) o[d] += p * Vs[j][d];
        }
    }
    const float inv = 1.f / l;
#pragma unroll
    for (int d = 0; d < 64; ++d) ocat[((size_t)(b * NS + s)) * DM + h * 64 + d] = f2bf(o[d] * inv);
}
__global__ void __launch_bounds__(256) n_conv(const bf16* __restrict__ pc, const float* __restrict__ cw, bf16* __restrict__ yc) {
    const int i = blockIdx.x * 256 + threadIdx.x; if (i >= NT * DM) return;
    const int t = i >> 10, c = i & 1023, s = t & 4095;
    const bf16* row = pc + (size_t)t * 3072;
    const float u1 = bf2f(row[1024 + c]) * bf2f(row[2048 + c]);
    const float u0 = (s > 0) ? bf2f(row[1024 + c - 3072]) * bf2f(row[2048 + c - 3072]) : 0.f;
    const float u2 = (s < NS - 1) ? bf2f(row[1024 + c + 3072]) * bf2f(row[2048 + c + 3072]) : 0.f;
    const float y = u0 * cw[c] + u1 * cw[1024 + c] + u2 * cw[2048 + c];
    yc[i] = f2bf(bf2f(row[c]) * y);
}

#endif
#define GAS __attribute__((address_space(1)))
#define LAS __attribute__((address_space(3)))
typedef unsigned v4u __attribute__((ext_vector_type(4)));
typedef unsigned v2u __attribute__((ext_vector_type(2)));
typedef float f32x4 __attribute__((ext_vector_type(4)));
typedef float f32x2 __attribute__((ext_vector_type(2)));
typedef short bf16x8 __attribute__((ext_vector_type(8)));
typedef short bf16x16 __attribute__((ext_vector_type(16)));
typedef float f32x16 __attribute__((ext_vector_type(16)));
typedef short s16x4 __attribute__((ext_vector_type(4)));
typedef GAS unsigned gu32;
#define RLX_AGENT __ATOMIC_RELAXED, __HIP_MEMORY_SCOPE_AGENT
#define LDS_WAIT() asm volatile("s_waitcnt lgkmcnt(0)" ::: "memory")
#define VM_WAIT() asm volatile("s_waitcnt vmcnt(0)" ::: "memory")

constexpr int NWAVES = 8;
constexpr int SCR_BYTES = 151552;
constexpr int MISC_OFF = SCR_BYTES;
constexpr int LDS_BYTES = 155648;

constexpr size_t WS_WIN = 528 * MiB, WS_WUQ = 530 * MiB, WS_WUKV = 531 * MiB, WS_WOUT0 = 532 * MiB, WS_WCIN = 534 * MiB, WS_WCOUT = 540 * MiB, WS_CST = 542 * MiB;
constexpr size_t WS_WUP = 544 * MiB, WS_WDN = 800 * MiB, WS_H8 = 928 * MiB, WS_END2 = 944 * MiB;
#ifndef MOE_FP8
#define MOE_FP8 1
#endif
typedef int v8i __attribute__((ext_vector_type(8)));
typedef int v4i __attribute__((ext_vector_type(4)));
constexpr int CW_BAR = 4096;

__device__ __forceinline__ unsigned pk2(float lo, float hi) { return (unsigned)f2bf(lo) | ((unsigned)f2bf(hi) << 16); }
typedef __bf16 bf16x2_t __attribute__((ext_vector_type(2)));
__device__ __forceinline__ unsigned cvt_pk_bf16(float lo, float hi) { f32x2 v = {lo, hi}; bf16x2_t b = __builtin_convertvector(v, bf16x2_t); return __builtin_bit_cast(unsigned, b); }

#define XB_TMO      128
#define XB_XCNT(j)  (256  + 64 * (j))
#define XB_XSUB(j)  (1280 + 64 * (j))
#define XB_XGEN(j)  (2304 + 64 * (j))
#define XB_TOP      3328
#define XB_TOPGEN   3392
#define XCD_BAR_WORDS 3456
#define XB_SPIN_CAP (1u << 20)
__device__ __forceinline__ unsigned xb_ld(unsigned* p)              { return __hip_atomic_load(p, __ATOMIC_RELAXED, __HIP_MEMORY_SCOPE_AGENT); }
__device__ __forceinline__ unsigned xb_add(unsigned* p, unsigned v) { return __hip_atomic_fetch_add(p, v, __ATOMIC_RELAXED, __HIP_MEMORY_SCOPE_AGENT); }
__device__ __forceinline__ unsigned xb_xcc_id() { return (unsigned)__builtin_amdgcn_s_getreg((3 << 11) | 20) & 0xFu; }
#define XB_SPIN(cond, bar) do { unsigned _sp = 0; while (cond) { __builtin_amdgcn_s_sleep(1); \
    if ((++_sp & 255u) == 0u) { if (xb_ld(&(bar)[XB_TMO])) break; if (_sp > XB_SPIN_CAP) { atomicAdd(&(bar)[XB_TMO], 1u); break; } } } } while (0)
struct XcdBarrier { unsigned* bar; unsigned x; volatile LAS unsigned* st; };
__device__ __forceinline__ XcdBarrier xcd_barrier_post(unsigned* bar, volatile LAS unsigned* st) {
    XcdBarrier b; b.bar = bar; b.x = xb_xcc_id(); b.st = st;
    if (threadIdx.x == 0) (void)xb_add(&bar[XB_XCNT(b.x)], 1u);
    return b;
}
__device__ __forceinline__ void xcd_barrier_complete(unsigned* bar, unsigned x, unsigned& nloc, unsigned& nx) {
    const unsigned G = gridDim.x * gridDim.y * gridDim.z;
    unsigned sum, cnt, mine, sp = 0u;
    for (;;) {
        sum = 0u; cnt = 0u; mine = 0u;
#pragma unroll
        for (unsigned j = 0; j < 16; ++j) { const unsigned c = xb_ld(&bar[XB_XCNT(j)]); sum += c; cnt += (c > 0u) ? 1u : 0u; mine = (j == x) ? c : mine; }
        if (sum == G) break;
        __builtin_amdgcn_s_sleep(1);
        if ((++sp & 255u) == 0u) { if (xb_ld(&bar[XB_TMO])) break; if (sp > XB_SPIN_CAP) { atomicAdd(&bar[XB_TMO], 1u); break; } }
    }
    nloc = mine > 0u ? mine : 1u; nx = cnt > 0u ? cnt : 1u;
}
__device__ __forceinline__ void xcd_barrier(const XcdBarrier& b) {
    asm volatile("s_waitcnt vmcnt(0)" ::: "memory");
    __syncthreads();
    if (threadIdx.x == 0) {
        unsigned* bar = b.bar;
        __builtin_amdgcn_s_waitcnt(0);
        unsigned nloc = b.st[0], nx = b.st[1];
        if (nloc == 0u) { xcd_barrier_complete(bar, b.x, nloc, nx); b.st[0] = nloc; b.st[1] = nx; }
        const unsigned old = xb_add(&bar[XB_XSUB(b.x)], 1u);
        const unsigned gen = old / nloc;
        if (old + 1u == (gen + 1u) * nloc) {
            __builtin_amdgcn_fence(__ATOMIC_RELEASE, "agent");
            asm volatile("s_waitcnt vmcnt(0)" ::: "memory");
            const unsigned og = xb_add(&bar[XB_TOP], 1u);
            const unsigned tg = og / nx;
            if (og + 1u == (tg + 1u) * nx) xb_add(&bar[XB_TOPGEN], 1u);
            else XB_SPIN(xb_ld(&bar[XB_TOPGEN]) == tg, bar);
            __builtin_amdgcn_fence(__ATOMIC_ACQUIRE, "agent");
            xb_add(&bar[XB_XGEN(b.x)], 1u);
            asm volatile("s_waitcnt vmcnt(0)" ::: "memory");
        } else {
            XB_SPIN(xb_ld(&bar[XB_XGEN(b.x)]) == gen, bar);
            __builtin_amdgcn_fence(__ATOMIC_ACQUIRE, "agent");
            asm volatile("s_waitcnt vmcnt(0)" ::: "memory");
        }
    }
    __syncthreads();
}

namespace pg8 {
constexpr int BM = 256, BK = 64, HALF = 128, HTB = HALF * BK * 2, STAGE_BYTES = 8 * HTB, NXCD = 8, WGM = 8;
__host__ __device__ __forceinline__ int lds_byte(int r, int c) { const int st = (r >> 4) * 2 + (c >> 5), rr = r & 15, cc = c & 31, ob = rr * 64 + cc * 2; return st * 1024 + (ob ^ (((ob >> 9) & 1) << 5)); }
__host__ __device__ __forceinline__ void stage_rc(int b, int& R, int& C) { const int st = b / 1024, sb = b % 1024, swz = sb ^ (((sb >> 9) & 1) << 5); R = (st >> 1) * 16 + swz / 64; C = (st & 1) * 32 + (swz % 64) / 2; }
__host__ __device__ __forceinline__ int perm32(int rho) { const int n = rho >> 4, i = rho & 15; return 8 * (i >> 2) + 4 * n + (i & 3); }

struct Unit { int pm, pn, e, nvalid, local, halfm, roff, rbase; };

struct DenseSched {
    const char* A; const char* B; int K; int nM, nN, nwg, G, c;
    __device__ void init(const void* A_, const void* B_, int M, int N, int K_, int G_, int c_) { A = (const char*)A_; B = (const char*)B_; K = K_; nM = M / BM; nN = N / BM; nwg = nM * nN; G = G_; c = c_; }
    __device__ bool next(int i, Unit& u) const {
        const long L = (long)i * G + c; if (L >= nwg) return false;
        int wgid = (int)L; { const int q = nwg / NXCD, r = nwg % NXCD, xcd = wgid % NXCD, off = wgid / NXCD; wgid = (xcd < r ? xcd * (q + 1) : r * (q + 1) + (xcd - r) * q) + off; }
        const int nig = WGM * nN, gid = wgid / nig, fm = gid * WGM, gsz = (nM - fm) < WGM ? (nM - fm) : WGM;
        u.pm = fm + ((wgid % nig) % gsz); u.pn = (wgid % nig) / gsz; u.e = 0; u.nvalid = 256; u.local = 0; u.halfm = 0; u.roff = 0; u.rbase = u.pm * BM; return true;
    }
    __device__ __forceinline__ const char* aptr(const Unit& u) const { return A + (size_t)u.pm * BM * K * 2; }
    __device__ __forceinline__ const char* bptr(const Unit& u) const { return B + (size_t)u.pn * BM * K * 2; }
    __device__ __forceinline__ const int* rows(const Unit&) const { return nullptr; }
};
struct ListSched {
    const char* A; const char* B; int K, nN, first, count, halfm;
    __device__ bool next(int i, Unit& u) const {
        if (i >= count) return false; const int idx = first + i;
        u.pm = idx / nN; u.pn = idx % nN; u.e = 0; u.nvalid = 256; u.local = 0; u.halfm = halfm; u.roff = 0; u.rbase = u.pm * (halfm ? HALF : BM); return true;
    }
    __device__ __forceinline__ const char* aptr(const Unit& u) const { return A + (size_t)u.pm * (halfm ? HALF : BM) * K * 2; }
    __device__ __forceinline__ const char* bptr(const Unit& u) const { return B + (size_t)u.pn * BM * K * 2; }
    __device__ __forceinline__ const int* rows(const Unit&) const { return nullptr; }
};
struct MoeSched {
    const LAS int* poff; const char* A; const char* B; const int* list; const unsigned* cnt; int npn, G, vcu; size_t bexp; bool gather; int rb;
    __device__ bool next(int i, Unit& u) const {
        const int MT = __builtin_amdgcn_readfirstlane(poff[32]) >> 8, total = MT * npn, nfull = (total / G) * G;
        int L = i * G + vcu, half = 0, hm = 0;
        if (L >= nfull) {
            const int hidx = L - nfull; if (hidx >= 2 * (total - nfull)) return false;
            L = nfull + (hidx >> 1); half = hidx & 1; hm = 1; }
        const int pm = L / npn, pn = L % npn, row0 = pm << 8;
        int e = 0;
        for (int j = 1; j < 32; ++j) e = (poff[j] <= row0) ? j : e;
        e = __builtin_amdgcn_readfirstlane(e);
        u.pm = pm; u.pn = pn; u.e = e; u.halfm = hm; u.roff = half * HALF; u.rbase = row0 + half * HALF;
        const int local = row0 - __builtin_amdgcn_readfirstlane(poff[e]), left = __builtin_amdgcn_readfirstlane((int)cnt[e]) - local;
        u.nvalid = left < 256 ? left : 256; u.local = local;
        return true;
    }
    __device__ __forceinline__ const char* aptr(const Unit& u) const { return gather ? A : A + (size_t)u.rbase * rb; }
    __device__ __forceinline__ const char* bptr(const Unit& u) const { return B + (size_t)u.e * bexp + (size_t)u.pn * BM * rb; }
    __device__ __forceinline__ const int* rows(const Unit& u) const { return list + (size_t)u.e * NT + u.local; }
};

template <class Epi, class Sched, bool GATHER, bool ALIGN_EPI, bool F8 = false>
__device__ __forceinline__ void gemm_phase(LAS unsigned char* lds, const int RB  , const Sched& S, const Epi& E) {
    int tid = threadIdx.x; asm volatile("" : "+v"(tid));
    const int wid = __builtin_amdgcn_readfirstlane(tid >> 6), lane = tid & 63, wr = wid >> 2, wc = wid & 3, fr = lane & 15, fq = lane >> 4;
    const int nt = RB / (BK * 2);
    LAS v2u* tbl = (LAS v2u*)(lds + STAGE_BYTES) + tid;
    { v2u ob;
#pragma unroll
      for (int i = 0; i < 2; ++i) { int R, C; stage_rc(tid * 16 + i * 8192, R, C); const int Rb = Epi::PERM ? ((R & ~31) + perm32(R & 31)) : R; ob[i] = (unsigned)(Rb * RB + C * 2); }
      tbl[0] = ob; }
    const size_t kstep = (size_t)(BK * 2);
    const size_t hstepB = (size_t)HALF * RB;
    const unsigned ldsw = (unsigned)wid * 1024u;
    const int aoff = lds_byte(wr * 64 + fr, fq * 8), boff = lds_byte(wc * 32 + fr, fq * 8);
#define PG8_SA(b, h) (((b) * 2 + (h)) * HTB)
#define PG8_SB(b, h) ((4 + (b) * 2 + (h)) * HTB)
#define PG8_STAGE_T(bufoff, gbase, k) do { const v2u _o = tbl[(k) * 512]; \
        __builtin_amdgcn_global_load_lds((const unsigned*)((const char*)(gbase) + _o.x), (LAS unsigned*)(lds + (bufoff) + ldsw), 16, 0, 0); \
        __builtin_amdgcn_global_load_lds((const unsigned*)((const char*)(gbase) + _o.y), (LAS unsigned*)(lds + (bufoff) + ldsw + 8192), 16, 0, 0); } while (0)
#define PG8_STAGE_A(bufoff, gbase, k) PG8_STAGE_T(bufoff, gbase, k)
#define PG8_STAGE_B(bufoff, gbase) PG8_STAGE_T(bufoff, gbase, 0)
#define PG8_SETV(kb, u) do { int _t = tid; asm volatile("" : "+v"(_t));   _Pragma("unroll") for (int _h = 0; _h < 2; ++_h) { v2u _o; _Pragma("unroll") for (int _i = 0; _i < 2; ++_i) { int _R, _C; stage_rc(_t * 16 + _i * 8192, _R, _C); const int _r = _R + 128 * _h; \
        if constexpr (GATHER) { const int _rq = _r + (u).roff, _rr = _rq < (u).nvalid ? _rq : (u).nvalid - 1; _o[_i] = (unsigned)S.rows(u)[_rr] * (unsigned)RB + (unsigned)_C * 2u; } \
        else _o[_i] = (unsigned)(_r * RB) + (unsigned)_C * 2u; } tbl[((kb) + _h) * 512] = _o; } } while (0)
#define PG8_LDA(dst, b, h) do { _Pragma("unroll") for (int m = 0; m < 4; ++m) _Pragma("unroll") for (int k = 0; k < 2; ++k) dst[m][k] = *(const LAS v4i*)(lds + PG8_SA(b, h) + aoff + m * 2048 + k * 1024); } while (0)
#define PG8_LDB(dst, b, h) do { _Pragma("unroll") for (int n = 0; n < 2; ++n) _Pragma("unroll") for (int k = 0; k < 2; ++k) dst[n][k] = *(const LAS v4i*)(lds + PG8_SB(b, h) + boff + n * 2048 + k * 1024); } while (0)
#define PG8_CAT(x) __builtin_shufflevector(x[0], x[1], 0, 1, 2, 3, 4, 5, 6, 7)
#define PG8_MMA(ai, bj, At, Bt) do { __builtin_amdgcn_s_setprio(1); _Pragma("unroll") for (int m = 0; m < 4; ++m) _Pragma("unroll") for (int n = 0; n < 2; ++n) { \
        if constexpr (F8) acc[ai][bj][m][n] = __builtin_amdgcn_mfma_scale_f32_16x16x128_f8f6f4(PG8_CAT(Bt[n]), PG8_CAT(At[m]), acc[ai][bj][m][n], 0, 0, 0, 0, 0, 0);   \
        else { _Pragma("unroll") for (int k = 0; k < 2; ++k) acc[ai][bj][m][n] = __builtin_amdgcn_mfma_f32_16x16x32_bf16(__builtin_bit_cast(bf16x8, Bt[n][k]), __builtin_bit_cast(bf16x8, At[m][k]), acc[ai][bj][m][n], 0, 0, 0); } } \
        __builtin_amdgcn_s_setprio(0); } while (0)
#define PG8_WAIT_V(n) asm volatile("s_waitcnt vmcnt(" #n ")" ::: "memory")
#define PG8_WAIT_L(n) asm volatile("s_waitcnt lgkmcnt(" #n ")" ::: "memory")
#define PG8_BAR __builtin_amdgcn_s_barrier()
#define PG8_SCHED __builtin_amdgcn_sched_barrier(0)
    Unit cur, nxt; int ui = 0;
    if (!S.next(0, cur)) return;
    f32x4 acc[2][2][4][2];
#pragma unroll
    for (int a = 0; a < 2; ++a)
#pragma unroll
        for (int b = 0; b < 2; ++b)
#pragma unroll
            for (int m = 0; m < 4; ++m)
#pragma unroll
                for (int n = 0; n < 2; ++n) acc[a][b][m][n] = (f32x4){0.f, 0.f, 0.f, 0.f};
    v4i At[4][2], B0[2][2], B1[2][2];
    const char* cA = S.aptr(cur); const char* cB = S.bptr(cur);
    PG8_SETV(1, cur);
    PG8_STAGE_B(PG8_SB(0, 0), cB); PG8_STAGE_B(PG8_SB(0, 1), cB + hstepB); PG8_STAGE_A(PG8_SA(0, 0), cA, 1); PG8_STAGE_A(PG8_SA(0, 1), cA, 2);
    if (wr == 1) PG8_BAR;
    PG8_WAIT_V(2); PG8_BAR;
    PG8_STAGE_B(PG8_SB(1, 0), cB + kstep); PG8_STAGE_A(PG8_SA(1, 0), cA + kstep, 1); PG8_STAGE_B(PG8_SB(1, 1), cB + hstepB + kstep);
    PG8_WAIT_V(6); PG8_BAR;
    for (;;) {
        const bool has_next = S.next(ui + 1, nxt);
        const char* nA = has_next ? S.aptr(nxt) : cA; const char* nB = has_next ? S.bptr(nxt) : cB;
        if (has_next) { PG8_SETV(3, nxt); } else { tbl[3 * 512] = tbl[1 * 512]; tbl[4 * 512] = tbl[2 * 512]; }
#pragma unroll 1
        for (int t = 0; t < nt; t += 2) {
            const bool last = (t == nt - 2);
            const char* a1 = cA + (size_t)(t + 1) * kstep;
            const char* a2 = last ? nA : cA + (size_t)(t + 2) * kstep; const char* b2 = last ? nB : cB + (size_t)(t + 2) * kstep;
            const char* a3 = a2 + kstep; const char* b3 = b2 + kstep;
            const int k2 = last ? 3 : 1;
            PG8_LDB(B0, 0, 0); PG8_LDB(B1, 0, 1); PG8_SCHED; PG8_LDA(At, 0, 0); PG8_STAGE_A(PG8_SA(1, 1), a1, 2);
            PG8_WAIT_V(8); PG8_WAIT_L(0); PG8_BAR; PG8_MMA(0, 0, At, B0); PG8_MMA(0, 1, At, B1); PG8_BAR; PG8_SCHED;
            PG8_LDA(At, 0, 1); PG8_STAGE_B(PG8_SB(0, 0), b2); PG8_STAGE_B(PG8_SB(0, 1), b2 + hstepB); PG8_STAGE_A(PG8_SA(0, 0), a2, k2);
            PG8_WAIT_V(8); PG8_WAIT_L(0); PG8_BAR; if (!cur.halfm) { PG8_MMA(1, 0, At, B0); PG8_MMA(1, 1, At, B1); } PG8_BAR; PG8_SCHED;
            PG8_LDB(B0, 1, 0); PG8_LDB(B1, 1, 1); PG8_SCHED; PG8_LDA(At, 1, 0); PG8_STAGE_A(PG8_SA(0, 1), a2, k2 + 1);
            PG8_WAIT_V(8); PG8_WAIT_L(0); PG8_BAR; PG8_MMA(0, 0, At, B0); PG8_MMA(0, 1, At, B1); PG8_BAR; PG8_SCHED;
            PG8_LDA(At, 1, 1); PG8_STAGE_B(PG8_SB(1, 0), b3); PG8_STAGE_B(PG8_SB(1, 1), b3 + hstepB); PG8_STAGE_A(PG8_SA(1, 0), a3, k2);
            PG8_WAIT_V(8); PG8_WAIT_L(0); PG8_BAR; if (!cur.halfm) { PG8_MMA(1, 0, At, B0); PG8_MMA(1, 1, At, B1); } PG8_BAR; PG8_SCHED;
        }
        if constexpr (ALIGN_EPI) { if (wr == 0) PG8_BAR; }
        { int te = threadIdx.x; asm volatile("" : "+v"(te));
          E(acc, cur, wr, wc, te & 15, (te & 63) >> 4); }
        if (!has_next) break;
#pragma unroll
        for (int a = 0; a < 2; ++a)
#pragma unroll
            for (int b = 0; b < 2; ++b)
#pragma unroll
                for (int m = 0; m < 4; ++m)
#pragma unroll
                    for (int n = 0; n < 2; ++n) acc[a][b][m][n] = (f32x4){0.f, 0.f, 0.f, 0.f};
        cur = nxt; cA = nA; cB = nB; ++ui;
        tbl[1 * 512] = tbl[3 * 512]; tbl[2 * 512] = tbl[4 * 512];
        if constexpr (ALIGN_EPI) { if (wr == 1) PG8_BAR; }
    }
    PG8_WAIT_V(0);
    if constexpr (!ALIGN_EPI) { if (wr == 0) PG8_BAR; }
    PG8_BAR;
#undef PG8_SA
#undef PG8_SB
#undef PG8_STAGE_T
#undef PG8_STAGE_A
#undef PG8_STAGE_B
#undef PG8_SETV
#undef PG8_LDA
#undef PG8_LDB
#undef PG8_MMA
#undef PG8_CAT
#undef PG8_WAIT_V
#undef PG8_WAIT_L
#undef PG8_BAR
#undef PG8_SCHED
}

typedef const f32x4 (&AccRef)[2][2][4][2];
struct EpiOutF32 {
    static constexpr bool PERM = true; float* O; int ldc; int pad;
    __device__ __forceinline__ void operator()(AccRef acc, const Unit& u, int wr, int wc, int fr, int fq) const {
        const int row0 = u.rbase + wr * 64 + fr, col0 = u.pn * BM + wc * 32 + 8 * fq;
#pragma unroll
        for (int ai = 0; ai < 2; ++ai)
#pragma unroll
            for (int m = 0; m < 4; ++m) { float* rowp = O + (size_t)(row0 + ai * HALF + m * 16) * ldc + col0;
#pragma unroll
                for (int bj = 0; bj < 2; ++bj) { *(f32x4*)(rowp + bj * HALF) = acc[ai][bj][m][0]; *(f32x4*)(rowp + bj * HALF + 4) = acc[ai][bj][m][1]; } }
    }
};
struct EpiOutBf {
    static constexpr bool PERM = true; bf16* O; int ldc; int fnet; float scale;
    __device__ __forceinline__ void operator()(AccRef acc, const Unit& u, int wr, int wc, int fr, int fq) const {
        const int row0 = u.rbase + wr * 64 + fr; bf16* base; int colt;
        if (fnet) { const int b = u.pn >> 1; base = O + (size_t)b * NS * DM + 512; colt = (u.pn & 1) * 256; }
        else { base = O; colt = u.pn * BM; }
        const int col0 = colt + wc * 32 + 8 * fq;
#pragma unroll
        for (int ai = 0; ai < 2; ++ai) { if (ai == 1 && u.halfm) break;
#pragma unroll
            for (int m = 0; m < 4; ++m) { bf16* rowp = base + (size_t)(row0 + ai * HALF + m * 16) * ldc + col0;
#pragma unroll
                for (int bj = 0; bj < 2; ++bj) { const f32x4 v0 = acc[ai][bj][m][0] * scale, v1 = acc[ai][bj][m][1] * scale;
                    v4u w; w.x = cvt_pk_bf16(v0[0], v0[1]); w.y = cvt_pk_bf16(v0[2], v0[3]); w.z = cvt_pk_bf16(v1[0], v1[1]); w.w = cvt_pk_bf16(v1[2], v1[3]);
                    *(v4u*)(rowp + bj * HALF) = w; } } }
    }
};
struct EpiConv {
    static constexpr bool PERM = true; bf16* gb; bf16* uu;
    __device__ __forceinline__ void operator()(AccRef acc, const Unit& u, int wr, int wc, int fr, int fq) const {
        const int row0 = u.rbase + wr * 64 + fr;
        if (u.pn < 4) { const int col0 = u.pn * BM + wc * 32 + 8 * fq;
#pragma unroll
            for (int ai = 0; ai < 2; ++ai)
#pragma unroll
                for (int m = 0; m < 4; ++m) { bf16* rowp = gb + (size_t)(row0 + ai * HALF + m * 16) * DM + col0;
#pragma unroll
                    for (int bj = 0; bj < 2; ++bj) { const f32x4 v0 = acc[ai][bj][m][0], v1 = acc[ai][bj][m][1];
                        v4u w; w.x = cvt_pk_bf16(v0[0], v0[1]); w.y = cvt_pk_bf16(v0[2], v0[3]); w.z = cvt_pk_bf16(v1[0], v1[1]); w.w = cvt_pk_bf16(v1[2], v1[3]);
                        *(v4u*)(rowp + bj * HALF) = w; } }
        } else { const int col0 = (u.pn - 4) * 128 + wc * 32 + 8 * fq;
#pragma unroll
            for (int ai = 0; ai < 2; ++ai)
#pragma unroll
                for (int m = 0; m < 4; ++m) { const f32x4 v0 = acc[ai][0][m][0] * acc[ai][1][m][0], v1 = acc[ai][0][m][1] * acc[ai][1][m][1];
                    v4u w; w.x = cvt_pk_bf16(v0[0], v0[1]); w.y = cvt_pk_bf16(v0[2], v0[3]); w.z = cvt_pk_bf16(v1[0], v1[1]); w.w = cvt_pk_bf16(v1[2], v1[3]);
                    *(v4u*)(uu + (size_t)(row0 + ai * HALF + m * 16) * DM + col0) = w; }
        }
    }
};
struct EpiG1 {
    static constexpr bool PERM = false; bf16* cq; bf16* ckv; bf16* kpe; bf16* uf; const float* rope;
    __device__ __forceinline__ void operator()(AccRef acc, const Unit& u, int wr, int wc, int fr, int fq) const {
        const int row0 = u.rbase + wr * 64 + fr;
#pragma unroll
        for (int ai = 0; ai < 2; ++ai)
#pragma unroll
            for (int m = 0; m < 4; ++m) { const int row = row0 + ai * HALF + m * 16;
#pragma unroll
                for (int bj = 0; bj < 2; ++bj) {
                    if (u.pn == 1 && bj == 1) {
                        if (wc == 0) { const f32x4 t1 = acc[ai][1][m][0], t2 = acc[ai][1][m][1];
                            const f32x4 cs = *(const f32x4*)(rope + (size_t)row * 16 + 4 * fq), sn = *(const f32x4*)(rope + (size_t)NT * 16 + (size_t)row * 16 + 4 * fq);
                            v2u w1, w2; w1.x = cvt_pk_bf16(t1[0] * cs[0] - t2[0] * sn[0], t1[1] * cs[1] - t2[1] * sn[1]); w1.y = cvt_pk_bf16(t1[2] * cs[2] - t2[2] * sn[2], t1[3] * cs[3] - t2[3] * sn[3]);
                            w2.x = cvt_pk_bf16(t2[0] * cs[0] + t1[0] * sn[0], t2[1] * cs[1] + t1[1] * sn[1]); w2.y = cvt_pk_bf16(t2[2] * cs[2] + t1[2] * sn[2], t2[3] * cs[3] + t1[3] * sn[3]);
                            *(v2u*)(kpe + (size_t)row * 32 + 4 * fq) = w1; *(v2u*)(kpe + (size_t)row * 32 + 16 + 4 * fq) = w2; }
                    } else {
#pragma unroll
                        for (int n = 0; n < 2; ++n) { const f32x4 v = acc[ai][bj][m][n]; v2u w; w.x = cvt_pk_bf16(v[0], v[1]); w.y = cvt_pk_bf16(v[2], v[3]);
                            const int ct = bj * HALF + wc * 32 + 16 * n + 4 * fq;
                            bf16* p;
                            if (u.pn == 0) p = cq + (size_t)row * 256 + ct;
                            else if (u.pn == 1) p = ckv + (size_t)row * 128 + ct;
                            else p = uf + (size_t)row * 512 + (u.pn - 2) * 256 + ct;
                            *(v2u*)p = w; }
                    } } }
    }
};
struct EpiUp {
    static constexpr bool PERM = true; bf16* aact; const float* bg; const float* bl;
    __device__ __forceinline__ void operator()(AccRef acc, const Unit& u, int wr, int wc, int fr, int fq) const {
        const int row0 = u.rbase + wr * 64 + fr, col0 = u.pn * 128 + wc * 32 + 8 * fq;
        const float* pg = bg + (size_t)u.e * DM + col0; const float* pl = bl + (size_t)u.e * DM + col0;
        const f32x4 g0 = *(const f32x4*)pg, g1 = *(const f32x4*)(pg + 4), l0 = *(const f32x4*)pl, l1 = *(const f32x4*)(pl + 4);
#pragma unroll
        for (int ai = 0; ai < 2; ++ai)
#pragma unroll
            for (int m = 0; m < 4; ++m) { const f32x4 a0 = acc[ai][0][m][0] + g0, a1 = acc[ai][0][m][1] + g1, b0 = acc[ai][1][m][0] + l0, b1 = acc[ai][1][m][1] + l1;
                v4u w; w.x = cvt_pk_bf16(swiglu(a0[0], b0[0]), swiglu(a0[1], b0[1])); w.y = cvt_pk_bf16(swiglu(a0[2], b0[2]), swiglu(a0[3], b0[3]));
                w.z = cvt_pk_bf16(swiglu(a1[0], b1[0]), swiglu(a1[1], b1[1])); w.w = cvt_pk_bf16(swiglu(a1[2], b1[2]), swiglu(a1[3], b1[3]));
                *(v4u*)(aact + (size_t)(row0 + ai * HALF + m * 16) * DM + col0) = w; }
    }
};
struct EpiDown {
    static constexpr bool PERM = true; bf16* y; const float* bd;
    __device__ __forceinline__ void operator()(AccRef acc, const Unit& u, int wr, int wc, int fr, int fq) const {
        const int row0 = u.rbase + wr * 64 + fr, col0 = u.pn * BM + wc * 32 + 8 * fq;
#pragma unroll
        for (int bj = 0; bj < 2; ++bj) { const float* pb = bd + (size_t)u.e * DM + col0 + bj * HALF; const f32x4 c0 = *(const f32x4*)pb, c1 = *(const f32x4*)(pb + 4);
#pragma unroll
            for (int ai = 0; ai < 2; ++ai)
#pragma unroll
                for (int m = 0; m < 4; ++m) { const f32x4 v0 = acc[ai][bj][m][0] + c0, v1 = acc[ai][bj][m][1] + c1;
                    v4u w; w.x = cvt_pk_bf16(v0[0], v0[1]); w.y = cvt_pk_bf16(v0[2], v0[3]); w.z = cvt_pk_bf16(v1[0], v1[1]); w.w = cvt_pk_bf16(v1[2], v1[3]);
                    *(v4u*)(y + (size_t)(row0 + ai * HALF + m * 16) * DM + col0 + bj * HALF) = w; } }
    }
};
struct EpiUp8 {
    static constexpr bool PERM = true; unsigned char* aact; const float* bg; const float* bl;
    __device__ __forceinline__ void operator()(AccRef acc, const Unit& u, int wr, int wc, int fr, int fq) const {
        const int row0 = u.rbase + wr * 64 + fr, col0 = u.pn * 128 + wc * 32 + 8 * fq;
        const float* pg = bg + (size_t)u.e * DM + col0; const float* pl = bl + (size_t)u.e * DM + col0;
        const f32x4 g0 = *(const f32x4*)pg, g1 = *(const f32x4*)(pg + 4), l0 = *(const f32x4*)pl, l1 = *(const f32x4*)(pl + 4);
        constexpr float S = 1.f / 32.f;
#pragma unroll
        for (int ai = 0; ai < 2; ++ai) { if (ai == 1 && u.halfm) break;
#pragma unroll
            for (int m = 0; m < 4; ++m) { const f32x4 a0 = acc[ai][0][m][0] * S + g0, a1 = acc[ai][0][m][1] * S + g1, b0 = acc[ai][1][m][0] * S + l0, b1 = acc[ai][1][m][1] * S + l1;
                v2u w; w.x = pack_fp8x4(swiglu(a0[0], b0[0]), swiglu(a0[1], b0[1]), swiglu(a0[2], b0[2]), swiglu(a0[3], b0[3]));
                w.y = pack_fp8x4(swiglu(a1[0], b1[0]), swiglu(a1[1], b1[1]), swiglu(a1[2], b1[2]), swiglu(a1[3], b1[3]));
                *(v2u*)(aact + (size_t)(row0 + ai * HALF + m * 16) * DM + col0) = w; } }
    }
};
struct EpiDown8 {
    static constexpr bool PERM = true; bf16* y; const float* bd;
    __device__ __forceinline__ void operator()(AccRef acc, const Unit& u, int wr, int wc, int fr, int fq) const {
        const int row0 = u.rbase + wr * 64 + fr, col0 = u.pn * BM + wc * 32 + 8 * fq;
        constexpr float S = 1.f / 64.f;
#pragma unroll
        for (int bj = 0; bj < 2; ++bj) { const float* pb = bd + (size_t)u.e * DM + col0 + bj * HALF; const f32x4 c0 = *(const f32x4*)pb, c1 = *(const f32x4*)(pb + 4);
#pragma unroll
            for (int ai = 0; ai < 2; ++ai) { if (ai == 1 && u.halfm) break;
#pragma unroll
                for (int m = 0; m < 4; ++m) { const f32x4 v0 = acc[ai][bj][m][0] * S + c0, v1 = acc[ai][bj][m][1] * S + c1;
                    v4u w; w.x = cvt_pk_bf16(v0[0], v0[1]); w.y = cvt_pk_bf16(v0[2], v0[3]); w.z = cvt_pk_bf16(v1[0], v1[1]); w.w = cvt_pk_bf16(v1[2], v1[3]);
                    *(v4u*)(y + (size_t)(row0 + ai * HALF + m * 16) * DM + col0 + bj * HALF) = w; } } }
    }
};
}

__device__ __forceinline__ void tr_item(const float* __restrict__ W, int ldn, int K, int k0, int n0, bf16* __restrict__ WT, int drow0, const float* __restrict__ ks, LAS float* scr, int lane) {
    float v[32];
#pragma unroll
    for (int i = 0; i < 32; ++i) v[i] = __builtin_nontemporal_load(W + (size_t)(k0 + 2 * i + (lane >> 5)) * ldn + n0 + (lane & 31));
#pragma unroll
    for (int i = 0; i < 32; ++i) { const int kk = 2 * i + (lane >> 5); float x = v[i]; if (ks) x *= ks[k0 + kk]; scr[kk * 33 + (lane & 31)] = x; }
    LDS_WAIT(); asm volatile("" ::: "memory");
    const int c = lane & 7;
#pragma unroll
    for (int j = 0; j < 4; ++j) { const int n = (lane >> 3) + 8 * j; const LAS float* s = scr + (8 * c) * 33 + n;
        v4u o; o.x = pk2(s[0 * 33], s[1 * 33]); o.y = pk2(s[2 * 33], s[3 * 33]); o.z = pk2(s[4 * 33], s[5 * 33]); o.w = pk2(s[6 * 33], s[7 * 33]);
        *(v4u*)(WT + (size_t)(drow0 + n) * K + k0 + 8 * c) = o; }
    LDS_WAIT(); asm volatile("" ::: "memory");
}

__device__ __forceinline__ void tr_item8(const float* __restrict__ W, int ldn, int K, int k0, int n0, unsigned char* __restrict__ WT, int drow0, float scale, LAS float* scr, int lane) {
    float v[32];
#pragma unroll
    for (int i = 0; i < 32; ++i) v[i] = __builtin_nontemporal_load(W + (size_t)(k0 + 2 * i + (lane >> 5)) * ldn + n0 + (lane & 31));
#pragma unroll
    for (int i = 0; i < 32; ++i) { const int kk = 2 * i + (lane >> 5); scr[kk * 33 + (lane & 31)] = v[i] * scale; }
    LDS_WAIT(); asm volatile("" ::: "memory");
    const int c = lane & 3;
#pragma unroll
    for (int j = 0; j < 2; ++j) { const int n = (lane >> 2) + 16 * j; const LAS float* s = scr + (16 * c) * 33 + n;
        v4u o; o.x = pack_fp8x4(s[0 * 33], s[1 * 33], s[2 * 33], s[3 * 33]); o.y = pack_fp8x4(s[4 * 33], s[5 * 33], s[6 * 33], s[7 * 33]);
        o.z = pack_fp8x4(s[8 * 33], s[9 * 33], s[10 * 33], s[11 * 33]); o.w = pack_fp8x4(s[12 * 33], s[13 * 33], s[14 * 33], s[15 * 33]);
        *(v4u*)(WT + (size_t)(drow0 + n) * K + k0 + 16 * c) = o; }
    LDS_WAIT(); asm volatile("" ::: "memory");
}

struct FastArgs {
    const float* in[27];
    float* out; unsigned char* ws;
    int ph_lo, ph_hi, bar_region, pad;
};

constexpr int IT_WIN = 16 * 29, IT_WUQ = 4 * 24, IT_WUK = 2 * 16, IT_WUV = 2 * 16, IT_WOUT0 = 16 * 32, IT_WCIN = 16 * 96, IT_WCOUT = 16 * 32, IT_MOE = 64 * 512;
constexpr int IT_SMALL = IT_WIN + IT_WUQ + IT_WUK + IT_WUV + IT_WOUT0 + IT_WCIN + IT_WCOUT;
constexpr int IT_TOTAL = IT_SMALL + 3 * IT_MOE;

__device__ __forceinline__ void conv_item(const FastArgs& a, int it, LAS float* scr, int lane) {
    unsigned char* ws = a.ws;
    int r = it;
    if (r < IT_WIN) { const int kb = r / 29, nb = r % 29; tr_item(a.in[9], PROJ_A, 1024, kb * 64, nb * 32, (bf16*)(ws + WS_WIN), nb < 13 ? nb * 32 : nb * 32 + 96, nullptr, scr, lane); return; } r -= IT_WIN;
    if (r < IT_WUQ) { const int kb = r / 24, nb = r % 24; tr_item(a.in[12], 768, 256, kb * 64, nb * 32, (bf16*)(ws + WS_WUQ), nb * 32, a.in[10], scr, lane); return; } r -= IT_WUQ;
    if (r < IT_WUK) { const int kb = r / 16, nb = r % 16; tr_item(a.in[13], 512, 128, kb * 64, nb * 32, (bf16*)(ws + WS_WUKV), nb * 32, a.in[11], scr, lane); return; } r -= IT_WUK;
    if (r < IT_WUV) { const int kb = r / 16, nb = r % 16; tr_item(a.in[14], 512, 128, kb * 64, nb * 32, (bf16*)(ws + WS_WUKV), 512 + nb * 32, a.in[11], scr, lane); return; } r -= IT_WUV;
    if (r < IT_WOUT0) { const int kb = r / 32, nb = r % 32; tr_item(a.in[15], 1024, 1024, kb * 64, nb * 32, (bf16*)(ws + WS_WOUT0), nb * 32, nullptr, scr, lane); return; } r -= IT_WOUT0;
    if (r < IT_WCIN) { const int kb = r / 96, nb = r % 96, reg = nb >> 5, ch = (nb & 31) * 32;
        const int drow = (reg == 0) ? ch : 1024 + (ch >> 7) * 256 + (reg - 1) * 128 + (ch & 127);
        tr_item(a.in[16], 3072, 1024, kb * 64, nb * 32, (bf16*)(ws + WS_WCIN), drow, nullptr, scr, lane); return; } r -= IT_WCIN;
    if (r < IT_WCOUT) { const int kb = r / 32, nb = r % 32; tr_item(a.in[18], 1024, 1024, kb * 64, nb * 32, (bf16*)(ws + WS_WCOUT), nb * 32, nullptr, scr, lane); return; } r -= IT_WCOUT;
    const int which = r / IT_MOE; r -= which * IT_MOE;
    const int mat = r >> 9, rem = r & 511, kb = rem >> 5, nb = rem & 31;
    const float* src = a.in[which == 0 ? 21 : (which == 1 ? 23 : 25)] + (size_t)mat * DM * DM;
#if MOE_FP8
    if (which == 2) tr_item8(src, 1024, 1024, kb * 64, nb * 32, (unsigned char*)(ws + WS_WDN) + (size_t)mat * DM * DM, nb * 32, 64.f, scr, lane);
    else tr_item8(src, 1024, 1024, kb * 64, nb * 32, (unsigned char*)(ws + WS_WUP) + (size_t)mat * 2048 * DM, (nb >> 2) * 256 + which * 128 + (nb & 3) * 32, 32.f, scr, lane);
#else
    if (which == 2) tr_item(src, 1024, 1024, kb * 64, nb * 32, (bf16*)(ws + WS_WDN) + (size_t)mat * DM * DM, nb * 32, nullptr, scr, lane);
    else tr_item(src, 1024, 1024, kb * 64, nb * 32, (bf16*)(ws + WS_WUP) + (size_t)mat * 2048 * DM, (nb >> 2) * 256 + which * 128 + (nb & 3) * 32, nullptr, scr, lane);
#endif
}

__device__ __forceinline__ void mod_unit(const FastArgs& a, int unit, LAS float* lds, int tid) {
    LAS float* cond = lds; LAS float* part = lds + 4096;
    const float* c = a.in[1]; const float* ada_w = a.in[3]; const float* ada_b = a.in[4]; float* mod = (float*)(a.ws + WS_MOD);
    for (int i = tid; i < 4096; i += 512) { const float v = c[i]; cond[i] = v / (1.f + expf(-v)); }
    __syncthreads();
    const int l = unit >> 7, n0 = (unit & 127) * 48, ks = tid / 12, c4 = tid % 12;
    if (ks < 42) {
        f32x4 s0 = {0.f, 0.f, 0.f, 0.f}, s1 = s0, s2 = s0, s3 = s0;
        for (int k = ks; k < 1024; k += 42) { const f32x4 w = *(const f32x4*)(ada_w + ((size_t)l * 1024 + k) * 6144 + n0 + 4 * c4);
            s0 += w * cond[k]; s1 += w * cond[1024 + k]; s2 += w * cond[2048 + k]; s3 += w * cond[3072 + k]; }
        *(LAS f32x4*)(part + (ks * 4 + 0) * 48 + 4 * c4) = s0; *(LAS f32x4*)(part + (ks * 4 + 1) * 48 + 4 * c4) = s1;
        *(LAS f32x4*)(part + (ks * 4 + 2) * 48 + 4 * c4) = s2; *(LAS f32x4*)(part + (ks * 4 + 3) * 48 + 4 * c4) = s3;
    }
    __syncthreads();
    if (tid < 192) { const int b = tid / 48, col = tid % 48; float s = 0.f;
        for (int k = 0; k < 42; ++k) s += part[(k * 4 + b) * 48 + col];
        mod[(l * 4 + b) * 6144 + n0 + col] = s + ada_b[l * 6144 + n0 + col]; }
    __syncthreads();
}

__device__ __forceinline__ void p0_prologue(const FastArgs& a, LAS unsigned char* lds, int vcu, int G, int tid, int wave, int lane) {
    unsigned char* ws = a.ws;
    for (int u = vcu; u < 256; u += G) mod_unit(a, u, (LAS float*)lds, tid);
    { float* rope = (float*)(ws + WS_ROPE); const int* pos = (const int*)a.in[2];
      for (int i = vcu * 512 + tid; i < NT * 16; i += G * 512) { const int t = i >> 4, j = i & 15;
          const float inv = exp2f(-(float)j * (13.287712379549449f / 16.f)); const float ang = (float)pos[t] * inv;
          const double rev = (double)ang * 0.15915494309189535; const float fr = (float)(rev - rint(rev));
          rope[i] = __builtin_amdgcn_cosf(fr); rope[NT * 16 + i] = __builtin_amdgcn_sinf(fr); } }
    { bf16* cst = (bf16*)(ws + WS_CST);
      for (int i = vcu * 512 + tid; i < 128 * 64; i += G * 512) { const int n = i >> 6, c = i & 63; const float fr = (float)((c * (n & 63)) & 63) * (1.f / 64.f);
          cst[i] = f2bf(n < 64 ? __builtin_amdgcn_cosf(fr) : __builtin_amdgcn_sinf(fr)); } }
    { v4u* p = (v4u*)((bf16*)(ws + WS_WIN) + 416 * 1024); const v4u z = {0u, 0u, 0u, 0u};
      for (int i = vcu * 512 + tid; i < 96 * 1024 / 8; i += G * 512) p[i] = z; }
    { unsigned char* dm = (unsigned char*)(ws + WS_DMAT);
      for (int i = vcu * 512 + tid; i < 4096 * 8192 / 16; i += G * 512) { const int sp = i >> 9, k0 = (i & 511) * 16; unsigned w[4];
#pragma unroll
          for (int q = 0; q < 4; ++q) { float v[4];
#pragma unroll
              for (int e = 0; e < 4; ++e) { const int k = k0 + 4 * q + e, sq = k & 4095; const float fr = (float)((sp * sq) & 4095) * (1.f / 4096.f);
                  v[e] = (k < 4096) ? __builtin_amdgcn_cosf(fr) : -__builtin_amdgcn_sinf(fr); }
              w[q] = pack_fp8x4(v[0], v[1], v[2], v[3]); }
          v4u o = {w[0], w[1], w[2], w[3]}; *(v4u*)(dm + (size_t)i * 16) = o; } }
    { LAS float* scr = (LAS float*)(lds + wave * 16384);
      const int gw = vcu * NWAVES + wave, NGW = G * NWAVES;
      for (int it = gw; it < IT_SMALL; it += NGW) conv_item(a, it, scr, lane);
#if MOE_FP8
      float v[32], vn[32];
#define MOE_SRC(it_) ({ const int r_ = (it_) - IT_SMALL, wh_ = r_ / IT_MOE, q_ = r_ - wh_ * IT_MOE, mat_ = q_ >> 9, rem_ = q_ & 511; \
          a.in[wh_ == 0 ? 21 : (wh_ == 1 ? 23 : 25)] + (size_t)mat_ * DM * DM + (size_t)((rem_ >> 5) * 64 + (lane >> 5)) * DM + (rem_ & 31) * 32 + (lane & 31); })
      int it = IT_SMALL + ((G == 256) ? 2 * IT_MOE : 0) + gw;
      if (it < IT_TOTAL) { const float* sp = MOE_SRC(it);
#pragma unroll
          for (int i = 0; i < 32; ++i) v[i] = __builtin_nontemporal_load(sp + (size_t)(2 * i) * DM); }
      for (; it < IT_TOTAL; it += NGW) {
          const int nx = it + NGW;
          if (nx < IT_TOTAL) { const float* sp = MOE_SRC(nx);
#pragma unroll
              for (int i = 0; i < 32; ++i) vn[i] = __builtin_nontemporal_load(sp + (size_t)(2 * i) * DM); }
          const int r = it - IT_SMALL, which = r / IT_MOE, q = r - which * IT_MOE, mat = q >> 9, rem = q & 511, kb = rem >> 5, nb = rem & 31;
          const float scale = (which == 2) ? 64.f : 32.f;
          unsigned char* WT = (which == 2) ? (unsigned char*)(ws + WS_WDN) + (size_t)mat * DM * DM : (unsigned char*)(ws + WS_WUP) + (size_t)mat * 2048 * DM;
          const int drow0 = (which == 2) ? nb * 32 : (nb >> 2) * 256 + which * 128 + (nb & 3) * 32, k0 = kb * 64;
#pragma unroll
          for (int i = 0; i < 32; ++i) { const int kk = 2 * i + (lane >> 5); scr[kk * 33 + (lane & 31)] = v[i] * scale; }
          LDS_WAIT(); asm volatile("" ::: "memory");
          const int c = lane & 3;
#pragma unroll
          for (int j = 0; j < 2; ++j) { const int n = (lane >> 2) + 16 * j; const LAS float* sq = scr + (16 * c) * 33 + n;
              v4u o; o.x = pack_fp8x4(sq[0 * 33], sq[1 * 33], sq[2 * 33], sq[3 * 33]); o.y = pack_fp8x4(sq[4 * 33], sq[5 * 33], sq[6 * 33], sq[7 * 33]);
              o.z = pack_fp8x4(sq[8 * 33], sq[9 * 33], sq[10 * 33], sq[11 * 33]); o.w = pack_fp8x4(sq[12 * 33], sq[13 * 33], sq[14 * 33], sq[15 * 33]);
              *(v4u*)(WT + (size_t)(drow0 + n) * DM + k0 + 16 * c) = o; }
          LDS_WAIT(); asm volatile("" ::: "memory");
#pragma unroll
          for (int i = 0; i < 32; ++i) v[i] = vn[i];
      }
#undef MOE_SRC
#else
      for (int it = IT_SMALL + gw; it < IT_TOTAL; it += NGW) conv_item(a, it, scr, lane);
#endif
    }
}
namespace att {
constexpr int QBLK = 32, KVBLK = 64;
constexpr int SHM_V = KVBLK * 128 * 2, SHM_K = KVBLK * 128 * 2, SHM_ATTN = 2 * SHM_V + 2 * SHM_K + NWAVES * 64 * 4;
constexpr float THR = 8.f;
#define KSWZ(row, colB) ((row) * 256 + ((colB) ^ (((row) & 7) << 4)))
#define SBAR() __builtin_amdgcn_sched_barrier(0)
__device__ __forceinline__ int crow(int r, int hi) { return (r & 3) + 8 * (r >> 2) + 4 * hi; }
__device__ __forceinline__ unsigned cvtpk(float lo, float hi) { unsigned r; asm volatile("v_cvt_pk_bf16_f32 %0, %1, %2" : "=v"(r) : "v"(lo), "v"(hi)); return r; }
__device__ __forceinline__ bf16x8 ld8(const bf16* p) { return *reinterpret_cast<const bf16x8*>(p); }

__device__ __forceinline__ void partialSM(f32x16& p0, f32x16& p1, float& m_reg, float& mn, float& alpha) {
  constexpr float C = 1.4426950408889634f;
  float pmax = p0[0];
#pragma unroll
  for (int r = 1; r < 16; ++r) pmax = fmaxf(pmax, p0[r]);
#pragma unroll
  for (int r = 0; r < 16; ++r) pmax = fmaxf(pmax, p1[r]);
  { auto rr = __builtin_amdgcn_permlane32_swap(__float_as_uint(pmax), __float_as_uint(pmax), false, false);
    pmax = fmaxf(__uint_as_float(rr[0]), __uint_as_float(rr[1])); }
  if (__builtin_expect(__all(pmax - m_reg <= THR), 1)) { mn = m_reg; alpha = 1.f; }
  else { mn = fmaxf(m_reg, pmax); alpha = __builtin_amdgcn_exp2f((m_reg - mn) * C); m_reg = mn; }
  const float mnC = -mn * C;
#pragma unroll
  for (int r = 0; r < 16; ++r) p0[r] = fmaf(p0[r], C, mnC);
#pragma unroll
  for (int r = 0; r < 16; ++r) p1[r] = fmaf(p1[r], C, mnC);
#pragma unroll
  for (int r = 0; r < 16; ++r) p0[r] = __builtin_amdgcn_exp2f(p0[r]);
}
__device__ __forceinline__ void finishSM(f32x16& p0, f32x16& p1, float alpha, float& l_reg, bf16x8& pa0, bf16x8& pa1, bf16x8& pa2, bf16x8& pa3) {
#pragma unroll
  for (int r = 0; r < 16; ++r) p1[r] = __builtin_amdgcn_exp2f(p1[r]);
  float ps = 0;
#pragma unroll
  for (int r = 0; r < 16; ++r) ps += p0[r];
#pragma unroll
  for (int r = 0; r < 16; ++r) ps += p1[r];
  { auto rr = __builtin_amdgcn_permlane32_swap(__float_as_uint(ps), __float_as_uint(ps), false, false);
    ps = __uint_as_float(rr[0]) + __uint_as_float(rr[1]); }
  l_reg = l_reg * alpha + ps;
#define PK4(P, BASE, OUT) do { unsigned a0 = cvtpk(P[BASE + 0], P[BASE + 1]), a1 = cvtpk(P[BASE + 2], P[BASE + 3]);   \
    unsigned b0 = cvtpk(P[BASE + 4], P[BASE + 5]), b1 = cvtpk(P[BASE + 6], P[BASE + 7]);                              \
    auto r0 = __builtin_amdgcn_permlane32_swap(a0, b0, false, false); auto r1 = __builtin_amdgcn_permlane32_swap(a1, b1, false, false); \
    v4u w = {r0[0], r1[0], r0[1], r1[1]}; OUT = *reinterpret_cast<bf16x8*>(&w); } while (0)
  PK4(p0, 0, pa0); PK4(p0, 8, pa1); PK4(p1, 0, pa2); PK4(p1, 8, pa3);
#undef PK4
}
__device__ __forceinline__ void qkt(f32x16& p0, f32x16& p1, const bf16* Ks, const bf16x8* qr, int r32, int hi) {
  p0 = f32x16{}; p1 = f32x16{};
#pragma unroll
  for (int d0 = 0; d0 < 6; ++d0) { const int cb = (d0 * 16 + hi * 8) * 2;
    bf16x8 b0 = *reinterpret_cast<const bf16x8*>((const char*)Ks + KSWZ(r32, cb));
    bf16x8 b1 = *reinterpret_cast<const bf16x8*>((const char*)Ks + KSWZ(32 + r32, cb));
    p0 = __builtin_amdgcn_mfma_f32_32x32x16_bf16(b0, qr[d0], p0, 0, 0, 0);
    p1 = __builtin_amdgcn_mfma_f32_32x32x16_bf16(b1, qr[d0], p1, 0, 0, 0); }
}
__device__ __forceinline__ int v_st(int k, int c) { const int kk = (k & ~0xC) | ((k & 4) << 1) | ((k & 8) >> 1); return ((kk >> 3) * 4 + (c >> 5)) * 512 + ((kk & 7) * 32 + (c & 31)) * 2; }
__device__ __forceinline__ int v_rd_base(int lane) { return ((lane & 3) << 3) | (((lane >> 2) & 3) << 6) | (((lane >> 4) & 1) << 5) | (((lane >> 5) & 1) << 8); }
constexpr int v_rd_off(int d0, int ks, int half) { return d0 * 512 + ks * 4096 + half * 2048; }
template <int OFF> __device__ __forceinline__ s16x4 tr_read(int vb) {
  s16x4 r; asm volatile("ds_read_b64_tr_b16 %0, %1 offset:%2" : "=&v"(r) : "v"(vb), "i"(OFF) : "memory"); return r;
}
template <int D0> __device__ __forceinline__ void pv_one(f32x16& od, int vb, bf16x8 pa0, bf16x8 pa1, bf16x8 pa2, bf16x8 pa3) {
  const s16x4 l0 = tr_read<v_rd_off(D0, 0, 0)>(vb), h0 = tr_read<v_rd_off(D0, 0, 1)>(vb), l1 = tr_read<v_rd_off(D0, 1, 0)>(vb), h1 = tr_read<v_rd_off(D0, 1, 1)>(vb);
  const s16x4 l2 = tr_read<v_rd_off(D0, 2, 0)>(vb), h2 = tr_read<v_rd_off(D0, 2, 1)>(vb), l3 = tr_read<v_rd_off(D0, 3, 0)>(vb), h3 = tr_read<v_rd_off(D0, 3, 1)>(vb);
  asm volatile("s_waitcnt lgkmcnt(0)" ::: "memory"); SBAR();
#define PK(L, H) (bf16x8){L[0], L[1], L[2], L[3], H[0], H[1], H[2], H[3]}
  od = __builtin_amdgcn_mfma_f32_32x32x16_bf16(pa0, PK(l0, h0), od, 0, 0, 0);
  od = __builtin_amdgcn_mfma_f32_32x32x16_bf16(pa1, PK(l1, h1), od, 0, 0, 0);
  od = __builtin_amdgcn_mfma_f32_32x32x16_bf16(pa2, PK(l2, h2), od, 0, 0, 0);
  od = __builtin_amdgcn_mfma_f32_32x32x16_bf16(pa3, PK(l3, h3), od, 0, 0, 0);
#undef PK
}
__device__ __forceinline__ void pv_d0(f32x16* o, int vb, bf16x8 pa0, bf16x8 pa1, bf16x8 pa2, bf16x8 pa3) {
  pv_one<0>(o[0], vb, pa0, pa1, pa2, pa3); pv_one<1>(o[1], vb, pa0, pa1, pa2, pa3);
}
template <bool BG> __device__ __forceinline__ void attn_unit(const bf16* __restrict__ Qb, const bf16* __restrict__ Kh, const bf16* __restrict__ Vh, bf16* __restrict__ Ob, int ldo, int seq, char* lds, const float* bg_src0, const float* bg_src1, const float* bg_src2, unsigned char* bg_wup, unsigned char* bg_wdn, int& c_it, const int c_end) {
  int tid = threadIdx.x; asm volatile("" : "+v"(tid));
  const int wid = tid >> 6, lane = tid & 63, r32 = lane & 31, hi = lane >> 5;
  bf16* V_lds = (bf16*)lds; bf16* K_lds = (bf16*)(lds + 2 * SHM_V);
  float* ws = (float*)(lds + 2 * SHM_V + 2 * SHM_K) + wid * 64; float* li_l = ws; float* al_l = ws + 32;
  float m_reg = -1e30f, l_reg = 0; f32x16 o[2] = {}; bf16x8 qr[6];
  const bf16* Qw = Qb + (long)(wid * QBLK + r32) * QKD + hi * 8;
#pragma unroll
  for (int d0 = 0; d0 < 6; ++d0) qr[d0] = ld8(Qw + d0 * 16);
  const bool lowh = tid < 256;
  const int cA = tid, rA = cA / 12, qA = cA - rA * 12;
  const int cBk = 512 + (tid & 255), rBk = cBk / 12, qBk = cBk - rBk * 12, cBv = tid & 255, rBv = cBv >> 3, qBv = cBv & 7;
  const int cCv = lowh ? 256 + tid : (tid & 255), rCv = cCv >> 3, qCv = cCv & 7;
  const bf16* pA = Kh + (long)rA * QKD + qA * 8;
  const bf16* pB = lowh ? Kh + (long)rBk * QKD + qBk * 8 : Vh + (long)rBv * VH + qBv * 8; const int sB = lowh ? QKD : VH;
  const bf16* pC = Vh + (long)rCv * VH + qCv * 8;
  const int wA = 2 * SHM_V + KSWZ(rA, qA * 16), wB = lowh ? 2 * SHM_V + KSWZ(rBk, qBk * 16) : v_st(rBv, qBv * 8), wC = v_st(rCv, qCv * 8);
  const int vb0 = (int)(uintptr_t)V_lds + v_rd_base(lane);
  struct { bf16x8 x0, x1, x2; } sr_[2];
#define SLOAD(i, k0) do { sr_[i].x0 = ld8(pA + (long)(k0) * QKD); sr_[i].x1 = ld8(pB + (long)(k0) * sB); sr_[i].x2 = ld8(pC + (long)(k0) * VH); } while (0)
#define SWRITE(bb, i) do { *(bf16x8*)(lds + wA + (bb) * SHM_K) = sr_[i].x0; *(bf16x8*)(lds + wB + (bb) * SHM_K) = sr_[i].x1; *(bf16x8*)(lds + wC + (bb) * SHM_K) = sr_[i].x2; } while (0)
#define RESC(a) do { if (__any((a) < 1.f)) { if (hi == 0) al_l[r32] = (a); asm volatile("s_waitcnt lgkmcnt(0)" ::: "memory"); \
    _Pragma("unroll") for (int d = 0; d < 2; ++d) _Pragma("unroll") for (int r = 0; r < 16; ++r) o[d][r] *= al_l[crow(r, hi)]; } } while (0)
  float cv[16];
#define BG_LOAD() do { if constexpr (BG) { const int wh_ = c_it / 65536, q_ = c_it & 65535, mat_ = q_ >> 10, nb_ = (q_ >> 6) & 15, kc_ = q_ & 63; \
      const float* s_ = (wh_ == 0 ? bg_src0 : (wh_ == 1 ? bg_src1 : bg_src2)) + (size_t)mat_ * DM * DM + (size_t)(16 * kc_) * DM + 64 * nb_ + lane; \
      _Pragma("unroll") for (int i_ = 0; i_ < 16; ++i_) cv[i_] = __builtin_nontemporal_load(s_ + (size_t)i_ * DM); } } while (0)
#define BG_STORE() do { if constexpr (BG) { const int wh_ = c_it / 65536, q_ = c_it & 65535, mat_ = q_ >> 10, nb_ = (q_ >> 6) & 15, kc_ = q_ & 63, n_ = 64 * nb_ + lane; const float sc_ = (wh_ == 2) ? 64.f : 32.f; \
      unsigned char* d_ = (wh_ == 2) ? bg_wdn + ((size_t)mat_ * DM + n_) * DM + 16 * kc_ : bg_wup + ((size_t)mat_ * 2048 + (n_ >> 7) * 256 + wh_ * 128 + (n_ & 127)) * DM + 16 * kc_; \
      v4u o_; o_.x = pack_fp8x4(cv[0] * sc_, cv[1] * sc_, cv[2] * sc_, cv[3] * sc_); o_.y = pack_fp8x4(cv[4] * sc_, cv[5] * sc_, cv[6] * sc_, cv[7] * sc_); \
      o_.z = pack_fp8x4(cv[8] * sc_, cv[9] * sc_, cv[10] * sc_, cv[11] * sc_); o_.w = pack_fp8x4(cv[12] * sc_, cv[13] * sc_, cv[14] * sc_, cv[15] * sc_); \
      *(v4u*)d_ = o_; } } while (0)
#define BG_STEP() do { if constexpr (BG) { BG_STORE(); c_it = (c_it + 1 < c_end) ? c_it + 1 : c_end - 1; BG_LOAD(); } } while (0)
  f32x16 pA0, pA1, pB0, pB1; float mnA, mnB, alA, alB; bf16x8 pa0, pa1, pa2, pa3; const int NTL = seq / KVBLK;
  constexpr int SE = 0, SO = 1;
  SLOAD(SE, 0); asm volatile("s_waitcnt vmcnt(0)" ::: "memory"); SWRITE(0, SE); __syncthreads();
  qkt(pA0, pA1, K_lds, qr, r32, hi); partialSM(pA0, pA1, m_reg, mnA, alA);
  SLOAD(SO, KVBLK); SLOAD(SE, 2 * KVBLK); BG_LOAD();
  SWRITE(1, SO); __syncthreads();
  for (int j = 1; j + 1 < NTL; j += 2) {
    SBAR(); qkt(pB0, pB1, (bf16*)((char*)K_lds + SHM_K), qr, r32, hi);
    finishSM(pA0, pA1, alA, l_reg, pa0, pa1, pa2, pa3); SBAR();
    SLOAD(SO, (j + 2) * KVBLK); BG_STEP(); SBAR();
    pv_d0(o, vb0, pa0, pa1, pa2, pa3); partialSM(pB0, pB1, m_reg, mnB, alB);
    __syncthreads(); SWRITE(0, SE);
    RESC(alB); __syncthreads();
    SBAR(); qkt(pA0, pA1, K_lds, qr, r32, hi);
    finishSM(pB0, pB1, alB, l_reg, pa0, pa1, pa2, pa3); SBAR();
    { const int kn_ = (j + 3 < NTL) ? (j + 3) * KVBLK : seq - KVBLK; SLOAD(SE, kn_); } SBAR();
    pv_d0(o, vb0 + (int)SHM_V, pa0, pa1, pa2, pa3); partialSM(pA0, pA1, m_reg, mnA, alA);
    __syncthreads(); SWRITE(1, SO);
    RESC(alA); __syncthreads();
  }
  SBAR(); qkt(pB0, pB1, (bf16*)((char*)K_lds + SHM_K), qr, r32, hi);
  finishSM(pA0, pA1, alA, l_reg, pa0, pa1, pa2, pa3); SBAR();
  pv_d0(o, vb0, pa0, pa1, pa2, pa3); partialSM(pB0, pB1, m_reg, mnB, alB);
  __syncthreads(); RESC(alB);
  finishSM(pB0, pB1, alB, l_reg, pa0, pa1, pa2, pa3); SBAR();
  pv_d0(o, vb0 + (int)SHM_V, pa0, pa1, pa2, pa3);
  if (hi == 0) li_l[r32] = l_reg; asm volatile("s_waitcnt lgkmcnt(0)" ::: "memory");
  float rli[16];
#pragma unroll
  for (int r = 0; r < 16; ++r) rli[r] = __builtin_amdgcn_rcpf(li_l[crow(r, hi)]);
  bf16* Ow = Ob + (long)(wid * QBLK) * ldo;
#pragma unroll
  for (int r = 0; r < 16; ++r) { const int orow = crow(r, hi);
#pragma unroll
    for (int d0 = 0; d0 < 2; ++d0) Ow[(long)orow * ldo + d0 * 32 + r32] = f2bf(o[d0][r] * rli[r]); }
  BG_STORE(); if constexpr (BG) c_it = (c_it + 1 < c_end) ? c_it + 1 : c_end - 1;
  __syncthreads();
#undef BG_STEP
#undef BG_LOAD
#undef BG_STORE
#undef SLOAD
#undef SWRITE
#undef RESC
}
#undef KSWZ
#undef SBAR
}

constexpr int P3_CQ_LD = 264, P3_CKV_LD = 136, P3_UF_LD = 520;
constexpr int P3_CQ_OFF = 0, P3_CKV_OFF = 64 * P3_CQ_LD * 2, P3_UF_OFF = P3_CKV_OFF + 64 * P3_CKV_LD * 2, P3_R_OFF = P3_UF_OFF + 64 * P3_UF_LD * 2, P3_BYTES = P3_R_OFF + 512;
__device__ __forceinline__ void p3_unit(const FastArgs& a, int chunk, LAS unsigned char* lds) {
    int tid = threadIdx.x; asm volatile("" : "+v"(tid));
    const int lane = tid & 63, wave = __builtin_amdgcn_readfirstlane(tid >> 6);
    unsigned char* ws = a.ws;
    const bf16* CQ = (const bf16*)(ws + WS_CQ); const bf16* CKV = (const bf16*)(ws + WS_CKV); const bf16* KPE = (const bf16*)(ws + WS_KPE); const bf16* UF = (const bf16*)(ws + WS_UF);
    const bf16* Wuq = (const bf16*)(ws + WS_WUQ); const bf16* Wukv = (const bf16*)(ws + WS_WUKV); const bf16* CSt = (const bf16*)(ws + WS_CST); const float* rope = (const float*)(ws + WS_ROPE);
    bf16* Qo = (bf16*)(ws + WS_Q); bf16* Ko = (bf16*)(ws + WS_K); bf16* Vo = (bf16*)(ws + WS_V); bf16* UCS = (bf16*)(ws + WS_UCS);
    LAS bf16* cqs = (LAS bf16*)(lds + P3_CQ_OFF); LAS bf16* ckvs = (LAS bf16*)(lds + P3_CKV_OFF); LAS bf16* ufs = (LAS bf16*)(lds + P3_UF_OFF);
    LAS float* rq = (LAS float*)(lds + P3_R_OFF); LAS float* rkv = rq + 64;
    const int t0 = chunk * 64, b = t0 >> 12, s0 = t0 & 4095, fr = lane & 15, fq = lane >> 4;
#pragma unroll
    for (int i = 0; i < 4; ++i) { const int p = tid + 512 * i, r = p >> 5, c = p & 31; *(LAS v4u*)(cqs + r * P3_CQ_LD + c * 8) = *(const v4u*)(CQ + (size_t)(t0 + r) * 256 + c * 8); }
#pragma unroll
    for (int i = 0; i < 2; ++i) { const int p = tid + 512 * i, r = p >> 4, c = p & 15; *(LAS v4u*)(ckvs + r * P3_CKV_LD + c * 8) = *(const v4u*)(CKV + (size_t)(t0 + r) * 128 + c * 8); }
#pragma unroll
    for (int i = 0; i < 8; ++i) { const int p = tid + 512 * i, r = p >> 6, c = p & 63; *(LAS v4u*)(ufs + r * P3_UF_LD + c * 8) = *(const v4u*)(UF + (size_t)(t0 + r) * 512 + c * 8); }
    __syncthreads();
#pragma unroll
    for (int i = 0; i < 8; ++i) { const int r = wave * 8 + i;
        const v2u u = *(const LAS v2u*)(cqs + r * P3_CQ_LD + lane * 4);
        const float x0 = __uint_as_float(u.x << 16), x1 = __uint_as_float(u.x & 0xffff0000u), x2 = __uint_as_float(u.y << 16), x3 = __uint_as_float(u.y & 0xffff0000u);
        const float sq = wsum((x0 * x0 + x1 * x1) + (x2 * x2 + x3 * x3));
        const unsigned v = *(const LAS unsigned*)(ckvs + r * P3_CKV_LD + lane * 2);
        const float y0 = __uint_as_float(v << 16), y1 = __uint_as_float(v & 0xffff0000u);
        const float sk = wsum(y0 * y0 + y1 * y1);
        if (lane == 0) { rq[r] = rsqrtf(sq * (1.f / 256.f) + 1e-6f); rkv[r] = rsqrtf(sk * (1.f / 128.f) + 1e-6f); } }
    __syncthreads();
    const size_t bh = (size_t)(b * NH + wave) * NS;
    {
        f32x4 acc[4][6];
#pragma unroll
        for (int m = 0; m < 4; ++m)
#pragma unroll
            for (int n = 0; n < 6; ++n) acc[m][n] = (f32x4){0.f, 0.f, 0.f, 0.f};
#pragma unroll 1
        for (int kt = 0; kt < 8; ++kt) { bf16x8 af[4], wf[6];
#pragma unroll
            for (int m = 0; m < 4; ++m) af[m] = *(const LAS bf16x8*)(cqs + (16 * m + fr) * P3_CQ_LD + kt * 32 + 8 * fq);
#pragma unroll
            for (int n = 0; n < 6; ++n) wf[n] = *(const bf16x8*)(Wuq + (size_t)(96 * wave + 16 * n + fr) * 256 + kt * 32 + 8 * fq);
#pragma unroll
            for (int m = 0; m < 4; ++m)
#pragma unroll
                for (int n = 0; n < 6; ++n) acc[m][n] = __builtin_amdgcn_mfma_f32_16x16x32_bf16(wf[n], af[m], acc[m][n], 0, 0, 0); }
#pragma unroll
        for (int m = 0; m < 4; ++m) { const int tl = 16 * m + fr, t = t0 + tl; const float sc = rq[tl] * 0.10206207261596575f;
            bf16* qrow = Qo + (bh + s0 + tl) * QKD + 4 * fq;
#pragma unroll
            for (int n = 0; n < 4; ++n) { const f32x4 v = acc[m][n] * sc; v2u w; w.x = cvt_pk_bf16(v[0], v[1]); w.y = cvt_pk_bf16(v[2], v[3]); *(v2u*)(qrow + 16 * n) = w; }
            const f32x4 cs = *(const f32x4*)(rope + (size_t)t * 16 + 4 * fq), sn = *(const f32x4*)(rope + (size_t)NT * 16 + (size_t)t * 16 + 4 * fq);
            const f32x4 t1 = acc[m][4] * sc, t2 = acc[m][5] * sc; const f32x4 o1 = t1 * cs - t2 * sn, o2 = t2 * cs + t1 * sn;
            v2u w1, w2; w1.x = cvt_pk_bf16(o1[0], o1[1]); w1.y = cvt_pk_bf16(o1[2], o1[3]); w2.x = cvt_pk_bf16(o2[0], o2[1]); w2.y = cvt_pk_bf16(o2[2], o2[3]);
            *(v2u*)(qrow + 64) = w1; *(v2u*)(qrow + 80) = w2; }
    }
#pragma unroll 1
    for (int pass = 0; pass < 2; ++pass) {
        f32x4 acc[4][4];
#pragma unroll
        for (int m = 0; m < 4; ++m)
#pragma unroll
            for (int n = 0; n < 4; ++n) acc[m][n] = (f32x4){0.f, 0.f, 0.f, 0.f};
#pragma unroll
        for (int kt = 0; kt < 4; ++kt) { bf16x8 af[4], wf[4];
#pragma unroll
            for (int m = 0; m < 4; ++m) af[m] = *(const LAS bf16x8*)(ckvs + (16 * m + fr) * P3_CKV_LD + kt * 32 + 8 * fq);
#pragma unroll
            for (int n = 0; n < 4; ++n) wf[n] = *(const bf16x8*)(Wukv + (size_t)(512 * pass + 64 * wave + 16 * n + fr) * 128 + kt * 32 + 8 * fq);
#pragma unroll
            for (int m = 0; m < 4; ++m)
#pragma unroll
                for (int n = 0; n < 4; ++n) acc[m][n] = __builtin_amdgcn_mfma_f32_16x16x32_bf16(wf[n], af[m], acc[m][n], 0, 0, 0); }
#pragma unroll
        for (int m = 0; m < 4; ++m) { const int tl = 16 * m + fr; const float sc = rkv[tl];
            bf16* orow = (pass == 0) ? (Ko + (bh + s0 + tl) * QKD + 4 * fq) : (Vo + (bh + s0 + tl) * VH + 4 * fq);
#pragma unroll
            for (int n = 0; n < 4; ++n) { const f32x4 v = acc[m][n] * sc; v2u w; w.x = cvt_pk_bf16(v[0], v[1]); w.y = cvt_pk_bf16(v[2], v[3]); *(v2u*)(orow + 16 * n) = w; } }
    }
#pragma unroll
    for (int i = 0; i < 4; ++i) { const int p = lane + 64 * i, tl = p >> 2, c = p & 3;
        *(v4u*)(Ko + (bh + s0 + tl) * QKD + 64 + 8 * c) = *(const v4u*)(KPE + (size_t)(t0 + tl) * 32 + 8 * c); }
#pragma unroll 1
    for (int pass = 0; pass < 2; ++pass) {
        f32x4 acc[4][4];
#pragma unroll
        for (int m = 0; m < 4; ++m)
#pragma unroll
            for (int n = 0; n < 4; ++n) acc[m][n] = (f32x4){0.f, 0.f, 0.f, 0.f};
#pragma unroll
        for (int kt = 0; kt < 2; ++kt) { bf16x8 af[4], wf[4];
#pragma unroll
            for (int m = 0; m < 4; ++m) af[m] = *(const LAS bf16x8*)(ufs + (16 * m + fr) * P3_UF_LD + 64 * wave + kt * 32 + 8 * fq);
#pragma unroll
            for (int n = 0; n < 4; ++n) wf[n] = *(const bf16x8*)(CSt + (size_t)(64 * pass + 16 * n + fr) * 64 + kt * 32 + 8 * fq);
#pragma unroll
            for (int m = 0; m < 4; ++m)
#pragma unroll
                for (int n = 0; n < 4; ++n) acc[m][n] = __builtin_amdgcn_mfma_f32_16x16x32_bf16(af[m], wf[n], acc[m][n], 0, 0, 0); }
#pragma unroll
        for (int m = 0; m < 4; ++m)
#pragma unroll
            for (int n = 0; n < 4; ++n) { const f32x4 v = acc[m][n];
                *(unsigned*)((unsigned char*)UCS + ((size_t)(b * 512 + 64 * wave + 16 * n + fr)) * 8192 + 4096 * pass + s0 + 16 * m + 4 * fq) = pack_fp8x4(v[0], v[1], v[2], v[3]); }
    }
    __syncthreads();
}

__device__ __forceinline__ void conv_phase(const FastArgs& a, unsigned char* ws, int vcu, int G, int tid) {
    const bf16* gbp = (const bf16*)(ws + WS_PC); const bf16* up = (const bf16*)(ws + WS_PC + (size_t)NT * DM * 2); bf16* yc = (bf16*)(ws + WS_YC); const float* cw = a.in[17];
    for (int i = vcu * 512 + tid; i < NT * 128; i += G * 512) { const int t = i >> 7, c = (i & 127) * 8, s = t & 4095;
        const bf16x8 gb = *(const bf16x8*)(gbp + (size_t)t * DM + c), u1 = *(const bf16x8*)(up + (size_t)t * DM + c);
        bf16x8 u0 = {0, 0, 0, 0, 0, 0, 0, 0}, u2 = u0;
        if (s > 0) u0 = *(const bf16x8*)(up + (size_t)(t - 1) * DM + c);
        if (s < NS - 1) u2 = *(const bf16x8*)(up + (size_t)(t + 1) * DM + c);
        const f32x4 w0a = *(const f32x4*)(cw + c), w0b = *(const f32x4*)(cw + c + 4), w1a = *(const f32x4*)(cw + 1024 + c), w1b = *(const f32x4*)(cw + 1024 + c + 4), w2a = *(const f32x4*)(cw + 2048 + c), w2b = *(const f32x4*)(cw + 2048 + c + 4);
        float y[8];
#pragma unroll
        for (int j = 0; j < 8; ++j) { const float w0 = j < 4 ? w0a[j & 3] : w0b[j & 3], w1 = j < 4 ? w1a[j & 3] : w1b[j & 3], w2 = j < 4 ? w2a[j & 3] : w2b[j & 3];
            y[j] = bf2f((bf16)gb[j]) * (bf2f((bf16)u0[j]) * w0 + bf2f((bf16)u1[j]) * w1 + bf2f((bf16)u2[j]) * w2); }
        v4u w = {cvt_pk_bf16(y[0], y[1]), cvt_pk_bf16(y[2], y[3]), cvt_pk_bf16(y[4], y[5]), cvt_pk_bf16(y[6], y[7])};
        *(v4u*)(yc + (size_t)t * DM + c) = w; }
}

constexpr int N_PHASES = 17;
#ifndef PHMASK
#define PHMASK 0x1ffff
#endif
#define PHASE_ENV() int tid = threadIdx.x; asm volatile("" : "+v"(tid)); const int lane = tid & 63, wave = __builtin_amdgcn_readfirstlane(tid >> 6); \
    int Gv_ = gridDim.x, bxv_ = blockIdx.x; unsigned wl_ = (unsigned)(unsigned long long)a.ws, wh_ = (unsigned)((unsigned long long)a.ws >> 32); asm volatile("" : "+v"(Gv_), "+v"(bxv_), "+v"(wl_), "+v"(wh_)); \
    const int G = __builtin_amdgcn_readfirstlane(Gv_), bx = __builtin_amdgcn_readfirstlane(bxv_); const int vcu = (G % 8 == 0) ? (bx % 8) * (G / 8) + bx / 8 : bx; \
    unsigned char* ws = (unsigned char*)(GAS unsigned char*)(((unsigned long long)(unsigned)__builtin_amdgcn_readfirstlane((int)wh_) << 32) | (unsigned long long)(unsigned)__builtin_amdgcn_readfirstlane((int)wl_));     \
    int lz_ = 0; asm volatile("" : "+v"(lz_)); LAS unsigned char* ldsp = lds + __builtin_amdgcn_readfirstlane(lz_);     \
    (void)lane; (void)wave; (void)vcu; (void)tid; (void)ldsp
#define IN(k) (((PHMASK >> (k)) & 1) && lo <= (k) && (k) < hi)
#ifndef DUPMASK
#define DUPMASK 0
#endif
#ifndef SEAMREP
#define SEAMREP 1
#endif
#define NREP(k) ((((DUPMASK) >> (k)) & 1) ? 2 : 1)
#define SEAM(k) do { if (IN(k) && IN((k) + 1)) { PHASE_ENV(); XcdBarrier b_; b_.bar = (unsigned*)(ws + WS_CTL) + CW_BAR + a.bar_region * XCD_BAR_WORDS; b_.x = xb_xcc_id(); \
        b_.st = (volatile LAS unsigned*)(lds + MISC_OFF) + 8; for (int sr_ = 0; sr_ < SEAMREP; ++sr_) xcd_barrier(b_); } } while (0)


template <int L> __device__ __forceinline__ void moe_block(const FastArgs& a, LAS unsigned char* lds) {
    extern __shared__ __attribute__((aligned(16))) unsigned char lds_raw[];
#if (MODE & 16)
    constexpr int lo = 0, hi = N_PHASES;
#else
    const int lo = a.ph_lo, hi = a.ph_hi;
#endif
        const int p0 = (L == 0) ? 6 : 13;
        if (IN(p0)) for (int rep_ = 0; rep_ < NREP(p0); ++rep_) { if (rep_) __syncthreads(); PHASE_ENV(); RowArgs r{}; if (L == 0) r.xin = a.in[0]; else r.xin_bf = (const bf16*)(ws + WS_XB); r.o_bf = (const bf16*)(ws + WS_O); r.xout_bf = (bf16*)(ws + WS_XA);
#if MOE_FP8
            r.h8 = (unsigned char*)(ws + WS_H8);
#else
            r.h = (bf16*)(ws + WS_H);
#endif
            r.mod = (const float*)(ws + WS_MOD) + L * 4 * 6144; r.gamma = a.in[5] + L * DM; r.beta = a.in[6] + L * DM;
            r.wr = a.in[19] + (size_t)L * DM * NE; r.br = a.in[20] + L * NE; r.topi = (int*)(ws + WS_TOPI); r.tpos = (int*)(ws + WS_TPOS); r.gate = (float*)(ws + WS_GATE); r.list = (int*)(ws + WS_LIST);
            r.cnt = (unsigned*)(ws + WS_CTL) + CW_CNT + 32 * L;
            if (NREP(p0) == 2 && rep_ == 0) { r.cnt += 1024; r.topi = (int*)(ws + WS_TMP); r.tpos = (int*)(ws + WS_TMP + MiB); r.gate = (float*)(ws + WS_TMP + 2 * MiB); r.list = (int*)(ws + WS_TMP + 4 * MiB); }
            load_wl(r.wr, (char*)lds_raw, tid); __syncthreads();
            for (int ch = vcu; ch < NT / 64; ch += G) rp_b_chunk(r, ch, wave, lane, (char*)lds_raw); }
        SEAM(p0);
        if (IN(p0 + 1)) for (int rep_ = 0; rep_ < NREP(p0 + 1); ++rep_) { if (rep_) __syncthreads(); PHASE_ENV(); const unsigned* cntL = (const unsigned*)(ws + WS_CTL) + CW_CNT + 32 * L; const size_t EW = (size_t)L * NE * DM * DM, EB = (size_t)L * NE * DM;
            compute_poff(cntL, (int*)(lds_raw + MISC_OFF + 256), tid); __syncthreads();
#if MOE_FP8
            pg8::MoeSched S{(const LAS int*)(ldsp + MISC_OFF + 256), (const char*)(ws + WS_H8), (const char*)(ws + WS_WUP) + EW * 2, (const int*)(ws + WS_LIST), cntL, 8, G, vcu, (size_t)2048 * DM, true, DM};
            pg8::EpiUp8 E{(unsigned char*)(ws + WS_AACT), a.in[22] + EB, a.in[24] + EB};
            pg8::gemm_phase<pg8::EpiUp8, pg8::MoeSched, true, true, true>(ldsp, DM, S, E); }
#else
            pg8::MoeSched S{(const LAS int*)(ldsp + MISC_OFF + 256), (const char*)(ws + WS_H), (const char*)(ws + WS_WUP) + EW * 4, (const int*)(ws + WS_LIST), cntL, 8, G, vcu, (size_t)2048 * DM * 2, true, 2 * DM};
            pg8::EpiUp E{(bf16*)(ws + WS_AACT), a.in[22] + EB, a.in[24] + EB};
            pg8::gemm_phase<pg8::EpiUp, pg8::MoeSched, true, true>(ldsp, 2 * DM, S, E); }
#endif
        SEAM(p0 + 1);
        if (IN(p0 + 2)) for (int rep_ = 0; rep_ < NREP(p0 + 2); ++rep_) { if (rep_) __syncthreads(); PHASE_ENV(); const unsigned* cntL = (const unsigned*)(ws + WS_CTL) + CW_CNT + 32 * L; const size_t EW = (size_t)L * NE * DM * DM, EB = (size_t)L * NE * DM;
            compute_poff(cntL, (int*)(lds_raw + MISC_OFF + 256), tid); __syncthreads();
#if MOE_FP8
            pg8::MoeSched S{(const LAS int*)(ldsp + MISC_OFF + 256), (const char*)(ws + WS_AACT), (const char*)(ws + WS_WDN) + EW, (const int*)(ws + WS_LIST), cntL, 4, G, vcu, (size_t)DM * DM, false, DM};
            pg8::EpiDown8 E{(bf16*)(ws + WS_Y), a.in[26] + EB};
            pg8::gemm_phase<pg8::EpiDown8, pg8::MoeSched, false, true, true>(ldsp, DM, S, E); }
#else
            pg8::MoeSched S{(const LAS int*)(ldsp + MISC_OFF + 256), (const char*)(ws + WS_AACT), (const char*)(ws + WS_WDN) + EW * 2, (const int*)(ws + WS_LIST), cntL, 4, G, vcu, (size_t)DM * DM * 2, false, 2 * DM};
            pg8::EpiDown E{(bf16*)(ws + WS_Y), a.in[26] + EB};
            pg8::gemm_phase<pg8::EpiDown, pg8::MoeSched, false, true>(ldsp, 2 * DM, S, E); }
#endif
        SEAM(p0 + 2);
        if (IN(p0 + 3)) for (int rep_ = 0; rep_ < NREP(p0 + 3); ++rep_) { if (rep_) __syncthreads(); PHASE_ENV(); RowArgs r{}; r.xin_bf = (const bf16*)(ws + WS_XA); if (L == 0) r.xout_bf = (bf16*)(ws + WS_XB); else r.xout = a.out; r.h = (bf16*)(ws + WS_H);
            r.mod = (const float*)(ws + WS_MOD) + L * 4 * 6144; r.mod_next = (const float*)(ws + WS_MOD) + 4 * 6144; r.gamma = a.in[7] + L * DM; r.beta = a.in[8] + L * DM;
            r.topi = (int*)(ws + WS_TOPI); r.tpos = (int*)(ws + WS_TPOS); r.gate = (float*)(ws + WS_GATE); r.y = (const bf16*)(ws + WS_Y); r.cntc = (const unsigned*)(ws + WS_CTL) + CW_CNT + 32 * L;
            compute_poff(r.cntc, (int*)(lds_raw + MISC_OFF + 256), tid); __syncthreads();
            for (int ch = vcu; ch < NT / 64; ch += G) rp_c_chunk(r, ch, wave, lane, (const int*)(lds_raw + MISC_OFF + 256), L == 1); }
}

__global__ void __launch_bounds__(512) mk_fwd(FastArgs a) {
    extern __shared__ __attribute__((aligned(16))) unsigned char lds_raw[];
    LAS unsigned char* lds = (LAS unsigned char*)lds_raw;
    { volatile LAS unsigned* MISC = (volatile LAS unsigned*)(lds + MISC_OFF);
      for (int u = threadIdx.x; u < (LDS_BYTES - MISC_OFF) / 4; u += 512) ((LAS unsigned*)(lds + MISC_OFF))[u] = 0u;
      __syncthreads();
      (void)xcd_barrier_post((unsigned*)(a.ws + WS_CTL) + CW_BAR + a.bar_region * XCD_BAR_WORDS, MISC + 8); }
#if (MODE & 16)
    constexpr int lo = 0, hi = N_PHASES;
#else
    const int lo = a.ph_lo, hi = a.ph_hi;
#endif
    if (IN(0)) for (int rep_ = 0; rep_ < NREP(0); ++rep_) { if (rep_) __syncthreads(); PHASE_ENV(); p0_prologue(a, ldsp, vcu, G, tid, wave, lane); } SEAM(0);
    if (IN(1)) for (int rep_ = 0; rep_ < NREP(1); ++rep_) { if (rep_) __syncthreads(); PHASE_ENV(); RowArgs r{}; r.xin = a.in[0]; r.h = (bf16*)(ws + WS_H); r.mod = (const float*)(ws + WS_MOD); for (int ch = vcu; ch < NT / 64; ch += G) rp_a_chunk(r, ch, wave, lane); } SEAM(1);
    if (IN(2)) for (int rep_ = 0; rep_ < NREP(2); ++rep_) { if (rep_) __syncthreads(); PHASE_ENV(); pg8::DenseSched S; S.init(ws + WS_H, ws + WS_WIN, NT, 1024, 1024, G, bx);
        pg8::EpiG1 E{(bf16*)(ws + WS_CQ), (bf16*)(ws + WS_CKV), (bf16*)(ws + WS_KPE), (bf16*)(ws + WS_UF), (const float*)(ws + WS_ROPE)};
        pg8::gemm_phase<pg8::EpiG1, pg8::DenseSched, false, true>(ldsp, 2048, S, E); } SEAM(2);
    if (IN(3)) for (int rep_ = 0; rep_ < NREP(3); ++rep_) { if (rep_) __syncthreads(); PHASE_ENV(); for (int ch = vcu; ch < NT / 64; ch += G) p3_unit(a, ch, ldsp); } SEAM(3);
    if (IN(4)) for (int rep_ = 0; rep_ < NREP(4); ++rep_) { if (rep_) __syncthreads(); PHASE_ENV();
        const bool deal = (G == 256);
#ifndef P4_SKIP0
#define P4_SKIP0 0
#endif
        if (!((P4_SKIP0 & 1) && NREP(4) == 2 && rep_ == 0))
        for (int u = vcu; u < 256; u += G) { pg8::ListSched S{(const char*)(ws + WS_DMAT), (const char*)(ws + WS_UCS), 4096  , 8, u, 1, 1};
            pg8::EpiOutBf E{(bf16*)(ws + WS_OCAT), DM, 1, 1.f / 512.f}; pg8::gemm_phase<pg8::EpiOutBf, pg8::ListSched, false, true, true>(ldsp, 8192, S, E); }
        const int ufirst = deal ? 2 * vcu : vcu, ucount = deal ? 2 : (512 - vcu + G - 1) / G, ustep = deal ? 1 : G;
        const bf16* Qb = (const bf16*)(ws + WS_Q); const bf16* Kb = (const bf16*)(ws + WS_K); const bf16* Vb = (const bf16*)(ws + WS_V); bf16* OC = (bf16*)(ws + WS_OCAT);
        const float* bg_src0 = a.in[21]; const float* bg_src1 = a.in[23]; const float* bg_src2 = a.in[25]; unsigned char* bg_wup = (unsigned char*)(ws + WS_WUP); unsigned char* bg_wdn = (unsigned char*)(ws + WS_WDN);
        const int gw_ = __builtin_amdgcn_readfirstlane(vcu * NWAVES + (tid >> 6));
        int c_it = deal ? gw_ * 64 : 0; const int c_end = deal ? gw_ * 64 + 64 : 0;
        const bool bg_on = deal && !(NREP(4) == 2 && rep_ == 0);
        if (!((P4_SKIP0 & 2) && NREP(4) == 2 && rep_ == 0))
        for (int i = 0; i < ucount; ++i) { const int u = ufirst + i * ustep; if (u < 512) { const int bhh = u >> 4, qb = u & 15, b = bhh >> 3, h = bhh & 7;
            const bf16* q_ = Qb + ((size_t)bhh * NS + qb * 256) * QKD; const bf16* k_ = Kb + (size_t)bhh * NS * QKD; const bf16* v_ = Vb + (size_t)bhh * NS * VH; bf16* o_ = OC + ((size_t)(b * NS + qb * 256)) * DM + h * 64;
            if (bg_on) att::attn_unit<true>(q_, k_, v_, o_, DM, NS, (char*)lds_raw, bg_src0, bg_src1, bg_src2, bg_wup, bg_wdn, c_it, c_end);
            else att::attn_unit<false>(q_, k_, v_, o_, DM, NS, (char*)lds_raw, bg_src0, bg_src1, bg_src2, bg_wup, bg_wdn, c_it, c_end); } }
    } SEAM(4);
    if (IN(5)) for (int rep_ = 0; rep_ < NREP(5); ++rep_) { if (rep_) __syncthreads(); PHASE_ENV(); pg8::DenseSched S; S.init(ws + WS_OCAT, ws + WS_WOUT0, NT, 1024, 1024, G, bx); pg8::EpiOutBf E{(bf16*)(ws + WS_O), DM, 0, 1.f};
        pg8::gemm_phase<pg8::EpiOutBf, pg8::DenseSched, false, true>(ldsp, 2048, S, E); } SEAM(5);
    moe_block<0>(a, lds);

            SEAM(9);
            if (IN(10)) for (int rep_ = 0; rep_ < NREP(10); ++rep_) { if (rep_) __syncthreads(); PHASE_ENV(); pg8::DenseSched S; S.init(ws + WS_H, ws + WS_WCIN, NT, 3072, 1024, G, bx); pg8::EpiConv E{(bf16*)(ws + WS_PC), (bf16*)(ws + WS_PC + (size_t)NT * DM * 2)};
                pg8::gemm_phase<pg8::EpiConv, pg8::DenseSched, false, true>(ldsp, 2048, S, E); } SEAM(10);
            if (IN(11)) for (int rep_ = 0; rep_ < NREP(11); ++rep_) { if (rep_) __syncthreads(); PHASE_ENV(); conv_phase(a, ws, vcu, G, tid); } SEAM(11);
            if (IN(12)) for (int rep_ = 0; rep_ < NREP(12); ++rep_) { if (rep_) __syncthreads(); PHASE_ENV(); pg8::DenseSched S; S.init(ws + WS_YC, ws + WS_WCOUT, NT, 1024, 1024, G, bx); pg8::EpiOutBf E{(bf16*)(ws + WS_O), DM, 0, 1.f};
                pg8::gemm_phase<pg8::EpiOutBf, pg8::DenseSched, false, true>(ldsp, 2048, S, E); } SEAM(12);

    moe_block<1>(a, lds);
#undef IN
#undef SEAM
}
#if HYBRID
template <typename TA, bool BNT, typename Epi>
static void gemm(hipStream_t st, const TA* A, int lda, const void* B, int ldb, int M, int N, int K, const float* ascale, Epi epi) {
    dim3 g((N + 63) / 64, (M + 63) / 64);
    hipLaunchKernelGGL((n_gemm<TA, BNT, Epi>), g, dim3(256), 0, st, A, B, ascale, epi, lda, ldb, M, N, K, 0);
}
#endif

extern "C" void kernel_launch(void* const* d_in, const int* in_sizes, int n_in, void* d_out, int out_size, void* d_ws, size_t ws_size, hipStream_t stream) {
    static int inited = 0; static int grid = 0;
    if (!inited) {
        if (ws_size < WS_END2 || n_in != 27) { fprintf(stderr, "kernel_launch: workspace too small (%zu < %zu) or n_in %d != 27\n", ws_size, (size_t)WS_END2, n_in); inited = -1; return; }
#if HYBRID
        (void)hipFuncSetAttribute((const void*)k_rp_b, hipFuncAttributeMaxDynamicSharedMemorySize, RP_LDS_BYTES);
#endif
        if (hipFuncSetAttribute((const void*)mk_fwd, hipFuncAttributeMaxDynamicSharedMemorySize, LDS_BYTES) != hipSuccess) { fprintf(stderr, "kernel_launch: hipFuncSetAttribute(mk_fwd) failed\n"); inited = -1; return; }
        int dev = 0, cus = 0;
        if (hipGetDevice(&dev) != hipSuccess || hipDeviceGetAttribute(&cus, hipDeviceAttributeMultiprocessorCount, dev) != hipSuccess) { inited = -1; return; }
        int per_cu = 0;
        if (hipOccupancyMaxActiveBlocksPerMultiprocessor(&per_cu, (const void*)mk_fwd, 512, LDS_BYTES) != hipSuccess || per_cu < 1) { fprintf(stderr, "kernel_launch: occupancy query says %d blocks per CU\n", per_cu); }
        (void)hipGetLastError();
        grid = cus;
        inited = 1;
    }
    if (inited < 0) return;
    const float* x = (const float*)d_in[0]; const float* c = (const float*)d_in[1]; const int* positions = (const int*)d_in[2];
    const float* ada_w = (const float*)d_in[3]; const float* ada_b = (const float*)d_in[4];
    const float* ln_mix_g = (const float*)d_in[5]; const float* ln_mix_b = (const float*)d_in[6]; const float* ln_ffn_g = (const float*)d_in[7]; const float* ln_ffn_b = (const float*)d_in[8];
    const float* mla_w_in = (const float*)d_in[9]; const float* q_norm_g = (const float*)d_in[10]; const float* kv_norm_g = (const float*)d_in[11];
    const float* w_uq = (const float*)d_in[12]; const float* w_uk = (const float*)d_in[13]; const float* w_uv = (const float*)d_in[14]; const float* mix_a_w_out = (const float*)d_in[15];
    const float* conv_w_in = (const float*)d_in[16]; const float* conv_w = (const float*)d_in[17]; const float* conv_w_out = (const float*)d_in[18];
    const float* w_router = (const float*)d_in[19]; const float* b_router = (const float*)d_in[20];
    const float* w_glu = (const float*)d_in[21]; const float* b_glu = (const float*)d_in[22]; const float* w_lin = (const float*)d_in[23]; const float* b_lin = (const float*)d_in[24];
    const float* w_down = (const float*)d_in[25]; const float* b_down = (const float*)d_in[26];
    char* ws = (char*)d_ws;
    unsigned* ctl = (unsigned*)(ws + WS_CTL);
    float* MOD = (float*)(ws + WS_MOD); float* ROPE = (float*)(ws + WS_ROPE); float* RQ = (float*)(ws + WS_RQ); float* RKV = RQ + NT;
    int* TOPI = (int*)(ws + WS_TOPI); int* TPOS = (int*)(ws + WS_TPOS); float* GATE = (float*)(ws + WS_GATE); int* LIST = (int*)(ws + WS_LIST);
    bf16* H = (bf16*)(ws + WS_H); bf16* CQ = (bf16*)(ws + WS_CQ); bf16* CKV = (bf16*)(ws + WS_CKV); bf16* KPE = (bf16*)(ws + WS_KPE); bf16* UF = (bf16*)(ws + WS_UF);
    bf16* Qb = (bf16*)(ws + WS_Q); bf16* Kb = (bf16*)(ws + WS_K); bf16* Vb = (bf16*)(ws + WS_V); bf16* UCS = (bf16*)(ws + WS_UCS); bf16* DMAT = (bf16*)(ws + WS_DMAT);
    bf16* OCAT = (bf16*)(ws + WS_OCAT); float* O = (float*)(ws + WS_O); float* XA = (float*)(ws + WS_XA); float* XB = (float*)(ws + WS_XB);
    float* TMP = (float*)(ws + WS_TMP); bf16* PC = (bf16*)(ws + WS_PC); bf16* YC = (bf16*)(ws + WS_YC); bf16* AACT = (bf16*)(ws + WS_AACT); bf16* Yb = (bf16*)(ws + WS_Y);
    float* KR = TMP + (size_t)NT * 768;
    const float* MOD0 = MOD; const float* MOD1 = MOD + 4 * 6144;
    const size_t EW = (size_t)NE * DM * DM, EB = (size_t)NE * DM;

    (void)hipMemsetAsync(ws + WS_CTL, 0, CTL_BYTES, stream);
    FastArgs fa{};
    for (int i = 0; i < 27; ++i) fa.in[i] = (const float*)d_in[i];
    fa.out = (float*)d_out; fa.ws = (unsigned char*)d_ws;
    int region = 0;
    auto fast = [&](int lo, int hi) { fa.ph_lo = lo; fa.ph_hi = hi; fa.bar_region = region++; hipLaunchKernelGGL(mk_fwd, dim3(grid), dim3(512), LDS_BYTES, stream, fa); };
    constexpr bool F_GEMM = (MODE & 1) != 0, F_MOE = (MODE & 2) != 0, F_ATT = (MODE & 4) != 0, F_P3 = (MODE & 8) != 0, F_ONE = (MODE & 16) != 0;
    if (F_ONE) { fast(0, N_PHASES); return; }
#if HYBRID

    if (F_GEMM) fast(0, 3);
    else {
        hipLaunchKernelGGL(n_mod, dim3(6144 / 256, 2), dim3(256), 0, stream, c, ada_w, ada_b, MOD);
        hipLaunchKernelGGL(n_rope, dim3(NT * 16 / 256), dim3(256), 0, stream, positions, ROPE);
        hipLaunchKernelGGL(n_dmat, dim3(4096 * 8192 / 256), dim3(256), 0, stream, DMAT);
        { RowArgs a{}; a.xin = x; a.h = H; a.mod = MOD0; hipLaunchKernelGGL(k_rp_a, dim3(256), dim3(512), 0, stream, a); }
        gemm<bf16, false>(stream, H, DM, mla_w_in, PROJ_A, NT, PROJ_A, DM, nullptr, EpiP2{CQ, CKV, KR, UF});
        hipLaunchKernelGGL(n_kpe, dim3(NT * 16 / 256), dim3(256), 0, stream, KR, ROPE, KPE);
    }
    if (F_P3) fast(3, 4);
    else {
        hipLaunchKernelGGL(n_rms, dim3(NT / 256), dim3(256), 0, stream, CQ, CKV, RQ, RKV);
        gemm<bf16, false>(stream, CQ, 256, w_uq, 768, NT, 768, 256, q_norm_g, EpiQ{TMP, RQ});
        hipLaunchKernelGGL(n_qfin, dim3(NT * 768 / 256), dim3(256), 0, stream, TMP, ROPE, Qb);
        gemm<bf16, false>(stream, CKV, 128, w_uk, 512, NT, 512, 128, kv_norm_g, EpiKV{Kb, RKV, QKD});
        gemm<bf16, false>(stream, CKV, 128, w_uv, 512, NT, 512, 128, kv_norm_g, EpiKV{Vb, RKV, VH});
        hipLaunchKernelGGL(n_kcopy, dim3(NT * NH * 32 / 256), dim3(256), 0, stream, KPE, Kb);
        hipLaunchKernelGGL(n_fnet_ch, dim3(NS / 256, 512, NB), dim3(256), 0, stream, UF, UCS);
    }
    if (F_ATT) fast(4, 5);
    else {
        hipLaunchKernelGGL(n_attn, dim3(NS / 256, NH, NB), dim3(256), 0, stream, Qb, Kb, Vb, OCAT);
        gemm<bf16, true>(stream, DMAT, 8192, UCS, 8192, NS, NB * 512, 8192, nullptr, EpiFnet{OCAT});
    }
    if (F_GEMM) fast(5, 6);
    else gemm<bf16, false>(stream, OCAT, DM, mix_a_w_out, DM, NT, DM, DM, nullptr, EpiF32{O, DM});
    for (int L = 0; L < 2; ++L) {
        unsigned* cntL = ctl + CW_CNT + 32 * L;
        const int p0 = L == 0 ? 6 : 13;
        if (F_MOE) fast(p0, p0 + 4);
        else {
            { RowArgs a{}; a.xin = L == 0 ? x : XB; a.o = O; a.xout = XA; a.h = H; a.mod = L == 0 ? MOD0 : MOD1; a.gamma = ln_mix_g + L * DM; a.beta = ln_mix_b + L * DM;
              a.wr = w_router + (size_t)L * DM * NE; a.br = b_router + L * NE; a.topi = TOPI; a.tpos = TPOS; a.gate = GATE; a.list = LIST; a.cnt = cntL;
              hipLaunchKernelGGL(k_rp_b, dim3(256), dim3(512), RP_LDS_BYTES, stream, a); }
            hipLaunchKernelGGL(n_moe_up, dim3(16, NT / 64, NE), dim3(256), 0, stream, H, w_glu + L * EW, b_glu + L * EB, w_lin + L * EW, b_lin + L * EB, LIST, cntL, AACT);
            hipLaunchKernelGGL(n_moe_down, dim3(16, NT / 64, NE), dim3(256), 0, stream, AACT, w_down + L * EW, b_down + L * EB, cntL, Yb);
            { RowArgs a{}; a.xin = XA; a.xout = L == 0 ? XB : (float*)d_out; a.h = H; a.mod = L == 0 ? MOD0 : MOD1; a.mod_next = MOD1; a.gamma = ln_ffn_g + L * DM; a.beta = ln_ffn_b + L * DM;
              a.topi = TOPI; a.tpos = TPOS; a.gate = GATE; a.y = Yb; a.cntc = cntL; a.final_ = L;
              hipLaunchKernelGGL(k_rp_c, dim3(256), dim3(512), 0, stream, a); }
        }
        if (L == 0) {
            if (F_GEMM) fast(10, 13);
            else {
                gemm<bf16, false>(stream, H, DM, conv_w_in, 3072, NT, 3072, DM, nullptr, EpiBf{PC, 3072});
                hipLaunchKernelGGL(n_conv, dim3(NT * DM / 256), dim3(256), 0, stream, PC, conv_w, YC);
                gemm<bf16, false>(stream, YC, DM, conv_w_out, DM, NT, DM, DM, nullptr, EpiF32{O, DM});
            }
        }
    }
#endif
}
```

```cpp
#include <hip/hip_runtime.h>
#include <cstdio>
#include <cstdint>

#ifndef MODE
#define MODE 31
#endif
#define HYBRID (!(MODE & 16))

constexpr int NB = 4, NS = 4096, DM = 1024, NT = NB * NS;
constexpr int NH = 8, QKN = 64, QKR = 32, QKD = 96, VH = 64, QRANK = 256, KVRANK = 128;
constexpr int PROJ_A = 928;
constexpr int NE = 32, TOPK = 4;
constexpr float ALPHA = 1.4142135623730951f;
constexpr float SWL = 7.0f, SWA = 1.702f;
constexpr int SLOTS = NT * TOPK + NE * 256;

typedef unsigned short bf16;
__device__ __forceinline__ float bf2f(bf16 v) { return __uint_as_float(((unsigned)v) << 16); }
__device__ __forceinline__ bf16 f2bf(float f) { unsigned u = __float_as_uint(f); return (bf16)((u + 0x7fffu + ((u >> 16) & 1u)) >> 16); }
__device__ __forceinline__ float tof(float v) { return v; }
__device__ __forceinline__ float tof(bf16 v) { return bf2f(v); }

constexpr size_t MiB = 1u << 20;
constexpr size_t WS_CTL = 0;
constexpr size_t CTL_BYTES = 1 * MiB;
constexpr size_t WS_MOD = 1 * MiB;
constexpr size_t WS_ROPE = 2 * MiB;
constexpr size_t WS_RQ = 4 * MiB;
constexpr size_t WS_TOPI = 5 * MiB;
constexpr size_t WS_TPOS = 6 * MiB;
constexpr size_t WS_GATE = 7 * MiB;
constexpr size_t WS_LIST = 8 * MiB;
constexpr size_t WS_H = 16 * MiB;
constexpr size_t WS_O = 48 * MiB;
constexpr size_t WS_XA = 112 * MiB;
constexpr size_t WS_XB = 176 * MiB;
constexpr size_t WS_CQ = 240 * MiB;
constexpr size_t WS_CKV = 248 * MiB;
constexpr size_t WS_KPE = 252 * MiB;
constexpr size_t WS_UF = 256 * MiB;
constexpr size_t WS_Q = 272 * MiB;
constexpr size_t WS_K = 296 * MiB;
constexpr size_t WS_V = 320 * MiB;
constexpr size_t WS_UCS = 336 * MiB;
constexpr size_t WS_DMAT = 368 * MiB;
constexpr size_t WS_OCAT = 432 * MiB;
constexpr size_t WS_TMP = 464 * MiB;
constexpr size_t WS_PC = 240 * MiB;
constexpr size_t WS_YC = 336 * MiB;
constexpr size_t WS_AACT = 240 * MiB;
constexpr size_t WS_Y = 384 * MiB;
constexpr size_t WS_END = 528 * MiB;
constexpr int CW_CNT = 64;

template <int CTRL> __device__ __forceinline__ float dppf(float v) { return __int_as_float(__builtin_amdgcn_update_dpp(0, __float_as_int(v), CTRL, 0xf, 0xf, false)); }
__device__ __forceinline__ float wsum(float v) {
    v += dppf<0xB1>(v); v += dppf<0x4E>(v); v += dppf<0x141>(v); v += dppf<0x140>(v);
    { auto rr = __builtin_amdgcn_permlane16_swap(__float_as_uint(v), __float_as_uint(v), false, false); v = __uint_as_float(rr[0]) + __uint_as_float(rr[1]); }
    { auto rr = __builtin_amdgcn_permlane32_swap(__float_as_uint(v), __float_as_uint(v), false, false); v = __uint_as_float(rr[0]) + __uint_as_float(rr[1]); }
    return v;
}
__device__ __forceinline__ float swiglu(float g, float l) {
    g = fminf(g, SWL); l = fminf(fmaxf(l, -SWL), SWL);
    const float e = __builtin_amdgcn_exp2f(g * (-SWA * 1.4426950408889634f));
    return g * __builtin_amdgcn_rcpf(1.f + e) * (l + 1.f);
}

#if HYBRID
__global__ void __launch_bounds__(256) n_mod(const float* __restrict__ c, const float* __restrict__ ada_w, const float* __restrict__ ada_b, float* __restrict__ mod) {
    __shared__ float cond[4][1024];
    const int tid = threadIdx.x, n = blockIdx.x * 256 + tid, l = blockIdx.y;
    for (int i = tid; i < 4096; i += 256) { float v = c[i]; cond[i >> 10][i & 1023] = v / (1.f + expf(-v)); }
    __syncthreads();
    float a0 = 0.f, a1 = 0.f, a2 = 0.f, a3 = 0.f;
    const float* w = ada_w + (size_t)l * 1024 * 6144 + n;
    for (int k = 0; k < 1024; ++k) { float wv = w[(size_t)k * 6144]; a0 += cond[0][k] * wv; a1 += cond[1][k] * wv; a2 += cond[2][k] * wv; a3 += cond[3][k] * wv; }
    float bb = ada_b[l * 6144 + n];
    mod[(l * 4 + 0) * 6144 + n] = a0 + bb; mod[(l * 4 + 1) * 6144 + n] = a1 + bb; mod[(l * 4 + 2) * 6144 + n] = a2 + bb; mod[(l * 4 + 3) * 6144 + n] = a3 + bb;
}

__global__ void __launch_bounds__(256) n_rope(const int* __restrict__ pos, float* __restrict__ rope) {
    const int i = blockIdx.x * 256 + threadIdx.x;
    if (i >= NT * 16) return;
    const int t = i >> 4, j = i & 15;
    const float inv = exp2f(-(float)j * (13.287712379549449f / 16.f));
    const float ang = (float)pos[t] * inv;
    const double rev = (double)ang * 0.15915494309189535;
    const float fr = (float)(rev - rint(rev));
    rope[i] = __builtin_amdgcn_cosf(fr);
    rope[NT * 16 + i] = __builtin_amdgcn_sinf(fr);
}

__global__ void __launch_bounds__(256) n_dmat(bf16* __restrict__ dm) {
    const size_t i = (size_t)blockIdx.x * 256 + threadIdx.x;
    const int sp = (int)(i >> 13), k = (int)(i & 8191), s = k & 4095;
    const float fr = (float)((sp * s) & 4095) * (1.f / 4096.f);
    const float v = (k < 4096) ? __builtin_amdgcn_cosf(fr) : -__builtin_amdgcn_sinf(fr);
    dm[i] = f2bf(v * (1.f / 512.f));
}

#endif
__device__ __forceinline__ void ld_row(const float* p, int lane, float4 (&v)[4]) {
#pragma unroll
    for (int j = 0; j < 4; ++j) v[j] = ((const float4*)p)[lane + 64 * j];
}
__device__ __forceinline__ void st_row(float* p, int lane, const float4 (&v)[4]) {
#pragma unroll
    for (int j = 0; j < 4; ++j) ((float4*)p)[lane + 64 * j] = v[j];
}
__device__ __forceinline__ void ld_row_bf(const bf16* p, int lane, float4 (&v)[4]) {
#pragma unroll
    for (int j = 0; j < 4; ++j) { uint2 u = ((const uint2*)p)[lane + 64 * j];
        v[j].x = __uint_as_float(u.x << 16); v[j].y = __uint_as_float(u.x & 0xffff0000u); v[j].z = __uint_as_float(u.y << 16); v[j].w = __uint_as_float(u.y & 0xffff0000u); }
}
typedef __bf16 nbf2_t __attribute__((ext_vector_type(2))); typedef float nf2_t __attribute__((ext_vector_type(2)));
__device__ __forceinline__ unsigned pkbf(float lo, float hi) { nf2_t v = {lo, hi}; nbf2_t b = __builtin_convertvector(v, nbf2_t); return __builtin_bit_cast(unsigned, b); }
__device__ __forceinline__ void st_row_bf(bf16* p, int lane, const float4 (&v)[4]) {
#pragma unroll
    for (int j = 0; j < 4; ++j) { uint2 u; u.x = pkbf(v[j].x, v[j].y); u.y = pkbf(v[j].z, v[j].w); ((uint2*)p)[lane + 64 * j] = u; }
}
__device__ __forceinline__ unsigned pack_fp8x4(float a, float b, float c, float d) { int w = __builtin_amdgcn_cvt_pk_fp8_f32(a, b, 0, false); w = __builtin_amdgcn_cvt_pk_fp8_f32(c, d, w, true); return (unsigned)w; }
__device__ __forceinline__ void st_row_fp8(unsigned char* p, int lane, const float4 (&v)[4]) {
#pragma unroll
    for (int j = 0; j < 4; ++j) ((unsigned*)p)[lane + 64 * j] = pack_fp8x4(v[j].x, v[j].y, v[j].z, v[j].w);
}
__device__ __forceinline__ void ln_inplace(float4 (&v)[4], float eps) {
    float s = 0.f;
#pragma unroll
    for (int j = 0; j < 4; ++j) s += (v[j].x + v[j].y) + (v[j].z + v[j].w);
    const float mean = wsum(s) * (1.f / 1024.f);
    float s2 = 0.f;
#pragma unroll
    for (int j = 0; j < 4; ++j) { v[j].x -= mean; v[j].y -= mean; v[j].z -= mean; v[j].w -= mean; s2 += (v[j].x * v[j].x + v[j].y * v[j].y) + (v[j].z * v[j].z + v[j].w * v[j].w); }
    const float rstd = rsqrtf(wsum(s2) * (1.f / 1024.f) + eps);
#pragma unroll
    for (int j = 0; j < 4; ++j) { v[j].x *= rstd; v[j].y *= rstd; v[j].z *= rstd; v[j].w *= rstd; }
}
struct PVec { float4 v[4]; };
__device__ __forceinline__ void ld_pvec(const float* p, int lane, PVec& o) {
#pragma unroll
    for (int j = 0; j < 4; ++j) o.v[j] = ((const float4*)p)[lane + 64 * j];
}
__device__ __forceinline__ void modulate(float4 (&v)[4], const PVec& sc, const PVec& sh) {
#pragma unroll
    for (int j = 0; j < 4; ++j) { const float4 a = sc.v[j], b = sh.v[j];
        v[j].x = v[j].x * (1.f + a.x) + b.x; v[j].y = v[j].y * (1.f + a.y) + b.y; v[j].z = v[j].z * (1.f + a.z) + b.z; v[j].w = v[j].w * (1.f + a.w) + b.w; }
}
__device__ __forceinline__ void resid_ln(float4 (&x)[4], const float4 (&o)[4], const PVec& g, const PVec& gamma, const PVec& beta) {
#pragma unroll
    for (int j = 0; j < 4; ++j) { const float4 a = g.v[j];
        x[j].x = ALPHA * x[j].x + a.x * o[j].x; x[j].y = ALPHA * x[j].y + a.y * o[j].y; x[j].z = ALPHA * x[j].z + a.z * o[j].z; x[j].w = ALPHA * x[j].w + a.w * o[j].w; }
    ln_inplace(x, 1e-5f);
#pragma unroll
    for (int j = 0; j < 4; ++j) { const float4 a = gamma.v[j], b = beta.v[j];
        x[j].x = x[j].x * a.x + b.x; x[j].y = x[j].y * a.y + b.y; x[j].z = x[j].z * a.z + b.z; x[j].w = x[j].w * a.w + b.w; }
}

__device__ __forceinline__ float wmax(float v) {
    v = fmaxf(v, dppf<0xB1>(v)); v = fmaxf(v, dppf<0x4E>(v)); v = fmaxf(v, dppf<0x141>(v)); v = fmaxf(v, dppf<0x140>(v));
    { auto rr = __builtin_amdgcn_permlane16_swap(__float_as_uint(v), __float_as_uint(v), false, false); v = fmaxf(__uint_as_float(rr[0]), __uint_as_float(rr[1])); }
    { auto rr = __builtin_amdgcn_permlane32_swap(__float_as_uint(v), __float_as_uint(v), false, false); v = fmaxf(__uint_as_float(rr[0]), __uint_as_float(rr[1])); }
    return v;
}
__device__ __forceinline__ float xpose_reduce32(const float (&p)[32], int lane) {
    const bool b5 = (lane & 32) != 0, b4 = (lane & 16) != 0, b3 = (lane & 8) != 0, b2 = (lane & 4) != 0, b1 = (lane & 2) != 0;
    float q[16];
#pragma unroll
    for (int e = 0; e < 16; ++e) { const float send = b5 ? p[e] : p[e + 16], keep = b5 ? p[e + 16] : p[e];
        auto rr = __builtin_amdgcn_permlane32_swap(__float_as_uint(send), __float_as_uint(send), false, false);
        q[e] = keep + (b5 ? __uint_as_float(rr[0]) : __uint_as_float(rr[1])); }
    float r8[8];
#pragma unroll
    for (int e = 0; e < 8; ++e) { const float send = b4 ? q[e] : q[e + 8], keep = b4 ? q[e + 8] : q[e];
        auto rr = __builtin_amdgcn_permlane16_swap(__float_as_uint(send), __float_as_uint(send), false, false);
        r8[e] = keep + (b4 ? __uint_as_float(rr[0]) : __uint_as_float(rr[1])); }
    float r4[4];
#pragma unroll
    for (int e = 0; e < 4; ++e) { const float send = b3 ? r8[e] : r8[e + 4], keep = b3 ? r8[e + 4] : r8[e]; r4[e] = keep + dppf<0x128>(send); }
    float r2[2];
#pragma unroll
    for (int e = 0; e < 2; ++e) { const float send = b2 ? r4[e] : r4[e + 2], keep = b2 ? r4[e + 2] : r4[e]; r2[e] = keep + __shfl_xor(send, 4); }
    float r1;
    { const float send = b1 ? r2[0] : r2[1], keep = b1 ? r2[1] : r2[0]; r1 = keep + dppf<0x4E>(send); }
    r1 += dppf<0xB1>(r1);
    return r1;
}
__device__ __forceinline__ void top4_gates(float lg, int lane, int (&ei)[4], float (&gv)[4]) {
    float tv[4];
#pragma unroll
    for (int k = 0; k < 4; ++k) { const float m = wmax(lg); const unsigned long long bal = __ballot(lg == m); const int e = (__builtin_ctzll(bal) >> 1) & 31;
        ei[k] = e; tv[k] = m; lg = (((lane >> 1) & 31) == e) ? -3.0e38f : lg; }
    float s = 0.f;
#pragma unroll
    for (int k = 0; k < 4; ++k) { gv[k] = expf(tv[k] - tv[0]); s += gv[k]; }
    const float inv = 1.f / s;
#pragma unroll
    for (int k = 0; k < 4; ++k) gv[k] *= inv;
}
__device__ __forceinline__ void route_rows2(const float4 (&h0)[4], const float4 (&h1)[4], const float* wl, const float* __restrict__ br, int lane, int (&ei0)[4], float (&gv0)[4], int (&ei1)[4], float (&gv1)[4]) {
    float p0[32], p1[32];
#pragma unroll
    for (int e = 0; e < 32; ++e) { const float4* w = (const float4*)(wl + e * 1024); float a0 = 0.f, a1 = 0.f;
#pragma unroll
        for (int j = 0; j < 4; ++j) { const float4 ww = w[lane + 64 * j];
            a0 += (h0[j].x * ww.x + h0[j].y * ww.y) + (h0[j].z * ww.z + h0[j].w * ww.w);
            a1 += (h1[j].x * ww.x + h1[j].y * ww.y) + (h1[j].z * ww.z + h1[j].w * ww.w); }
        p0[e] = a0; p1[e] = a1; }
    const float bias = br[(lane >> 1) & 31];
    const float l0 = xpose_reduce32(p0, lane) + bias, l1 = xpose_reduce32(p1, lane) + bias;
    top4_gates(l0, lane, ei0, gv0); top4_gates(l1, lane, ei1, gv1);
}

struct RowArgs {
    const float* xin;
    const float* o;
    float* xout;
    bf16* h;
    const float* mod;
    const float* mod_next;
    const float* gamma; const float* beta;
    const float* wr; const float* br;
    int* topi; int* tpos; float* gate; int* list; unsigned* cnt;
    const bf16* y; const unsigned* cntc;
    unsigned char* h8;
    const bf16* xin_bf; bf16* xout_bf; const bf16* o_bf;
    int final_; int pad;
};

constexpr int RP_LDS_W = 32 * 1024 * 4;
constexpr int RP_LDS_BYTES = RP_LDS_W + 2048 + 512;

__device__ __forceinline__ void rp_a_chunk(const RowArgs& a, int chunk, int wave, int lane) {
    const int b = (chunk * 64) >> 12; PVec sc, sh; ld_pvec(a.mod + b * 6144 + 1024, lane, sc); ld_pvec(a.mod + b * 6144, lane, sh);
    for (int i0 = wave; i0 < 64; i0 += 16) {
        float4 v[2][4];
#pragma unroll
        for (int u = 0; u < 2; ++u) ld_row(a.xin + (size_t)(chunk * 64 + i0 + 8 * u) * DM, lane, v[u]);
#pragma unroll
        for (int u = 0; u < 2; ++u) { ln_inplace(v[u], 1e-6f); modulate(v[u], sc, sh); st_row_bf(a.h + (size_t)(chunk * 64 + i0 + 8 * u) * DM, lane, v[u]); } }
}
__device__ __forceinline__ void rp_b_chunk(const RowArgs& a, int chunk, int wave, int lane, char* lds) {
    const float* wl = (const float*)lds;
    int* se = (int*)(lds + RP_LDS_W); int* sp = se + 256; int* lcnt = sp + 256; int* base = lcnt + 32;
    const int tid = wave * 64 + lane;
    if (tid < 32) lcnt[tid] = 0;
    __syncthreads();
    const float* mb = a.mod + ((chunk * 64) >> 12) * 6144;
    float4 xrf[2][4]; uint2 xrb[2][4], orb[2][4]; float4 orf[2][4];
#define RPB_LOADX(ii) do { _Pragma("unroll") for (int u = 0; u < 2; ++u) { const size_t ro_ = (size_t)(chunk * 64 + (ii) + 8 * u) * DM; \
        if (a.xin_bf) { _Pragma("unroll") for (int j = 0; j < 4; ++j) xrb[u][j] = ((const uint2*)(a.xin_bf + ro_))[lane + 64 * j]; } \
        else { _Pragma("unroll") for (int j = 0; j < 4; ++j) xrf[u][j] = ((const float4*)(a.xin + ro_))[lane + 64 * j]; } } } while (0)
#define RPB_LOADO(ii) do { _Pragma("unroll") for (int u = 0; u < 2; ++u) { const size_t ro_ = (size_t)(chunk * 64 + (ii) + 8 * u) * DM; \
        if (a.o_bf) { _Pragma("unroll") for (int j = 0; j < 4; ++j) orb[u][j] = ((const uint2*)(a.o_bf + ro_))[lane + 64 * j]; } \
        else { _Pragma("unroll") for (int j = 0; j < 4; ++j) orf[u][j] = ((const float4*)(a.o + ro_))[lane + 64 * j]; } } } while (0)
#define RPB_LOADRAW(ii) do { RPB_LOADX(ii); if (a.xin_bf) RPB_LOADO(ii); } while (0)
    RPB_LOADRAW(wave);
    for (int i0 = wave; i0 < 64; i0 += 16) {
        float4 x[2][4], o[2][4];
        if (!a.xin_bf) RPB_LOADO(i0);
#pragma unroll
        for (int u = 0; u < 2; ++u)
#pragma unroll
            for (int j = 0; j < 4; ++j) {
                if (a.xin_bf) { const uint2 w = xrb[u][j]; x[u][j] = make_float4(__uint_as_float(w.x << 16), __uint_as_float(w.x & 0xffff0000u), __uint_as_float(w.y << 16), __uint_as_float(w.y & 0xffff0000u)); } else x[u][j] = xrf[u][j];
                if (a.o_bf) { const uint2 w = orb[u][j]; o[u][j] = make_float4(__uint_as_float(w.x << 16), __uint_as_float(w.x & 0xffff0000u), __uint_as_float(w.y << 16), __uint_as_float(w.y & 0xffff0000u)); } else o[u][j] = orf[u][j]; }
        PVec pg, pgam, pbet, psc, psh; ld_pvec(mb + 2048, lane, pg); ld_pvec(a.gamma, lane, pgam); ld_pvec(a.beta, lane, pbet); ld_pvec(mb + 4096, lane, psc); ld_pvec(mb + 3072, lane, psh);
#pragma unroll
        for (int u = 0; u < 2; ++u) { const int r = chunk * 64 + i0 + 8 * u;
            resid_ln(x[u], o[u], pg, pgam, pbet);
            if (a.xout_bf) st_row_bf(a.xout_bf + (size_t)r * DM, lane, x[u]); else st_row(a.xout + (size_t)r * DM, lane, x[u]);
            ln_inplace(x[u], 1e-6f);
            modulate(x[u], psc, psh);
            if (a.h) st_row_bf(a.h + (size_t)r * DM, lane, x[u]);
            if (a.h8) st_row_fp8(a.h8 + (size_t)r * DM, lane, x[u]); }
        { const int inext = (i0 + 16 < 64) ? i0 + 16 : i0; RPB_LOADRAW(inext); }
        int ei[2][4]; float gv[2][4]; route_rows2(x[0], x[1], wl, a.br, lane, ei[0], gv[0], ei[1], gv[1]);
#pragma unroll
        for (int u = 0; u < 2; ++u) { const int i = i0 + 8 * u, r = chunk * 64 + i;
            if (lane < 4) { const int e = (lane == 0) ? ei[u][0] : (lane == 1) ? ei[u][1] : (lane == 2) ? ei[u][2] : ei[u][3];
                const float g = (lane == 0) ? gv[u][0] : (lane == 1) ? gv[u][1] : (lane == 2) ? gv[u][2] : gv[u][3];
                const int lp = atomicAdd(&lcnt[e], 1);
                se[i * 4 + lane] = e; sp[i * 4 + lane] = lp;
                a.topi[r * 4 + lane] = e; a.gate[r * 4 + lane] = g; } }
    }
#undef RPB_LOADRAW
#undef RPB_LOADX
#undef RPB_LOADO
    __syncthreads();
    if (tid < 32) base[tid] = (int)atomicAdd(&a.cnt[tid], (unsigned)lcnt[tid]);
    __syncthreads();
    if (tid < 256) { const int r = chunk * 64 + (tid >> 2), e = se[tid], pos = base[e] + sp[tid];
        a.tpos[r * 4 + (tid & 3)] = pos; a.list[e * NT + pos] = r; }
    __syncthreads();
}
__device__ __forceinline__ void rp_c_chunk(const RowArgs& a, int chunk, int wave, int lane, const int* poff, bool final_) {
    int myslot = 0; float myg = 0.f;
    if (lane < 32) { const int r = chunk * 64 + wave + 8 * (lane >> 2), k = lane & 3; const int e = a.topi[r * 4 + k]; myslot = poff[e] + a.tpos[r * 4 + k]; myg = a.gate[r * 4 + k]; }
    const float* mb = a.mod + ((chunk * 64) >> 12) * 6144;
    PVec pg, pgam, pbet, psc, psh; ld_pvec(mb + 5120, lane, pg); ld_pvec(a.gamma, lane, pgam); ld_pvec(a.beta, lane, pbet);
    if (!final_) { const float* mn = a.mod_next + ((chunk * 64) >> 12) * 6144; ld_pvec(mn + 1024, lane, psc); ld_pvec(mn, lane, psh); }
    for (int it = 0; it < 8; it += 2) {
        float4 x[2][4]; uint2 yr[2][4][4]; float g[2][4];
#pragma unroll
        for (int u = 0; u < 2; ++u) { const int r = chunk * 64 + wave + 8 * (it + u);
            if (a.xin_bf) ld_row_bf(a.xin_bf + (size_t)r * DM, lane, x[u]); else ld_row(a.xin + (size_t)r * DM, lane, x[u]);
#pragma unroll
            for (int k = 0; k < 4; ++k) { const int slot = __builtin_amdgcn_readlane(myslot, 4 * (it + u) + k); g[u][k] = __int_as_float(__builtin_amdgcn_readlane(__float_as_int(myg), 4 * (it + u) + k));
                const uint2* yp = (const uint2*)(a.y + (size_t)slot * DM);
#pragma unroll
                for (int j = 0; j < 4; ++j) yr[u][k][j] = yp[lane + 64 * j]; } }
#pragma unroll
        for (int u = 0; u < 2; ++u) { const int r = chunk * 64 + wave + 8 * (it + u);
            float4 o[4];
#pragma unroll
            for (int j = 0; j < 4; ++j) { o[j] = make_float4(0.f, 0.f, 0.f, 0.f);
#pragma unroll
                for (int k = 0; k < 4; ++k) { const uint2 w = yr[u][k][j]; const float gg = g[u][k];
                    o[j].x += gg * __uint_as_float(w.x << 16); o[j].y += gg * __uint_as_float(w.x & 0xffff0000u); o[j].z += gg * __uint_as_float(w.y << 16); o[j].w += gg * __uint_as_float(w.y & 0xffff0000u); } }
            resid_ln(x[u], o, pg, pgam, pbet);
            if (a.xout_bf) st_row_bf(a.xout_bf + (size_t)r * DM, lane, x[u]); else st_row(a.xout + (size_t)r * DM, lane, x[u]);
            if (!final_) { ln_inplace(x[u], 1e-6f); modulate(x[u], psc, psh); st_row_bf(a.h + (size_t)r * DM, lane, x[u]); } }
    }
}
__device__ __forceinline__ void compute_poff(const unsigned* cnt, int* poff, int tid) {
    if (tid < 64) { const int v = (tid < 32) ? (((int)cnt[tid] + 255) & ~255) : 0; int x = v;
#pragma unroll
        for (int o = 1; o < 32; o <<= 1) { const int y = __shfl_up(x, o); if (tid >= o) x += y; }
        if (tid < 32) poff[tid] = x - v;
        if (tid == 31) poff[32] = x; }
}
__device__ __forceinline__ void load_wl(const float* wr, char* lds, int tid) {
    float* wl = (float*)lds; float4 v[16];
#pragma unroll
    for (int k = 0; k < 16; ++k) v[k] = ((const float4*)wr)[tid + 512 * k];
#pragma unroll
    for (int k = 0; k < 16; ++k) { const int i4 = tid + 512 * k, c = i4 >> 3, e0 = (i4 & 7) * 4;
        wl[(e0 + 0) * 1024 + c] = v[k].x; wl[(e0 + 1) * 1024 + c] = v[k].y; wl[(e0 + 2) * 1024 + c] = v[k].z; wl[(e0 + 3) * 1024 + c] = v[k].w; }
}

#if HYBRID
__global__ void __launch_bounds__(512) k_rp_a(RowArgs a) {
    const int wave = threadIdx.x >> 6, lane = threadIdx.x & 63;
    for (int ch = blockIdx.x; ch < NT / 64; ch += gridDim.x) rp_a_chunk(a, ch, wave, lane);
}
__global__ void __launch_bounds__(512) k_rp_b(RowArgs a) {
    extern __shared__ __attribute__((aligned(16))) char lds[];
    const int wave = threadIdx.x >> 6, lane = threadIdx.x & 63;
    load_wl(a.wr, lds, threadIdx.x);
    __syncthreads();
    for (int ch = blockIdx.x; ch < NT / 64; ch += gridDim.x) rp_b_chunk(a, ch, wave, lane, lds);
}
__global__ void __launch_bounds__(512) k_rp_c(RowArgs a) {
    __shared__ int poff[36];
    const int wave = threadIdx.x >> 6, lane = threadIdx.x & 63;
    compute_poff(a.cntc, poff, threadIdx.x);
    __syncthreads();
    for (int ch = blockIdx.x; ch < NT / 64; ch += gridDim.x) rp_c_chunk(a, ch, wave, lane, poff, a.final_ != 0);
}

#endif
#if HYBRID
struct EpiF32 { float* C; int ldc; int pad; __device__ void operator()(int r, int c, float v) const { C[(size_t)r * ldc + c] = v; } };
struct EpiBf { bf16* C; int ldc; int pad; __device__ void operator()(int r, int c, float v) const { C[(size_t)r * ldc + c] = f2bf(v); } };
struct EpiP2 { bf16* cq; bf16* ckv; float* kr; bf16* uf;
    __device__ void operator()(int r, int c, float v) const {
        if (c < 256) cq[(size_t)r * 256 + c] = f2bf(v); else if (c < 384) ckv[(size_t)r * 128 + c - 256] = f2bf(v);
        else if (c < 416) kr[(size_t)r * 32 + c - 384] = v; else uf[(size_t)r * 512 + c - 416] = f2bf(v); } };
struct EpiQ { float* tq; const float* rq; __device__ void operator()(int r, int c, float v) const { tq[(size_t)r * 768 + c] = v * rq[r] * 0.10206207261596575f; } };
struct EpiKV { bf16* o; const float* rkv; int hd; int pad;
    __device__ void operator()(int r, int c, float v) const { const int b = r >> 12, s = r & 4095, h = c >> 6, d = c & 63;
        o[(((size_t)(b * NH + h)) * NS + s) * hd + d] = f2bf(v * rkv[r]); } };
struct EpiFnet { bf16* ocat;
    __device__ void operator()(int r, int c, float v) const { const int b = c >> 9, cc = c & 511; ocat[((size_t)(b * NS + r)) * DM + 512 + cc] = f2bf(v); } };

template <typename TA, bool BNT, typename Epi>
__global__ void __launch_bounds__(256) n_gemm(const TA* __restrict__ A, const void* __restrict__ Bp, const float* __restrict__ ascale, Epi epi, int lda, int ldb, int M, int N, int K, int pad_) {
    __shared__ float As[16][68];
    __shared__ float Bs[16][68];
    const int tid = threadIdx.x, tx = tid & 15, ty = tid >> 4, m0 = blockIdx.y * 64, n0 = blockIdx.x * 64;
    float acc[4][4];
#pragma unroll
    for (int i = 0; i < 4; ++i)
#pragma unroll
        for (int j = 0; j < 4; ++j) acc[i][j] = 0.f;
    for (int k0 = 0; k0 < K; k0 += 16) {
        { const int r = tid >> 2, kk = (tid & 3) * 4, gr = m0 + r;
#pragma unroll
          for (int i = 0; i < 4; ++i) { float v = 0.f; if (gr < M) { v = tof(A[(size_t)gr * lda + k0 + kk + i]); if (ascale) v *= ascale[k0 + kk + i]; } As[kk + i][r] = v; } }
        if (!BNT) { const float* B = (const float*)Bp; const int kk = tid >> 4, n = (tid & 15) * 4;
#pragma unroll
          for (int i = 0; i < 4; ++i) Bs[kk][n + i] = (n0 + n + i < N) ? B[(size_t)(k0 + kk) * ldb + n0 + n + i] : 0.f; }
        else { const bf16* B = (const bf16*)Bp; const int n = tid >> 2, kk = (tid & 3) * 4;
#pragma unroll
          for (int i = 0; i < 4; ++i) Bs[kk + i][n] = (n0 + n < N) ? bf2f(B[(size_t)(n0 + n) * ldb + k0 + kk + i]) : 0.f; }
        __syncthreads();
#pragma unroll
        for (int kk = 0; kk < 16; ++kk) { float a[4], b[4];
#pragma unroll
            for (int i = 0; i < 4; ++i) { a[i] = As[kk][ty * 4 + i]; b[i] = Bs[kk][tx * 4 + i]; }
#pragma unroll
            for (int i = 0; i < 4; ++i)
#pragma unroll
                for (int j = 0; j < 4; ++j) acc[i][j] += a[i] * b[j]; }
        __syncthreads();
    }
#pragma unroll
    for (int i = 0; i < 4; ++i)
#pragma unroll
        for (int j = 0; j < 4; ++j) { const int r = m0 + ty * 4 + i, c = n0 + tx * 4 + j; if (r < M && c < N) epi(r, c, acc[i][j]); }
}

__global__ void __launch_bounds__(256) n_moe_up(const bf16* __restrict__ H, const float* __restrict__ wg, const float* __restrict__ bg, const float* __restrict__ wlin, const float* __restrict__ blin,
                                               const int* __restrict__ list, const unsigned* __restrict__ cnt, bf16* __restrict__ aact) {
    __shared__ float As[16][68];
    __shared__ float Bg[16][68];
    __shared__ float Bl[16][68];
    __shared__ int poff[36];
    const int e = blockIdx.z, M = (int)cnt[e], m0 = blockIdx.y * 64, n0 = blockIdx.x * 64;
    if (m0 >= M) return;
    const int tid = threadIdx.x, tx = tid & 15, ty = tid >> 4;
    compute_poff(cnt, poff, tid);
    const float* W1 = wg + (size_t)e * DM * DM; const float* W2 = wlin + (size_t)e * DM * DM;
    float ag[4][4], al[4][4];
#pragma unroll
    for (int i = 0; i < 4; ++i)
#pragma unroll
        for (int j = 0; j < 4; ++j) { ag[i][j] = 0.f; al[i][j] = 0.f; }
    const int r = tid >> 2, gr = m0 + r; const int src = (gr < M) ? list[e * NT + gr] : 0;
    for (int k0 = 0; k0 < DM; k0 += 16) {
        { const int kk = (tid & 3) * 4;
#pragma unroll
          for (int i = 0; i < 4; ++i) As[kk + i][r] = (gr < M) ? bf2f(H[(size_t)src * DM + k0 + kk + i]) : 0.f; }
        { const int kk = tid >> 4, n = (tid & 15) * 4;
#pragma unroll
          for (int i = 0; i < 4; ++i) { Bg[kk][n + i] = W1[(size_t)(k0 + kk) * DM + n0 + n + i]; Bl[kk][n + i] = W2[(size_t)(k0 + kk) * DM + n0 + n + i]; } }
        __syncthreads();
#pragma unroll
        for (int kk = 0; kk < 16; ++kk) { float a[4], b1[4], b2[4];
#pragma unroll
            for (int i = 0; i < 4; ++i) { a[i] = As[kk][ty * 4 + i]; b1[i] = Bg[kk][tx * 4 + i]; b2[i] = Bl[kk][tx * 4 + i]; }
#pragma unroll
            for (int i = 0; i < 4; ++i)
#pragma unroll
                for (int j = 0; j < 4; ++j) { ag[i][j] += a[i] * b1[j]; al[i][j] += a[i] * b2[j]; } }
        __syncthreads();
    }
    const int po = poff[e];
#pragma unroll
    for (int i = 0; i < 4; ++i)
#pragma unroll
        for (int j = 0; j < 4; ++j) { const int rr = m0 + ty * 4 + i, c = n0 + tx * 4 + j;
            if (rr < M) aact[(size_t)(po + rr) * DM + c] = f2bf(swiglu(ag[i][j] + bg[e * DM + c], al[i][j] + blin[e * DM + c])); }
}
__global__ void __launch_bounds__(256) n_moe_down(const bf16* __restrict__ aact, const float* __restrict__ wd, const float* __restrict__ bd, const unsigned* __restrict__ cnt, bf16* __restrict__ Y) {
    __shared__ float As[16][68];
    __shared__ float Bs[16][68];
    __shared__ int poff[36];
    const int e = blockIdx.z, M = (int)cnt[e], m0 = blockIdx.y * 64, n0 = blockIdx.x * 64;
    if (m0 >= M) return;
    const int tid = threadIdx.x, tx = tid & 15, ty = tid >> 4;
    compute_poff(cnt, poff, tid);
    __syncthreads();
    const int po = poff[e];
    const float* W = wd + (size_t)e * DM * DM;
    float acc[4][4];
#pragma unroll
    for (int i = 0; i < 4; ++i)
#pragma unroll
        for (int j = 0; j < 4; ++j) acc[i][j] = 0.f;
    const int r = tid >> 2, gr = m0 + r;
    for (int k0 = 0; k0 < DM; k0 += 16) {
        { const int kk = (tid & 3) * 4;
#pragma unroll
          for (int i = 0; i < 4; ++i) As[kk + i][r] = (gr < M) ? bf2f(aact[(size_t)(po + gr) * DM + k0 + kk + i]) : 0.f; }
        { const int kk = tid >> 4, n = (tid & 15) * 4;
#pragma unroll
          for (int i = 0; i < 4; ++i) Bs[kk][n + i] = W[(size_t)(k0 + kk) * DM + n0 + n + i]; }
        __syncthreads();
#pragma unroll
        for (int kk = 0; kk < 16; ++kk) { float a[4], b[4];
#pragma unroll
            for (int i = 0; i < 4; ++i) { a[i] = As[kk][ty * 4 + i]; b[i] = Bs[kk][tx * 4 + i]; }
#pragma unroll
            for (int i = 0; i < 4; ++i)
#pragma unroll
                for (int j = 0; j < 4; ++j) acc[i][j] += a[i] * b[j]; }
        __syncthreads();
    }
#pragma unroll
    for (int i = 0; i < 4; ++i)
#pragma unroll
        for (int j = 0; j < 4; ++j) { const int rr = m0 + ty * 4 + i, c = n0 + tx * 4 + j;
            if (rr < M) Y[(size_t)(po + rr) * DM + c] = f2bf(acc[i][j] + bd[e * DM + c]); }
}

__global__ void __launch_bounds__(256) n_kpe(const float* __restrict__ kr, const float* __restrict__ rope, bf16* __restrict__ kpe) {
    const int i = blockIdx.x * 256 + threadIdx.x; if (i >= NT * 16) return;
    const int t = i >> 4, j = i & 15; const float c = rope[i], s = rope[NT * 16 + i];
    const float t1 = kr[t * 32 + j], t2 = kr[t * 32 + 16 + j];
    kpe[t * 32 + j] = f2bf(t1 * c - t2 * s); kpe[t * 32 + 16 + j] = f2bf(t2 * c + t1 * s);
}
__global__ void __launch_bounds__(256) n_rms(const bf16* __restrict__ cq, const bf16* __restrict__ ckv, float* __restrict__ rq, float* __restrict__ rkv) {
    const int t = blockIdx.x * 256 + threadIdx.x; if (t >= NT) return;
    float s = 0.f; for (int k = 0; k < 256; ++k) { float v = bf2f(cq[(size_t)t * 256 + k]); s += v * v; }
    rq[t] = rsqrtf(s * (1.f / 256.f) + 1e-6f);
    s = 0.f; for (int k = 0; k < 128; ++k) { float v = bf2f(ckv[(size_t)t * 128 + k]); s += v * v; }
    rkv[t] = rsqrtf(s * (1.f / 128.f) + 1e-6f);
}
__global__ void __launch_bounds__(256) n_qfin(const float* __restrict__ tq, const float* __restrict__ rope, bf16* __restrict__ Q) {
    const int i = blockIdx.x * 256 + threadIdx.x; if (i >= NT * 768) return;
    const int t = i / 768, c = i % 768, h = c / 96, d = c % 96, b = t >> 12, s = t & 4095;
    float v;
    if (d < 64) v = tq[i];
    else { const int j = (d - 64) & 15; const float cs = rope[t * 16 + j], sn = rope[NT * 16 + t * 16 + j];
        const float t1 = tq[(size_t)t * 768 + h * 96 + 64 + j], t2 = tq[(size_t)t * 768 + h * 96 + 80 + j];
        v = (d < 80) ? (t1 * cs - t2 * sn) : (t2 * cs + t1 * sn); }
    Q[(((size_t)(b * NH + h)) * NS + s) * QKD + d] = f2bf(v);
}
__global__ void __launch_bounds__(256) n_kcopy(const bf16* __restrict__ kpe, bf16* __restrict__ K) {
    const int i = blockIdx.x * 256 + threadIdx.x; if (i >= NT * NH * 32) return;
    const int j = i & 31, h = (i >> 5) & 7, t = i >> 8, b = t >> 12, s = t & 4095;
    K[(((size_t)(b * NH + h)) * NS + s) * QKD + 64 + j] = kpe[t * 32 + j];
}
__global__ void __launch_bounds__(256) n_fnet_ch(const bf16* __restrict__ uf, bf16* __restrict__ ucs) {
    const int s = blockIdx.x * 256 + threadIdx.x, j = blockIdx.y, b = blockIdx.z, g = j >> 6, jj = j & 63, t = b * NS + s;
    float uc = 0.f, us = 0.f;
    for (int c = 0; c < 64; ++c) { const float fr = (float)((c * jj) & 63) * (1.f / 64.f); const float u = bf2f(uf[(size_t)t * 512 + g * 64 + c]);
        uc += u * __builtin_amdgcn_cosf(fr); us += u * __builtin_amdgcn_sinf(fr); }
    ucs[((size_t)(b * 512 + j)) * 8192 + s] = f2bf(uc); ucs[((size_t)(b * 512 + j)) * 8192 + 4096 + s] = f2bf(us);
}
__global__ void __launch_bounds__(256) n_attn(const bf16* __restrict__ Q, const bf16* __restrict__ K, const bf16* __restrict__ V, bf16* __restrict__ ocat) {
    __shared__ float Ks[32][96];
    __shared__ float Vs[32][64];
    const int tid = threadIdx.x, b = blockIdx.z, h = blockIdx.y, s = blockIdx.x * 256 + tid;
    const size_t bh = (size_t)(b * NH + h) * NS;
    float q[96], o[64];
#pragma unroll
    for (int d = 0; d < 96; ++d) q[d] = bf2f(Q[(bh + s) * QKD + d]);
#pragma unroll
    for (int d = 0; d < 64; ++d) o[d] = 0.f;
    float m = -1e30f, l = 0.f;
    for (int kt = 0; kt < NS / 32; ++kt) {
        __syncthreads();
        for (int i = tid; i < 32 * 96; i += 256) Ks[i / 96][i % 96] = bf2f(K[(bh + kt * 32) * QKD + i]);
        for (int i = tid; i < 32 * 64; i += 256) Vs[i >> 6][i & 63] = bf2f(V[(bh + kt * 32) * VH + i]);
        __syncthreads();
        for (int j = 0; j < 32; ++j) {
            float sc = 0.f;
#pragma unroll
            for (int d = 0; d < 96; ++d) sc += q[d] * Ks[j][d];
            if (sc > m) { const float a = __expf(m - sc); l *= a;
#pragma unroll
                for (int d = 0; d < 64; ++d) o[d] *= a;
                m = sc; }
            const float p = __expf(sc - m); l += p;
#pragma unroll
            for (int d = 0; d < 64; ++d) o[d] += p * Vs[j][d];
        }
    }
    const float inv = 1.f / l;
#pragma unroll
    for (int d = 0; d < 64; ++d) ocat[((size_t)(b * NS + s)) * DM + h * 64 + d] = f2bf(o[d] * inv);
}
__global__ void __launch_bounds__(256) n_conv(const bf16* __restrict__ pc, const float* __restrict__ cw, bf16* __restrict__ yc) {
    const int i = blockIdx.x * 256 + threadIdx.x; if (i >= NT * DM) return;
    const int t = i >> 10, c = i & 1023, s = t & 4095;
    const bf16* row = pc + (size_t)t * 3072;
    const float u1 = bf2f(row[1024 + c]) * bf2f(row[2048 + c]);
    const float u0 = (s > 0) ? bf2f(row[1024 + c - 3072]) * bf2f(row[2048 + c - 3072]) : 0.f;
    const float u2 = (s < NS - 1) ? bf2f(row[1024 + c + 3072]) * bf2f(row[2048 + c + 3072]) : 0.f;
    const float y = u0 * cw[c] + u1 * cw[1024 + c] + u2 * cw[2048 + c];
    yc[i] = f2bf(bf2f(row[c]) * y);
}

#endif
#define GAS __attribute__((address_space(1)))
#define LAS __attribute__((address_space(3)))
typedef unsigned v4u __attribute__((ext_vector_type(4)));
typedef unsigned v2u __attribute__((ext_vector_type(2)));
typedef float f32x4 __attribute__((ext_vector_type(4)));
typedef float f32x2 __attribute__((ext_vector_type(2)));
typedef short bf16x8 __attribute__((ext_vector_type(8)));
typedef short bf16x16 __attribute__((ext_vector_type(16)));
typedef float f32x16 __attribute__((ext_vector_type(16)));
typedef short s16x4 __attribute__((ext_vector_type(4)));
typedef GAS unsigned gu32;
#define RLX_AGENT __ATOMIC_RELAXED, __HIP_MEMORY_SCOPE_AGENT
#define LDS_WAIT() asm volatile("s_waitcnt lgkmcnt(0)" ::: "memory")
#define VM_WAIT() asm volatile("s_waitcnt vmcnt(0)" ::: "memory")

constexpr int NWAVES = 8;
constexpr int SCR_BYTES = 151552;
constexpr int MISC_OFF = SCR_BYTES;
constexpr int LDS_BYTES = 155648;

constexpr size_t WS_WIN = 528 * MiB, WS_WUQ = 530 * MiB, WS_WUKV = 531 * MiB, WS_WOUT0 = 532 * MiB, WS_WCIN = 534 * MiB, WS_WCOUT = 540 * MiB, WS_CST = 542 * MiB;
constexpr size_t WS_WUP = 544 * MiB, WS_WDN = 800 * MiB, WS_H8 = 928 * MiB, WS_END2 = 944 * MiB;
#ifndef MOE_FP8
#define MOE_FP8 1
#endif
typedef int v8i __attribute__((ext_vector_type(8)));
typedef int v4i __attribute__((ext_vector_type(4)));
constexpr int CW_BAR = 4096;

__device__ __forceinline__ unsigned pk2(float lo, float hi) { return (unsigned)f2bf(lo) | ((unsigned)f2bf(hi) << 16); }
typedef __bf16 bf16x2_t __attribute__((ext_vector_type(2)));
__device__ __forceinline__ unsigned cvt_pk_bf16(float lo, float hi) { f32x2 v = {lo, hi}; bf16x2_t b = __builtin_convertvector(v, bf16x2_t); return __builtin_bit_cast(unsigned, b); }

#define XB_TMO      128
#define XB_XCNT(j)  (256  + 64 * (j))
#define XB_XSUB(j)  (1280 + 64 * (j))
#define XB_XGEN(j)  (2304 + 64 * (j))
#define XB_TOP      3328
#define XB_TOPGEN   3392
#define XCD_BAR_WORDS 3456
#define XB_SPIN_CAP (1u << 20)
__device__ __forceinline__ unsigned xb_ld(unsigned* p)              { return __hip_atomic_load(p, __ATOMIC_RELAXED, __HIP_MEMORY_SCOPE_AGENT); }
__device__ __forceinline__ unsigned xb_add(unsigned* p, unsigned v) { return __hip_atomic_fetch_add(p, v, __ATOMIC_RELAXED, __HIP_MEMORY_SCOPE_AGENT); }
__device__ __forceinline__ unsigned xb_xcc_id() { return (unsigned)__builtin_amdgcn_s_getreg((3 << 11) | 20) & 0xFu; }
#define XB_SPIN(cond, bar) do { unsigned _sp = 0; while (cond) { __builtin_amdgcn_s_sleep(1); \
    if ((++_sp & 255u) == 0u) { if (xb_ld(&(bar)[XB_TMO])) break; if (_sp > XB_SPIN_CAP) { atomicAdd(&(bar)[XB_TMO], 1u); break; } } } } while (0)
struct XcdBarrier { unsigned* bar; unsigned x; volatile LAS unsigned* st; };
__device__ __forceinline__ XcdBarrier xcd_barrier_post(unsigned* bar, volatile LAS unsigned* st) {
    XcdBarrier b; b.bar = bar; b.x = xb_xcc_id(); b.st = st;
    if (threadIdx.x == 0) (void)xb_add(&bar[XB_XCNT(b.x)], 1u);
    return b;
}
__device__ __forceinline__ void xcd_barrier_complete(unsigned* bar, unsigned x, unsigned& nloc, unsigned& nx) {
    const unsigned G = gridDim.x * gridDim.y * gridDim.z;
    unsigned sum, cnt, mine, sp = 0u;
    for (;;) {
        sum = 0u; cnt = 0u; mine = 0u;
#pragma unroll
        for (unsigned j = 0; j < 16; ++j) { const unsigned c = xb_ld(&bar[XB_XCNT(j)]); sum += c; cnt += (c > 0u) ? 1u : 0u; mine = (j == x) ? c : mine; }
        if (sum == G) break;
        __builtin_amdgcn_s_sleep(1);
        if ((++sp & 255u) == 0u) { if (xb_ld(&bar[XB_TMO])) break; if (sp > XB_SPIN_CAP) { atomicAdd(&bar[XB_TMO], 1u); break; } }
    }
    nloc = mine > 0u ? mine : 1u; nx = cnt > 0u ? cnt : 1u;
}
__device__ __forceinline__ void xcd_barrier(const XcdBarrier& b) {
    asm volatile("s_waitcnt vmcnt(0)" ::: "memory");
    __syncthreads();
    if (threadIdx.x == 0) {
        unsigned* bar = b.bar;
        __builtin_amdgcn_s_waitcnt(0);
        unsigned nloc = b.st[0], nx = b.st[1];
        if (nloc == 0u) { xcd_barrier_complete(bar, b.x, nloc, nx); b.st[0] = nloc; b.st[1] = nx; }
        const unsigned old = xb_add(&bar[XB_XSUB(b.x)], 1u);
        const unsigned gen = old / nloc;
        if (old + 1u == (gen + 1u) * nloc) {
            __builtin_amdgcn_fence(__ATOMIC_RELEASE, "agent");
            asm volatile("s_waitcnt vmcnt(0)" ::: "memory");
            const unsigned og = xb_add(&bar[XB_TOP], 1u);
            const unsigned tg = og / nx;
            if (og + 1u == (tg + 1u) * nx) xb_add(&bar[XB_TOPGEN], 1u);
            else XB_SPIN(xb_ld(&bar[XB_TOPGEN]) == tg, bar);
            __builtin_amdgcn_fence(__ATOMIC_ACQUIRE, "agent");
            xb_add(&bar[XB_XGEN(b.x)], 1u);
            asm volatile("s_waitcnt vmcnt(0)" ::: "memory");
        } else {
            XB_SPIN(xb_ld(&bar[XB_XGEN(b.x)]) == gen, bar);
            __builtin_amdgcn_fence(__ATOMIC_ACQUIRE, "agent");
            asm volatile("s_waitcnt vmcnt(0)" ::: "memory");
        }
    }
    __syncthreads();
}

namespace pg8 {
constexpr int BM = 256, BK = 64, HALF = 128, HTB = HALF * BK * 2, STAGE_BYTES = 8 * HTB, NXCD = 8, WGM = 8;
__host__ __device__ __forceinline__ int lds_byte(int r, int c) { const int st = (r >> 4) * 2 + (c >> 5), rr = r & 15, cc = c & 31, ob = rr * 64 + cc * 2; return st * 1024 + (ob ^ (((ob >> 9) & 1) << 5)); }
__host__ __device__ __forceinline__ void stage_rc(int b, int& R, int& C) { const int st = b / 1024, sb = b % 1024, swz = sb ^ (((sb >> 9) & 1) << 5); R = (st >> 1) * 16 + swz / 64; C = (st & 1) * 32 + (swz % 64) / 2; }
__host__ __device__ __forceinline__ int perm32(int rho) { const int n = rho >> 4, i = rho & 15; return 8 * (i >> 2) + 4 * n + (i & 3); }

struct Unit { int pm, pn, e, nvalid, local, halfm, roff, rbase; };

struct DenseSched {
    const char* A; const char* B; int K; int nM, nN, nwg, G, c;
    __device__ void init(const void* A_, const void* B_, int M, int N, int K_, int G_, int c_) { A = (const char*)A_; B = (const char*)B_; K = K_; nM = M / BM; nN = N / BM; nwg = nM * nN; G = G_; c = c_; }
    __device__ bool next(int i, Unit& u) const {
        const long L = (long)i * G + c; if (L >= nwg) return false;
        int wgid = (int)L; { const int q = nwg / NXCD, r = nwg % NXCD, xcd = wgid % NXCD, off = wgid / NXCD; wgid = (xcd < r ? xcd * (q + 1) : r * (q + 1) + (xcd - r) * q) + off; }
        const int nig = WGM * nN, gid = wgid / nig, fm = gid * WGM, gsz = (nM - fm) < WGM ? (nM - fm) : WGM;
        u.pm = fm + ((wgid % nig) % gsz); u.pn = (wgid % nig) / gsz; u.e = 0; u.nvalid = 256; u.local = 0; u.halfm = 0; u.roff = 0; u.rbase = u.pm * BM; return true;
    }
    __device__ __forceinline__ const char* aptr(const Unit& u) const { return A + (size_t)u.pm * BM * K * 2; }
    __device__ __forceinline__ const char* bptr(const Unit& u) const { return B + (size_t)u.pn * BM * K * 2; }
    __device__ __forceinline__ const int* rows(const Unit&) const { return nullptr; }
};
struct ListSched {
    const char* A; const char* B; int K, nN, first, count, halfm;
    __device__ bool next(int i, Unit& u) const {
        if (i >= count) return false; const int idx = first + i;
        u.pm = idx / nN; u.pn = idx % nN; u.e = 0; u.nvalid = 256; u.local = 0; u.halfm = halfm; u.roff = 0; u.rbase = u.pm * (halfm ? HALF : BM); return true;
    }
    __device__ __forceinline__ const char* aptr(const Unit& u) const { return A + (size_t)u.pm * (halfm ? HALF : BM) * K * 2; }
    __device__ __forceinline__ const char* bptr(const Unit& u) const { return B + (size_t)u.pn * BM * K * 2; }
    __device__ __forceinline__ const int* rows(const Unit&) const { return nullptr; }
};
struct MoeSched {
    const LAS int* poff; const char* A; const char* B; const int* list; const unsigned* cnt; int npn, G, vcu; size_t bexp; bool gather; int rb;
    __device__ bool next(int i, Unit& u) const {
        const int MT = __builtin_amdgcn_readfirstlane(poff[32]) >> 8, total = MT * npn, nfull = (total / G) * G;
        int L = i * G + vcu, half = 0, hm = 0;
        if (L >= nfull) {
            const int hidx = L - nfull; if (hidx >= 2 * (total - nfull)) return false;
            L = nfull + (hidx >> 1); half = hidx & 1; hm = 1; }
        const int pm = L / npn, pn = L % npn, row0 = pm << 8;
        int e = 0;
        for (int j = 1; j < 32; ++j) e = (poff[j] <= row0) ? j : e;
        e = __builtin_amdgcn_readfirstlane(e);
        u.pm = pm; u.pn = pn; u.e = e; u.halfm = hm; u.roff = half * HALF; u.rbase = row0 + half * HALF;
        const int local = row0 - __builtin_amdgcn_readfirstlane(poff[e]), left = __builtin_amdgcn_readfirstlane((int)cnt[e]) - local;
        u.nvalid = left < 256 ? left : 256; u.local = local;
        return true;
    }
    __device__ __forceinline__ const char* aptr(const Unit& u) const { return gather ? A : A + (size_t)u.rbase * rb; }
    __device__ __forceinline__ const char* bptr(const Unit& u) const { return B + (size_t)u.e * bexp + (size_t)u.pn * BM * rb; }
    __device__ __forceinline__ const int* rows(const Unit& u) const { return list + (size_t)u.e * NT + u.local; }
};

template <class Epi, class Sched, bool GATHER, bool ALIGN_EPI, bool F8 = false>
__device__ __forceinline__ void gemm_phase(LAS unsigned char* lds, const int RB  , const Sched& S, const Epi& E) {
    int tid = threadIdx.x; asm volatile("" : "+v"(tid));
    const int wid = __builtin_amdgcn_readfirstlane(tid >> 6), lane = tid & 63, wr = wid >> 2, wc = wid & 3, fr = lane & 15, fq = lane >> 4;
    const int nt = RB / (BK * 2);
    LAS v2u* tbl = (LAS v2u*)(lds + STAGE_BYTES) + tid;
    { v2u ob;
#pragma unroll
      for (int i = 0; i < 2; ++i) { int R, C; stage_rc(tid * 16 + i * 8192, R, C); const int Rb = Epi::PERM ? ((R & ~31) + perm32(R & 31)) : R; ob[i] = (unsigned)(Rb * RB + C * 2); }
      tbl[0] = ob; }
    const size_t kstep = (size_t)(BK * 2);
    const size_t hstepB = (size_t)HALF * RB;
    const unsigned ldsw = (unsigned)wid * 1024u;
    const int aoff = lds_byte(wr * 64 + fr, fq * 8), boff = lds_byte(wc * 32 + fr, fq * 8);
#define PG8_SA(b, h) (((b) * 2 + (h)) * HTB)
#define PG8_SB(b, h) ((4 + (b) * 2 + (h)) * HTB)
#define PG8_STAGE_T(bufoff, gbase, k) do { const v2u _o = tbl[(k) * 512]; \
        __builtin_amdgcn_global_load_lds((const unsigned*)((const char*)(gbase) + _o.x), (LAS unsigned*)(lds + (bufoff) + ldsw), 16, 0, 0); \
        __builtin_amdgcn_global_load_lds((const unsigned*)((const char*)(gbase) + _o.y), (LAS unsigned*)(lds + (bufoff) + ldsw + 8192), 16, 0, 0); } while (0)
#define PG8_STAGE_A(bufoff, gbase, k) PG8_STAGE_T(bufoff, gbase, k)
#define PG8_STAGE_B(bufoff, gbase) PG8_STAGE_T(bufoff, gbase, 0)
#define PG8_SETV(kb, u) do { int _t = tid; asm volatile("" : "+v"(_t));   _Pragma("unroll") for (int _h = 0; _h < 2; ++_h) { v2u _o; _Pragma("unroll") for (int _i = 0; _i < 2; ++_i) { int _R, _C; stage_rc(_t * 16 + _i * 8192, _R, _C); const int _r = _R + 128 * _h; \
        if constexpr (GATHER) { const int _rq = _r + (u).roff, _rr = _rq < (u).nvalid ? _rq : (u).nvalid - 1; _o[_i] = (unsigned)S.rows(u)[_rr] * (unsigned)RB + (unsigned)_C * 2u; } \
        else _o[_i] = (unsigned)(_r * RB) + (unsigned)_C * 2u; } tbl[((kb) + _h) * 512] = _o; } } while (0)
#define PG8_LDA(dst, b, h) do { _Pragma("unroll") for (int m = 0; m < 4; ++m) _Pragma("unroll") for (int k = 0; k < 2; ++k) dst[m][k] = *(const LAS v4i*)(lds + PG8_SA(b, h) + aoff + m * 2048 + k * 1024); } while (0)
#define PG8_LDB(dst, b, h) do { _Pragma("unroll") for (int n = 0; n < 2; ++n) _Pragma("unroll") for (int k = 0; k < 2; ++k) dst[n][k] = *(const LAS v4i*)(lds + PG8_SB(b, h) + boff + n * 2048 + k * 1024); } while (0)
#define PG8_CAT(x) __builtin_shufflevector(x[0], x[1], 0, 1, 2, 3, 4, 5, 6, 7)
#define PG8_MMA(ai, bj, At, Bt) do { __builtin_amdgcn_s_setprio(1); _Pragma("unroll") for (int m = 0; m < 4; ++m) _Pragma("unroll") for (int n = 0; n < 2; ++n) { \
        if constexpr (F8) acc[ai][bj][m][n] = __builtin_amdgcn_mfma_scale_f32_16x16x128_f8f6f4(PG8_CAT(Bt[n]), PG8_CAT(At[m]), acc[ai][bj][m][n], 0, 0, 0, 0, 0, 0);   \
        else { _Pragma("unroll") for (int k = 0; k < 2; ++k) acc[ai][bj][m][n] = __builtin_amdgcn_mfma_f32_16x16x32_bf16(__builtin_bit_cast(bf16x8, Bt[n][k]), __builtin_bit_cast(bf16x8, At[m][k]), acc[ai][bj][m][n], 0, 0, 0); } } \
        __builtin_amdgcn_s_setprio(0); } while (0)
#define PG8_WAIT_V(n) asm volatile("s_waitcnt vmcnt(" #n ")" ::: "memory")
#define PG8_WAIT_L(n) asm volatile("s_waitcnt lgkmcnt(" #n ")" ::: "memory")
#define PG8_BAR __builtin_amdgcn_s_barrier()
#define PG8_SCHED __builtin_amdgcn_sched_barrier(0)
    Unit cur, nxt; int ui = 0;
    if (!S.next(0, cur)) return;
    f32x4 acc[2][2][4][2];
#pragma unroll
    for (int a = 0; a < 2; ++a)
#pragma unroll
        for (int b = 0; b < 2; ++b)
#pragma unroll
            for (int m = 0; m < 4; ++m)
#pragma unroll
                for (int n = 0; n < 2; ++n) acc[a][b][m][n] = (f32x4){0.f, 0.f, 0.f, 0.f};
    v4i At[4][2], B0[2][2], B1[2][2];
    const char* cA = S.aptr(cur); const char* cB = S.bptr(cur);
    PG8_SETV(1, cur);
    PG8_STAGE_B(PG8_SB(0, 0), cB); PG8_STAGE_B(PG8_SB(0, 1), cB + hstepB); PG8_STAGE_A(PG8_SA(0, 0), cA, 1); PG8_STAGE_A(PG8_SA(0, 1), cA, 2);
    if (wr == 1) PG8_BAR;
    PG8_WAIT_V(2); PG8_BAR;
    PG8_STAGE_B(PG8_SB(1, 0), cB + kstep); PG8_STAGE_A(PG8_SA(1, 0), cA + kstep, 1); PG8_STAGE_B(PG8_SB(1, 1), cB + hstepB + kstep);
    PG8_WAIT_V(6); PG8_BAR;
    for (;;) {
        const bool has_next = S.next(ui + 1, nxt);
        const char* nA = has_next ? S.aptr(nxt) : cA; const char* nB = has_next ? S.bptr(nxt) : cB;
        if (has_next) { PG8_SETV(3, nxt); } else { tbl[3 * 512] = tbl[1 * 512]; tbl[4 * 512] = tbl[2 * 512]; }
#pragma unroll 1
        for (int t = 0; t < nt; t += 2) {
            const bool last = (t == nt - 2);
            const char* a1 = cA + (size_t)(t + 1) * kstep;
            const char* a2 = last ? nA : cA + (size_t)(t + 2) * kstep; const char* b2 = last ? nB : cB + (size_t)(t + 2) * kstep;
            const char* a3 = a2 + kstep; const char* b3 = b2 + kstep;
            const int k2 = last ? 3 : 1;
            PG8_LDB(B0, 0, 0); PG8_LDB(B1, 0, 1); PG8_SCHED; PG8_LDA(At, 0, 0); PG8_STAGE_A(PG8_SA(1, 1), a1, 2);
            PG8_WAIT_V(8); PG8_WAIT_L(0); PG8_BAR; PG8_MMA(0, 0, At, B0); PG8_MMA(0, 1, At, B1); PG8_BAR; PG8_SCHED;
            PG8_LDA(At, 0, 1); PG8_STAGE_B(PG8_SB(0, 0), b2); PG8_STAGE_B(PG8_SB(0, 1), b2 + hstepB); PG8_STAGE_A(PG8_SA(0, 0), a2, k2);
            PG8_WAIT_V(8); PG8_WAIT_L(0); PG8_BAR; if (!cur.halfm) { PG8_MMA(1, 0, At, B0); PG8_MMA(1, 1, At, B1); } PG8_BAR; PG8_SCHED;
            PG8_LDB(B0, 1, 0); PG8_LDB(B1, 1, 1); PG8_SCHED; PG8_LDA(At, 1, 0); PG8_STAGE_A(PG8_SA(0, 1), a2, k2 + 1);
            PG8_WAIT_V(8); PG8_WAIT_L(0); PG8_BAR; PG8_MMA(0, 0, At, B0); PG8_MMA(0, 1, At, B1); PG8_BAR; PG8_SCHED;
            PG8_LDA(At, 1, 1); PG8_STAGE_B(PG8_SB(1, 0), b3); PG8_STAGE_B(PG8_SB(1, 1), b3 + hstepB); PG8_STAGE_A(PG8_SA(1, 0), a3, k2);
            PG8_WAIT_V(8); PG8_WAIT_L(0); PG8_BAR; if (!cur.halfm) { PG8_MMA(1, 0, At, B0); PG8_MMA(1, 1, At, B1); } PG8_BAR; PG8_SCHED;
        }
        if constexpr (ALIGN_EPI) { if (wr == 0) PG8_BAR; }
        { int te = threadIdx.x; asm volatile("" : "+v"(te));
          E(acc, cur, wr, wc, te & 15, (te & 63) >> 4); }
        if (!has_next) break;
#pragma unroll
        for (int a = 0; a < 2; ++a)
#pragma unroll
            for (int b = 0; b < 2; ++b)
#pragma unroll
                for (int m = 0; m < 4; ++m)
#pragma unroll
                    for (int n = 0; n < 2; ++n) acc[a][b][m][n] = (f32x4){0.f, 0.f, 0.f, 0.f};
        cur = nxt; cA = nA; cB = nB; ++ui;
        tbl[1 * 512] = tbl[3 * 512]; tbl[2 * 512] = tbl[4 * 512];
        if constexpr (ALIGN_EPI) { if (wr == 1) PG8_BAR; }
    }
    PG8_WAIT_V(0);
    if constexpr (!ALIGN_EPI) { if (wr == 0) PG8_BAR; }
    PG8_BAR;
#undef PG8_SA
#undef PG8_SB
#undef PG8_STAGE_T
#undef PG8_STAGE_A
#undef PG8_STAGE_B
#undef PG8_SETV
#undef PG8_LDA
#undef PG8_LDB
#undef PG8_MMA
#undef PG8_CAT
#undef PG8_WAIT_V
#undef PG8_WAIT_L
#undef PG8_BAR
#undef PG8_SCHED
}

typedef const f32x4 (&AccRef)[2][2][4][2];
struct EpiOutF32 {
    static constexpr bool PERM = true; float* O; int ldc; int pad;
    __device__ __forceinline__ void operator()(AccRef acc, const Unit& u, int wr, int wc, int fr, int fq) const {
        const int row0 = u.rbase + wr * 64 + fr, col0 = u.pn * BM + wc * 32 + 8 * fq;
#pragma unroll
        for (int ai = 0; ai < 2; ++ai)
#pragma unroll
            for (int m = 0; m < 4; ++m) { float* rowp = O + (size_t)(row0 + ai * HALF + m * 16) * ldc + col0;
#pragma unroll
                for (int bj = 0; bj < 2; ++bj) { *(f32x4*)(rowp + bj * HALF) = acc[ai][bj][m][0]; *(f32x4*)(rowp + bj * HALF + 4) = acc[ai][bj][m][1]; } }
    }
};
struct EpiOutBf {
    static constexpr bool PERM = true; bf16* O; int ldc; int fnet; float scale;
    __device__ __forceinline__ void operator()(AccRef acc, const Unit& u, int wr, int wc, int fr, int fq) const {
        const int row0 = u.rbase + wr * 64 + fr; bf16* base; int colt;
        if (fnet) { const int b = u.pn >> 1; base = O + (size_t)b * NS * DM + 512; colt = (u.pn & 1) * 256; }
        else { base = O; colt = u.pn * BM; }
        const int col0 = colt + wc * 32 + 8 * fq;
#pragma unroll
        for (int ai = 0; ai < 2; ++ai) { if (ai == 1 && u.halfm) break;
#pragma unroll
            for (int m = 0; m < 4; ++m) { bf16* rowp = base + (size_t)(row0 + ai * HALF + m * 16) * ldc + col0;
#pragma unroll
                for (int bj = 0; bj < 2; ++bj) { const f32x4 v0 = acc[ai][bj][m][0] * scale, v1 = acc[ai][bj][m][1] * scale;
                    v4u w; w.x = cvt_pk_bf16(v0[0], v0[1]); w.y = cvt_pk_bf16(v0[2], v0[3]); w.z = cvt_pk_bf16(v1[0], v1[1]); w.w = cvt_pk_bf16(v1[2], v1[3]);
                    *(v4u*)(rowp + bj * HALF) = w; } } }
    }
};
struct EpiConv {
    static constexpr bool PERM = true; bf16* gb; bf16* uu;
    __device__ __forceinline__ void operator()(AccRef acc, const Unit& u, int wr, int wc, int fr, int fq) const {
        const int row0 = u.rbase + wr * 64 + fr;
        if (u.pn < 4) { const int col0 = u.pn * BM + wc * 32 + 8 * fq;
#pragma unroll
            for (int ai = 0; ai < 2; ++ai)
#pragma unroll
                for (int m = 0; m < 4; ++m) { bf16* rowp = gb + (size_t)(row0 + ai * HALF + m * 16) * DM + col0;
#pragma unroll
                    for (int bj = 0; bj < 2; ++bj) { const f32x4 v0 = acc[ai][bj][m][0], v1 = acc[ai][bj][m][1];
                        v4u w; w.x = cvt_pk_bf16(v0[0], v0[1]); w.y = cvt_pk_bf16(v0[2], v0[3]); w.z = cvt_pk_bf16(v1[0], v1[1]); w.w = cvt_pk_bf16(v1[2], v1[3]);
                        *(v4u*)(rowp + bj * HALF) = w; } }
        } else { const int col0 = (u.pn - 4) * 128 + wc * 32 + 8 * fq;
#pragma unroll
            for (int ai = 0; ai < 2; ++ai)
#pragma unroll
                for (int m = 0; m < 4; ++m) { const f32x4 v0 = acc[ai][0][m][0] * acc[ai][1][m][0], v1 = acc[ai][0][m][1] * acc[ai][1][m][1];
                    v4u w; w.x = cvt_pk_bf16(v0[0], v0[1]); w.y = cvt_pk_bf16(v0[2], v0[3]); w.z = cvt_pk_bf16(v1[0], v1[1]); w.w = cvt_pk_bf16(v1[2], v1[3]);
                    *(v4u*)(uu + (size_t)(row0 + ai * HALF + m * 16) * DM + col0) = w; }
        }
    }
};
struct EpiG1 {
    static constexpr bool PERM = false; bf16* cq; bf16* ckv; bf16* kpe; bf16* uf; const float* rope;
    __device__ __forceinline__ void operator()(AccRef acc, const Unit& u, int wr, int wc, int fr, int fq) const {
        const int row0 = u.rbase + wr * 64 + fr;
#pragma unroll
        for (int ai = 0; ai < 2; ++ai)
#pragma unroll
            for (int m = 0; m < 4; ++m) { const int row = row0 + ai * HALF + m * 16;
#pragma unroll
                for (int bj = 0; bj < 2; ++bj) {
                    if (u.pn == 1 && bj == 1) {
                        if (wc == 0) { const f32x4 t1 = acc[ai][1][m][0], t2 = acc[ai][1][m][1];
                            const f32x4 cs = *(const f32x4*)(rope + (size_t)row * 16 + 4 * fq), sn = *(const f32x4*)(rope + (size_t)NT * 16 + (size_t)row * 16 + 4 * fq);
                            v2u w1, w2; w1.x = cvt_pk_bf16(t1[0] * cs[0] - t2[0] * sn[0], t1[1] * cs[1] - t2[1] * sn[1]); w1.y = cvt_pk_bf16(t1[2] * cs[2] - t2[2] * sn[2], t1[3] * cs[3] - t2[3] * sn[3]);
                            w2.x = cvt_pk_bf16(t2[0] * cs[0] + t1[0] * sn[0], t2[1] * cs[1] + t1[1] * sn[1]); w2.y = cvt_pk_bf16(t2[2] * cs[2] + t1[2] * sn[2], t2[3] * cs[3] + t1[3] * sn[3]);
                            *(v2u*)(kpe + (size_t)row * 32 + 4 * fq) = w1; *(v2u*)(kpe + (size_t)row * 32 + 16 + 4 * fq) = w2; }
                    } else {
#pragma unroll
                        for (int n = 0; n < 2; ++n) { const f32x4 v = acc[ai][bj][m][n]; v2u w; w.x = cvt_pk_bf16(v[0], v[1]); w.y = cvt_pk_bf16(v[2], v[3]);
                            const int ct = bj * HALF + wc * 32 + 16 * n + 4 * fq;
                            bf16* p;
                            if (u.pn == 0) p = cq + (size_t)row * 256 + ct;
                            else if (u.pn == 1) p = ckv + (size_t)row * 128 + ct;
                            else p = uf + (size_t)row * 512 + (u.pn - 2) * 256 + ct;
                            *(v2u*)p = w; }
                    } } }
    }
};
struct EpiUp {
    static constexpr bool PERM = true; bf16* aact; const float* bg; const float* bl;
    __device__ __forceinline__ void operator()(AccRef acc, const Unit& u, int wr, int wc, int fr, int fq) const {
        const int row0 = u.rbase + wr * 64 + fr, col0 = u.pn * 128 + wc * 32 + 8 * fq;
        const float* pg = bg + (size_t)u.e * DM + col0; const float* pl = bl + (size_t)u.e * DM + col0;
        const f32x4 g0 = *(const f32x4*)pg, g1 = *(const f32x4*)(pg + 4), l0 = *(const f32x4*)pl, l1 = *(const f32x4*)(pl + 4);
#pragma unroll
        for (int ai = 0; ai < 2; ++ai)
#pragma unroll
            for (int m = 0; m < 4; ++m) { const f32x4 a0 = acc[ai][0][m][0] + g0, a1 = acc[ai][0][m][1] + g1, b0 = acc[ai][1][m][0] + l0, b1 = acc[ai][1][m][1] + l1;
                v4u w; w.x = cvt_pk_bf16(swiglu(a0[0], b0[0]), swiglu(a0[1], b0[1])); w.y = cvt_pk_bf16(swiglu(a0[2], b0[2]), swiglu(a0[3], b0[3]));
                w.z = cvt_pk_bf16(swiglu(a1[0], b1[0]), swiglu(a1[1], b1[1])); w.w = cvt_pk_bf16(swiglu(a1[2], b1[2]), swiglu(a1[3], b1[3]));
                *(v4u*)(aact + (size_t)(row0 + ai * HALF + m * 16) * DM + col0) = w; }
    }
};
struct EpiDown {
    static constexpr bool PERM = true; bf16* y; const float* bd;
    __device__ __forceinline__ void operator()(AccRef acc, const Unit& u, int wr, int wc, int fr, int fq) const {
        const int row0 = u.rbase + wr * 64 + fr, col0 = u.pn * BM + wc * 32 + 8 * fq;
#pragma unroll
        for (int bj = 0; bj < 2; ++bj) { const float* pb = bd + (size_t)u.e * DM + col0 + bj * HALF; const f32x4 c0 = *(const f32x4*)pb, c1 = *(const f32x4*)(pb + 4);
#pragma unroll
            for (int ai = 0; ai < 2; ++ai)
#pragma unroll
                for (int m = 0; m < 4; ++m) { const f32x4 v0 = acc[ai][bj][m][0] + c0, v1 = acc[ai][bj][m][1] + c1;
                    v4u w; w.x = cvt_pk_bf16(v0[0], v0[1]); w.y = cvt_pk_bf16(v0[2], v0[3]); w.z = cvt_pk_bf16(v1[0], v1[1]); w.w = cvt_pk_bf16(v1[2], v1[3]);
                    *(v4u*)(y + (size_t)(row0 + ai * HALF + m * 16) * DM + col0 + bj * HALF) = w; } }
    }
};
struct EpiUp8 {
    static constexpr bool PERM = true; unsigned char* aact; const float* bg; const float* bl;
    __device__ __forceinline__ void operator()(AccRef acc, const Unit& u, int wr, int wc, int fr, int fq) const {
        const int row0 = u.rbase + wr * 64 + fr, col0 = u.pn * 128 + wc * 32 + 8 * fq;
        const float* pg = bg + (size_t)u.e * DM + col0; const float* pl = bl + (size_t)u.e * DM + col0;
        const f32x4 g0 = *(const f32x4*)pg, g1 = *(const f32x4*)(pg + 4), l0 = *(const f32x4*)pl, l1 = *(const f32x4*)(pl + 4);
        constexpr float S = 1.f / 32.f;
#pragma unroll
        for (int ai = 0; ai < 2; ++ai) { if (ai == 1 && u.halfm) break;
#pragma unroll
            for (int m = 0; m < 4; ++m) { const f32x4 a0 = acc[ai][0][m][0] * S + g0, a1 = acc[ai][0][m][1] * S + g1, b0 = acc[ai][1][m][0] * S + l0, b1 = acc[ai][1][m][1] * S + l1;
                v2u w; w.x = pack_fp8x4(swiglu(a0[0], b0[0]), swiglu(a0[1], b0[1]), swiglu(a0[2], b0[2]), swiglu(a0[3], b0[3]));
                w.y = pack_fp8x4(swiglu(a1[0], b1[0]), swiglu(a1[1], b1[1]), swiglu(a1[2], b1[2]), swiglu(a1[3], b1[3]));
                *(v2u*)(aact + (size_t)(row0 + ai * HALF + m * 16) * DM + col0) = w; } }
    }
};
struct EpiDown8 {
    static constexpr bool PERM = true; bf16* y; const float* bd;
    __device__ __forceinline__ void operator()(AccRef acc, const Unit& u, int wr, int wc, int fr, int fq) const {
        const int row0 = u.rbase + wr * 64 + fr, col0 = u.pn * BM + wc * 32 + 8 * fq;
        constexpr float S = 1.f / 64.f;
#pragma unroll
        for (int bj = 0; bj < 2; ++bj) { const float* pb = bd + (size_t)u.e * DM + col0 + bj * HALF; const f32x4 c0 = *(const f32x4*)pb, c1 = *(const f32x4*)(pb + 4);
#pragma unroll
            for (int ai = 0; ai < 2; ++ai) { if (ai == 1 && u.halfm) break;
#pragma unroll
                for (int m = 0; m < 4; ++m) { const f32x4 v0 = acc[ai][bj][m][0] * S + c0, v1 = acc[ai][bj][m][1] * S + c1;
                    v4u w; w.x = cvt_pk_bf16(v0[0], v0[1]); w.y = cvt_pk_bf16(v0[2], v0[3]); w.z = cvt_pk_bf16(v1[0], v1[1]); w.w = cvt_pk_bf16(v1[2], v1[3]);
                    *(v4u*)(y + (size_t)(row0 + ai * HALF + m * 16) * DM + col0 + bj * HALF) = w; } } }
    }
};
}

__device__ __forceinline__ void tr_item(const float* __restrict__ W, int ldn, int K, int k0, int n0, bf16* __restrict__ WT, int drow0, const float* __restrict__ ks, LAS float* scr, int lane) {
    float v[32];
#pragma unroll
    for (int i = 0; i < 32; ++i) v[i] = __builtin_nontemporal_load(W + (size_t)(k0 + 2 * i + (lane >> 5)) * ldn + n0 + (lane & 31));
#pragma unroll
    for (int i = 0; i < 32; ++i) { const int kk = 2 * i + (lane >> 5); float x = v[i]; if (ks) x *= ks[k0 + kk]; scr[kk * 33 + (lane & 31)] = x; }
    LDS_WAIT(); asm volatile("" ::: "memory");
    const int c = lane & 7;
#pragma unroll
    for (int j = 0; j < 4; ++j) { const int n = (lane >> 3) + 8 * j; const LAS float* s = scr + (8 * c) * 33 + n;
        v4u o; o.x = pk2(s[0 * 33], s[1 * 33]); o.y = pk2(s[2 * 33], s[3 * 33]); o.z = pk2(s[4 * 33], s[5 * 33]); o.w = pk2(s[6 * 33], s[7 * 33]);
        *(v4u*)(WT + (size_t)(drow0 + n) * K + k0 + 8 * c) = o; }
    LDS_WAIT(); asm volatile("" ::: "memory");
}

__device__ __forceinline__ void tr_item8(const float* __restrict__ W, int ldn, int K, int k0, int n0, unsigned char* __restrict__ WT, int drow0, float scale, LAS float* scr, int lane) {
    float v[32];
#pragma unroll
    for (int i = 0; i < 32; ++i) v[i] = __builtin_nontemporal_load(W + (size_t)(k0 + 2 * i + (lane >> 5)) * ldn + n0 + (lane & 31));
#pragma unroll
    for (int i = 0; i < 32; ++i) { const int kk = 2 * i + (lane >> 5); scr[kk * 33 + (lane & 31)] = v[i] * scale; }
    LDS_WAIT(); asm volatile("" ::: "memory");
    const int c = lane & 3;
#pragma unroll
    for (int j = 0; j < 2; ++j) { const int n = (lane >> 2) + 16 * j; const LAS float* s = scr + (16 * c) * 33 + n;
        v4u o; o.x = pack_fp8x4(s[0 * 33], s[1 * 33], s[2 * 33], s[3 * 33]); o.y = pack_fp8x4(s[4 * 33], s[5 * 33], s[6 * 33], s[7 * 33]);
        o.z = pack_fp8x4(s[8 * 33], s[9 * 33], s[10 * 33], s[11 * 33]); o.w = pack_fp8x4(s[12 * 33], s[13 * 33], s[14 * 33], s[15 * 33]);
        *(v4u*)(WT + (size_t)(drow0 + n) * K + k0 + 16 * c) = o; }
    LDS_WAIT(); asm volatile("" ::: "memory");
}

struct FastArgs {
    const float* in[27];
    float* out; unsigned char* ws;
    int ph_lo, ph_hi, bar_region, pad;
};

constexpr int IT_WIN = 16 * 29, IT_WUQ = 4 * 24, IT_WUK = 2 * 16, IT_WUV = 2 * 16, IT_WOUT0 = 16 * 32, IT_WCIN = 16 * 96, IT_WCOUT = 16 * 32, IT_MOE = 64 * 512;
constexpr int IT_SMALL = IT_WIN + IT_WUQ + IT_WUK + IT_WUV + IT_WOUT0 + IT_WCIN + IT_WCOUT;
constexpr int IT_TOTAL = IT_SMALL + 3 * IT_MOE;

__device__ __forceinline__ void conv_item(const FastArgs& a, int it, LAS float* scr, int lane) {
    unsigned char* ws = a.ws;
    int r = it;
    if (r < IT_WIN) { const int kb = r / 29, nb = r % 29; tr_item(a.in[9], PROJ_A, 1024, kb * 64, nb * 32, (bf16*)(ws + WS_WIN), nb < 13 ? nb * 32 : nb * 32 + 96, nullptr, scr, lane); return; } r -= IT_WIN;
    if (r < IT_WUQ) { const int kb = r / 24, nb = r % 24; tr_item(a.in[12], 768, 256, kb * 64, nb * 32, (bf16*)(ws + WS_WUQ), nb * 32, a.in[10], scr, lane); return; } r -= IT_WUQ;
    if (r < IT_WUK) { const int kb = r / 16, nb = r % 16; tr_item(a.in[13], 512, 128, kb * 64, nb * 32, (bf16*)(ws + WS_WUKV), nb * 32, a.in[11], scr, lane); return; } r -= IT_WUK;
    if (r < IT_WUV) { const int kb = r / 16, nb = r % 16; tr_item(a.in[14], 512, 128, kb * 64, nb * 32, (bf16*)(ws + WS_WUKV), 512 + nb * 32, a.in[11], scr, lane); return; } r -= IT_WUV;
    if (r < IT_WOUT0) { const int kb = r / 32, nb = r % 32; tr_item(a.in[15], 1024, 1024, kb * 64, nb * 32, (bf16*)(ws + WS_WOUT0), nb * 32, nullptr, scr, lane); return; } r -= IT_WOUT0;
    if (r < IT_WCIN) { const int kb = r / 96, nb = r % 96, reg = nb >> 5, ch = (nb & 31) * 32;
        const int drow = (reg == 0) ? ch : 1024 + (ch >> 7) * 256 + (reg - 1) * 128 + (ch & 127);
        tr_item(a.in[16], 3072, 1024, kb * 64, nb * 32, (bf16*)(ws + WS_WCIN), drow, nullptr, scr, lane); return; } r -= IT_WCIN;
    if (r < IT_WCOUT) { const int kb = r / 32, nb = r % 32; tr_item(a.in[18], 1024, 1024, kb * 64, nb * 32, (bf16*)(ws + WS_WCOUT), nb * 32, nullptr, scr, lane); return; } r -= IT_WCOUT;
    const int which = r / IT_MOE; r -= which * IT_MOE;
    const int mat = r >> 9, rem = r & 511, kb = rem >> 5, nb = rem & 31;
    const float* src = a.in[which == 0 ? 21 : (which == 1 ? 23 : 25)] + (size_t)mat * DM * DM;
#if MOE_FP8
    if (which == 2) tr_item8(src, 1024, 1024, kb * 64, nb * 32, (unsigned char*)(ws + WS_WDN) + (size_t)mat * DM * DM, nb * 32, 64.f, scr, lane);
    else tr_item8(src, 1024, 1024, kb * 64, nb * 32, (unsigned char*)(ws + WS_WUP) + (size_t)mat * 2048 * DM, (nb >> 2) * 256 + which * 128 + (nb & 3) * 32, 32.f, scr, lane);
#else
    if (which == 2) tr_item(src, 1024, 1024, kb * 64, nb * 32, (bf16*)(ws + WS_WDN) + (size_t)mat * DM * DM, nb * 32, nullptr, scr, lane);
    else tr_item(src, 1024, 1024, kb * 64, nb * 32, (bf16*)(ws + WS_WUP) + (size_t)mat * 2048 * DM, (nb >> 2) * 256 + which * 128 + (nb & 3) * 32, nullptr, scr, lane);
#endif
}

__device__ __forceinline__ void mod_unit(const FastArgs& a, int unit, LAS float* lds, int tid) {
    LAS float* cond = lds; LAS float* part = lds + 4096;
    const float* c = a.in[1]; const float* ada_w = a.in[3]; const float* ada_b = a.in[4]; float* mod = (float*)(a.ws + WS_MOD);
    for (int i = tid; i < 4096; i += 512) { const float v = c[i]; cond[i] = v / (1.f + expf(-v)); }
    __syncthreads();
    const int l = unit >> 7, n0 = (unit & 127) * 48, ks = tid / 12, c4 = tid % 12;
    if (ks < 42) {
        f32x4 s0 = {0.f, 0.f, 0.f, 0.f}, s1 = s0, s2 = s0, s3 = s0;
        for (int k = ks; k < 1024; k += 42) { const f32x4 w = *(const f32x4*)(ada_w + ((size_t)l * 1024 + k) * 6144 + n0 + 4 * c4);
            s0 += w * cond[k]; s1 += w * cond[1024 + k]; s2 += w * cond[2048 + k]; s3 += w * cond[3072 + k]; }
        *(LAS f32x4*)(part + (ks * 4 + 0) * 48 + 4 * c4) = s0; *(LAS f32x4*)(part + (ks * 4 + 1) * 48 + 4 * c4) = s1;
        *(LAS f32x4*)(part + (ks * 4 + 2) * 48 + 4 * c4) = s2; *(LAS f32x4*)(part + (ks * 4 + 3) * 48 + 4 * c4) = s3;
    }
    __syncthreads();
    if (tid < 192) { const int b = tid / 48, col = tid % 48; float s = 0.f;
        for (int k = 0; k < 42; ++k) s += part[(k * 4 + b) * 48 + col];
        mod[(l * 4 + b) * 6144 + n0 + col] = s + ada_b[l * 6144 + n0 + col]; }
    __syncthreads();
}

__device__ __forceinline__ void p0_prologue(const FastArgs& a, LAS unsigned char* lds, int vcu, int G, int tid, int wave, int lane) {
    unsigned char* ws = a.ws;
    for (int u = vcu; u < 256; u += G) mod_unit(a, u, (LAS float*)lds, tid);
    { float* rope = (float*)(ws + WS_ROPE); const int* pos = (const int*)a.in[2];
      for (int i = vcu * 512 + tid; i < NT * 16; i += G * 512) { const int t = i >> 4, j = i & 15;
          const float inv = exp2f(-(float)j * (13.287712379549449f / 16.f)); const float ang = (float)pos[t] * inv;
          const double rev = (double)ang * 0.15915494309189535; const float fr = (float)(rev - rint(rev));
          rope[i] = __builtin_amdgcn_cosf(fr); rope[NT * 16 + i] = __builtin_amdgcn_sinf(fr); } }
    { bf16* cst = (bf16*)(ws + WS_CST);
      for (int i = vcu * 512 + tid; i < 128 * 64; i += G * 512) { const int n = i >> 6, c = i & 63; const float fr = (float)((c * (n & 63)) & 63) * (1.f / 64.f);
          cst[i] = f2bf(n < 64 ? __builtin_amdgcn_cosf(fr) : __builtin_amdgcn_sinf(fr)); } }
    { v4u* p = (v4u*)((bf16*)(ws + WS_WIN) + 416 * 1024); const v4u z = {0u, 0u, 0u, 0u};
      for (int i = vcu * 512 + tid; i < 96 * 1024 / 8; i += G * 512) p[i] = z; }
    { unsigned char* dm = (unsigned char*)(ws + WS_DMAT);
      for (int i = vcu * 512 + tid; i < 4096 * 8192 / 16; i += G * 512) { const int sp = i >> 9, k0 = (i & 511) * 16; unsigned w[4];
#pragma unroll
          for (int q = 0; q < 4; ++q) { float v[4];
#pragma unroll
              for (int e = 0; e < 4; ++e) { const int k = k0 + 4 * q + e, sq = k & 4095; const float fr = (float)((sp * sq) & 4095) * (1.f / 4096.f);
                  v[e] = (k < 4096) ? __builtin_amdgcn_cosf(fr) : -__builtin_amdgcn_sinf(fr); }
              w[q] = pack_fp8x4(v[0], v[1], v[2], v[3]); }
          v4u o = {w[0], w[1], w[2], w[3]}; *(v4u*)(dm + (size_t)i * 16) = o; } }
    { LAS float* scr = (LAS float*)(lds + wave * 16384);
      const int gw = vcu * NWAVES + wave, NGW = G * NWAVES;
      for (int it = gw; it < IT_SMALL; it += NGW) conv_item(a, it, scr, lane);
#if MOE_FP8
      float v[32], vn[32];
#define MOE_SRC(it_) ({ const int r_ = (it_) - IT_SMALL, wh_ = r_ / IT_MOE, q_ = r_ - wh_ * IT_MOE, mat_ = q_ >> 9, rem_ = q_ & 511; \
          a.in[wh_ == 0 ? 21 : (wh_ == 1 ? 23 : 25)] + (size_t)mat_ * DM * DM + (size_t)((rem_ >> 5) * 64 + (lane >> 5)) * DM + (rem_ & 31) * 32 + (lane & 31); })
      int it = IT_SMALL + ((G == 256) ? 2 * IT_MOE : 0) + gw;
      if (it < IT_TOTAL) { const float* sp = MOE_SRC(it);
#pragma unroll
          for (int i = 0; i < 32; ++i) v[i] = __builtin_nontemporal_load(sp + (size_t)(2 * i) * DM); }
      for (; it < IT_TOTAL; it += NGW) {
          const int nx = it + NGW;
          if (nx < IT_TOTAL) { const float* sp = MOE_SRC(nx);
#pragma unroll
              for (int i = 0; i < 32; ++i) vn[i] = __builtin_nontemporal_load(sp + (size_t)(2 * i) * DM); }
          const int r = it - IT_SMALL, which = r / IT_MOE, q = r - which * IT_MOE, mat = q >> 9, rem = q & 511, kb = rem >> 5, nb = rem & 31;
          const float scale = (which == 2) ? 64.f : 32.f;
          unsigned char* WT = (which == 2) ? (unsigned char*)(ws + WS_WDN) + (size_t)mat * DM * DM : (unsigned char*)(ws + WS_WUP) + (size_t)mat * 2048 * DM;
          const int drow0 = (which == 2) ? nb * 32 : (nb >> 2) * 256 + which * 128 + (nb & 3) * 32, k0 = kb * 64;
#pragma unroll
          for (int i = 0; i < 32; ++i) { const int kk = 2 * i + (lane >> 5); scr[kk * 33 + (lane & 31)] = v[i] * scale; }
          LDS_WAIT(); asm volatile("" ::: "memory");
          const int c = lane & 3;
#pragma unroll
          for (int j = 0; j < 2; ++j) { const int n = (lane >> 2) + 16 * j; const LAS float* sq = scr + (16 * c) * 33 + n;
              v4u o; o.x = pack_fp8x4(sq[0 * 33], sq[1 * 33], sq[2 * 33], sq[3 * 33]); o.y = pack_fp8x4(sq[4 * 33], sq[5 * 33], sq[6 * 33], sq[7 * 33]);
              o.z = pack_fp8x4(sq[8 * 33], sq[9 * 33], sq[10 * 33], sq[11 * 33]); o.w = pack_fp8x4(sq[12 * 33], sq[13 * 33], sq[14 * 33], sq[15 * 33]);
              *(v4u*)(WT + (size_t)(drow0 + n) * DM + k0 + 16 * c) = o; }
          LDS_WAIT(); asm volatile("" ::: "memory");
#pragma unroll
          for (int i = 0; i < 32; ++i) v[i] = vn[i];
      }
#undef MOE_SRC
#else
      for (int it = IT_SMALL + gw; it < IT_TOTAL; it += NGW) conv_item(a, it, scr, lane);
#endif
    }
}
namespace att {
constexpr int QBLK = 32, KVBLK = 64;
constexpr int SHM_V = KVBLK * 128 * 2, SHM_K = KVBLK * 128 * 2, SHM_ATTN = 2 * SHM_V + 2 * SHM_K + NWAVES * 64 * 4;
constexpr float THR = 8.f;
#define KSWZ(row, colB) ((row) * 256 + ((colB) ^ (((row) & 7) << 4)))
#define SBAR() __builtin_amdgcn_sched_barrier(0)
__device__ __forceinline__ int crow(int r, int hi) { return (r & 3) + 8 * (r >> 2) + 4 * hi; }
__device__ __forceinline__ unsigned cvtpk(float lo, float hi) { unsigned r; asm volatile("v_cvt_pk_bf16_f32 %0, %1, %2" : "=v"(r) : "v"(lo), "v"(hi)); return r; }
__device__ __forceinline__ bf16x8 ld8(const bf16* p) { return *reinterpret_cast<const bf16x8*>(p); }

__device__ __forceinline__ void partialSM(f32x16& p0, f32x16& p1, float& m_reg, float& mn, float& alpha) {
  constexpr float C = 1.4426950408889634f;
  float pmax = p0[0];
#pragma unroll
  for (int r = 1; r < 16; ++r) pmax = fmaxf(pmax, p0[r]);
#pragma unroll
  for (int r = 0; r < 16; ++r) pmax = fmaxf(pmax, p1[r]);
  { auto rr = __builtin_amdgcn_permlane32_swap(__float_as_uint(pmax), __float_as_uint(pmax), false, false);
    pmax = fmaxf(__uint_as_float(rr[0]), __uint_as_float(rr[1])); }
  if (__builtin_expect(__all(pmax - m_reg <= THR), 1)) { mn = m_reg; alpha = 1.f; }
  else { mn = fmaxf(m_reg, pmax); alpha = __builtin_amdgcn_exp2f((m_reg - mn) * C); m_reg = mn; }
  const float mnC = -mn * C;
#pragma unroll
  for (int r = 0; r < 16; ++r) p0[r] = fmaf(p0[r], C, mnC);
#pragma unroll
  for (int r = 0; r < 16; ++r) p1[r] = fmaf(p1[r], C, mnC);
#pragma unroll
  for (int r = 0; r < 16; ++r) p0[r] = __builtin_amdgcn_exp2f(p0[r]);
}
__device__ __forceinline__ void finishSM(f32x16& p0, f32x16& p1, float alpha, float& l_reg, bf16x8& pa0, bf16x8& pa1, bf16x8& pa2, bf16x8& pa3) {
#pragma unroll
  for (int r = 0; r < 16; ++r) p1[r] = __builtin_amdgcn_exp2f(p1[r]);
  float ps = 0;
#pragma unroll
  for (int r = 0; r < 16; ++r) ps += p0[r];
#pragma unroll
  for (int r = 0; r < 16; ++r) ps += p1[r];
  { auto rr = __builtin_amdgcn_permlane32_swap(__float_as_uint(ps), __float_as_uint(ps), false, false);
    ps = __uint_as_float(rr[0]) + __uint_as_float(rr[1]); }
  l_reg = l_reg * alpha + ps;
#define PK4(P, BASE, OUT) do { unsigned a0 = cvtpk(P[BASE + 0], P[BASE + 1]), a1 = cvtpk(P[BASE + 2], P[BASE + 3]);   \
    unsigned b0 = cvtpk(P[BASE + 4], P[BASE + 5]), b1 = cvtpk(P[BASE + 6], P[BASE + 7]);                              \
    auto r0 = __builtin_amdgcn_permlane32_swap(a0, b0, false, false); auto r1 = __builtin_amdgcn_permlane32_swap(a1, b1, false, false); \
    v4u w = {r0[0], r1[0], r0[1], r1[1]}; OUT = *reinterpret_cast<bf16x8*>(&w); } while (0)
  PK4(p0, 0, pa0); PK4(p0, 8, pa1); PK4(p1, 0, pa2); PK4(p1, 8, pa3);
#undef PK4
}
__device__ __forceinline__ void qkt(f32x16& p0, f32x16& p1, const bf16* Ks, const bf16x8* qr, int r32, int hi) {
  p0 = f32x16{}; p1 = f32x16{};
#pragma unroll
  for (int d0 = 0; d0 < 6; ++d0) { const int cb = (d0 * 16 + hi * 8) * 2;
    bf16x8 b0 = *reinterpret_cast<const bf16x8*>((const char*)Ks + KSWZ(r32, cb));
    bf16x8 b1 = *reinterpret_cast<const bf16x8*>((const char*)Ks + KSWZ(32 + r32, cb));
    p0 = __builtin_amdgcn_mfma_f32_32x32x16_bf16(b0, qr[d0], p0, 0, 0, 0);
    p1 = __builtin_amdgcn_mfma_f32_32x32x16_bf16(b1, qr[d0], p1, 0, 0, 0); }
}
__device__ __forceinline__ int v_st(int k, int c) { const int kk = (k & ~0xC) | ((k & 4) << 1) | ((k & 8) >> 1); return ((kk >> 3) * 4 + (c >> 5)) * 512 + ((kk & 7) * 32 + (c & 31)) * 2; }
__device__ __forceinline__ int v_rd_base(int lane) { return ((lane & 3) << 3) | (((lane >> 2) & 3) << 6) | (((lane >> 4) & 1) << 5) | (((lane >> 5) & 1) << 8); }
constexpr int v_rd_off(int d0, int ks, int half) { return d0 * 512 + ks * 4096 + half * 2048; }
template <int OFF> __device__ __forceinline__ s16x4 tr_read(int vb) {
  s16x4 r; asm volatile("ds_read_b64_tr_b16 %0, %1 offset:%2" : "=&v"(r) : "v"(vb), "i"(OFF) : "memory"); return r;
}
template <int D0> __device__ __forceinline__ void pv_one(f32x16& od, int vb, bf16x8 pa0, bf16x8 pa1, bf16x8 pa2, bf16x8 pa3) {
  const s16x4 l0 = tr_read<v_rd_off(D0, 0, 0)>(vb), h0 = tr_read<v_rd_off(D0, 0, 1)>(vb), l1 = tr_read<v_rd_off(D0, 1, 0)>(vb), h1 = tr_read<v_rd_off(D0, 1, 1)>(vb);
  const s16x4 l2 = tr_read<v_rd_off(D0, 2, 0)>(vb), h2 = tr_read<v_rd_off(D0, 2, 1)>(vb), l3 = tr_read<v_rd_off(D0, 3, 0)>(vb), h3 = tr_read<v_rd_off(D0, 3, 1)>(vb);
  asm volatile("s_waitcnt lgkmcnt(0)" ::: "memory"); SBAR();
#define PK(L, H) (bf16x8){L[0], L[1], L[2], L[3], H[0], H[1], H[2], H[3]}
  od = __builtin_amdgcn_mfma_f32_32x32x16_bf16(pa0, PK(l0, h0), od, 0, 0, 0);
  od = __builtin_amdgcn_mfma_f32_32x32x16_bf16(pa1, PK(l1, h1), od, 0, 0, 0);
  od = __builtin_amdgcn_mfma_f32_32x32x16_bf16(pa2, PK(l2, h2), od, 0, 0, 0);
  od = __builtin_amdgcn_mfma_f32_32x32x16_bf16(pa3, PK(l3, h3), od, 0, 0, 0);
#undef PK
}
__device__ __forceinline__ void pv_d0(f32x16* o, int vb, bf16x8 pa0, bf16x8 pa1, bf16x8 pa2, bf16x8 pa3) {
  pv_one<0>(o[0], vb, pa0, pa1, pa2, pa3); pv_one<1>(o[1], vb, pa0, pa1, pa2, pa3);
}
template <bool BG> __device__ __forceinline__ void attn_unit(const bf16* __restrict__ Qb, const bf16* __restrict__ Kh, const bf16* __restrict__ Vh, bf16* __restrict__ Ob, int ldo, int seq, char* lds, const float* bg_src0, const float* bg_src1, const float* bg_src2, unsigned char* bg_wup, unsigned char* bg_wdn, int& c_it, const int c_end) {
  int tid = threadIdx.x; asm volatile("" : "+v"(tid));
  const int wid = tid >> 6, lane = tid & 63, r32 = lane & 31, hi = lane >> 5;
  bf16* V_lds = (bf16*)lds; bf16* K_lds = (bf16*)(lds + 2 * SHM_V);
  float* ws = (float*)(lds + 2 * SHM_V + 2 * SHM_K) + wid * 64; float* li_l = ws; float* al_l = ws + 32;
  float m_reg = -1e30f, l_reg = 0; f32x16 o[2] = {}; bf16x8 qr[6];
  const bf16* Qw = Qb + (long)(wid * QBLK + r32) * QKD + hi * 8;
#pragma unroll
  for (int d0 = 0; d0 < 6; ++d0) qr[d0] = ld8(Qw + d0 * 16);
  const bool lowh = tid < 256;
  const int cA = tid, rA = cA / 12, qA = cA - rA * 12;
  const int cBk = 512 + (tid & 255), rBk = cBk / 12, qBk = cBk - rBk * 12, cBv = tid & 255, rBv = cBv >> 3, qBv = cBv & 7;
  const int cCv = lowh ? 256 + tid : (tid & 255), rCv = cCv >> 3, qCv = cCv & 7;
  const bf16* pA = Kh + (long)rA * QKD + qA * 8;
  const bf16* pB = lowh ? Kh + (long)rBk * QKD + qBk * 8 : Vh + (long)rBv * VH + qBv * 8; const int sB = lowh ? QKD : VH;
  const bf16* pC = Vh + (long)rCv * VH + qCv * 8;
  const int wA = 2 * SHM_V + KSWZ(rA, qA * 16), wB = lowh ? 2 * SHM_V + KSWZ(rBk, qBk * 16) : v_st(rBv, qBv * 8), wC = v_st(rCv, qCv * 8);
  const int vb0 = (int)(uintptr_t)V_lds + v_rd_base(lane);
  struct { bf16x8 x0, x1, x2; } sr_[2];
#define SLOAD(i, k0) do { sr_[i].x0 = ld8(pA + (long)(k0) * QKD); sr_[i].x1 = ld8(pB + (long)(k0) * sB); sr_[i].x2 = ld8(pC + (long)(k0) * VH); } while (0)
#define SWRITE(bb, i) do { *(bf16x8*)(lds + wA + (bb) * SHM_K) = sr_[i].x0; *(bf16x8*)(lds + wB + (bb) * SHM_K) = sr_[i].x1; *(bf16x8*)(lds + wC + (bb) * SHM_K) = sr_[i].x2; } while (0)
#define RESC(a) do { if (__any((a) < 1.f)) { if (hi == 0) al_l[r32] = (a); asm volatile("s_waitcnt lgkmcnt(0)" ::: "memory"); \
    _Pragma("unroll") for (int d = 0; d < 2; ++d) _Pragma("unroll") for (int r = 0; r < 16; ++r) o[d][r] *= al_l[crow(r, hi)]; } } while (0)
  float cv[16];
#define BG_LOAD() do { if constexpr (BG) { const int wh_ = c_it / 65536, q_ = c_it & 65535, mat_ = q_ >> 10, nb_ = (q_ >> 6) & 15, kc_ = q_ & 63; \
      const float* s_ = (wh_ == 0 ? bg_src0 : (wh_ == 1 ? bg_src1 : bg_src2)) + (size_t)mat_ * DM * DM + (size_t)(16 * kc_) * DM + 64 * nb_ + lane; \
      _Pragma("unroll") for (int i_ = 0; i_ < 16; ++i_) cv[i_] = __builtin_nontemporal_load(s_ + (size_t)i_ * DM); } } while (0)
#define BG_STORE() do { if constexpr (BG) { const int wh_ = c_it / 65536, q_ = c_it & 65535, mat_ = q_ >> 10, nb_ = (q_ >> 6) & 15, kc_ = q_ & 63, n_ = 64 * nb_ + lane; const float sc_ = (wh_ == 2) ? 64.f : 32.f; \
      unsigned char* d_ = (wh_ == 2) ? bg_wdn + ((size_t)mat_ * DM + n_) * DM + 16 * kc_ : bg_wup + ((size_t)mat_ * 2048 + (n_ >> 7) * 256 + wh_ * 128 + (n_ & 127)) * DM + 16 * kc_; \
      v4u o_; o_.x = pack_fp8x4(cv[0] * sc_, cv[1] * sc_, cv[2] * sc_, cv[3] * sc_); o_.y = pack_fp8x4(cv[4] * sc_, cv[5] * sc_, cv[6] * sc_, cv[7] * sc_); \
      o_.z = pack_fp8x4(cv[8] * sc_, cv[9] * sc_, cv[10] * sc_, cv[11] * sc_); o_.w = pack_fp8x4(cv[12] * sc_, cv[13] * sc_, cv[14] * sc_, cv[15] * sc_); \
      *(v4u*)d_ = o_; } } while (0)
#define BG_STEP() do { if constexpr (BG) { BG_STORE(); c_it = (c_it + 1 < c_end) ? c_it + 1 : c_end - 1; BG_LOAD(); } } while (0)
  f32x16 pA0, pA1, pB0, pB1; float mnA, mnB, alA, alB; bf16x8 pa0, pa1, pa2, pa3; const int NTL = seq / KVBLK;
  constexpr int SE = 0, SO = 1;
  SLOAD(SE, 0); asm volatile("s_waitcnt vmcnt(0)" ::: "memory"); SWRITE(0, SE); __syncthreads();
  qkt(pA0, pA1, K_lds, qr, r32, hi); partialSM(pA0, pA1, m_reg, mnA, alA);
  SLOAD(SO, KVBLK); SLOAD(SE, 2 * KVBLK); BG_LOAD();
  SWRITE(1, SO); __syncthreads();
  for (int j = 1; j + 1 < NTL; j += 2) {
    SBAR(); qkt(pB0, pB1, (bf16*)((char*)K_lds + SHM_K), qr, r32, hi);
    finishSM(pA0, pA1, alA, l_reg, pa0, pa1, pa2, pa3); SBAR();
    SLOAD(SO, (j + 2) * KVBLK); BG_STEP(); SBAR();
    pv_d0(o, vb0, pa0, pa1, pa2, pa3); partialSM(pB0, pB1, m_reg, mnB, alB);
    __syncthreads(); SWRITE(0, SE);
    RESC(alB); __syncthreads();
    SBAR(); qkt(pA0, pA1, K_lds, qr, r32, hi);
    finishSM(pB0, pB1, alB, l_reg, pa0, pa1, pa2, pa3); SBAR();
    { const int kn_ = (j + 3 < NTL) ? (j + 3) * KVBLK : seq - KVBLK; SLOAD(SE, kn_); } SBAR();
    pv_d0(o, vb0 + (int)SHM_V, pa0, pa1, pa2, pa3); partialSM(pA0, pA1, m_reg, mnA, alA);
    __syncthreads(); SWRITE(1, SO);
    RESC(alA); __syncthreads();
  }
  SBAR(); qkt(pB0, pB1, (bf16*)((char*)K_lds + SHM_K), qr, r32, hi);
  finishSM(pA0, pA1, alA, l_reg, pa0, pa1, pa2, pa3); SBAR();
  pv_d0(o, vb0, pa0, pa1, pa2, pa3); partialSM(pB0, pB1, m_reg, mnB, alB);
  __syncthreads(); RESC(alB);
  finishSM(pB0, pB1, alB, l_reg, pa0, pa1, pa2, pa3); SBAR();
  pv_d0(o, vb0 + (int)SHM_V, pa0, pa1, pa2, pa3);
  if (hi == 0) li_l[r32] = l_reg; asm volatile("s_waitcnt lgkmcnt(0)" ::: "memory");
  float rli[16];
#pragma unroll
  for (int r = 0; r < 16; ++r) rli[r] = __builtin_amdgcn_rcpf(li_l[crow(r, hi)]);
  bf16* Ow = Ob + (long)(wid * QBLK) * ldo;
#pragma unroll
  for (int r = 0; r < 16; ++r) { const int orow = crow(r, hi);
#pragma unroll
    for (int d0 = 0; d0 < 2; ++d0) Ow[(long)orow * ldo + d0 * 32 + r32] = f2bf(o[d0][r] * rli[r]); }
  BG_STORE(); if constexpr (BG) c_it = (c_it + 1 < c_end) ? c_it + 1 : c_end - 1;
  __syncthreads();
#undef BG_STEP
#undef BG_LOAD
#undef BG_STORE
#undef SLOAD
#undef SWRITE
#undef RESC
}
#undef KSWZ
#undef SBAR
}

constexpr int P3_CQ_LD = 264, P3_CKV_LD = 136, P3_UF_LD = 520;
constexpr int P3_CQ_OFF = 0, P3_CKV_OFF = 64 * P3_CQ_LD * 2, P3_UF_OFF = P3_CKV_OFF + 64 * P3_CKV_LD * 2, P3_R_OFF = P3_UF_OFF + 64 * P3_UF_LD * 2, P3_BYTES = P3_R_OFF + 512;
__device__ __forceinline__ void p3_unit(const FastArgs& a, int chunk, LAS unsigned char* lds) {
    int tid = threadIdx.x; asm volatile("" : "+v"(tid));
    const int lane = tid & 63, wave = __builtin_amdgcn_readfirstlane(tid >> 6);
    unsigned char* ws = a.ws;
    const bf16* CQ = (const bf16*)(ws + WS_CQ); const bf16* CKV = (const bf16*)(ws + WS_CKV); const bf16* KPE = (const bf16*)(ws + WS_KPE); const bf16* UF = (const bf16*)(ws + WS_UF);
    const bf16* Wuq = (const bf16*)(ws + WS_WUQ); const bf16* Wukv = (const bf16*)(ws + WS_WUKV); const bf16* CSt = (const bf16*)(ws + WS_CST); const float* rope = (const float*)(ws + WS_ROPE);
    bf16* Qo = (bf16*)(ws + WS_Q); bf16* Ko = (bf16*)(ws + WS_K); bf16* Vo = (bf16*)(ws + WS_V); bf16* UCS = (bf16*)(ws + WS_UCS);
    LAS bf16* cqs = (LAS bf16*)(lds + P3_CQ_OFF); LAS bf16* ckvs = (LAS bf16*)(lds + P3_CKV_OFF); LAS bf16* ufs = (LAS bf16*)(lds + P3_UF_OFF);
    LAS float* rq = (LAS float*)(lds + P3_R_OFF); LAS float* rkv = rq + 64;
    const int t0 = chunk * 64, b = t0 >> 12, s0 = t0 & 4095, fr = lane & 15, fq = lane >> 4;
#pragma unroll
    for (int i = 0; i < 4; ++i) { const int p = tid + 512 * i, r = p >> 5, c = p & 31; *(LAS v4u*)(cqs + r * P3_CQ_LD + c * 8) = *(const v4u*)(CQ + (size_t)(t0 + r) * 256 + c * 8); }
#pragma unroll
    for (int i = 0; i < 2; ++i) { const int p = tid + 512 * i, r = p >> 4, c = p & 15; *(LAS v4u*)(ckvs + r * P3_CKV_LD + c * 8) = *(const v4u*)(CKV + (size_t)(t0 + r) * 128 + c * 8); }
#pragma unroll
    for (int i = 0; i < 8; ++i) { const int p = tid + 512 * i, r = p >> 6, c = p & 63; *(LAS v4u*)(ufs + r * P3_UF_LD + c * 8) = *(const v4u*)(UF + (size_t)(t0 + r) * 512 + c * 8); }
    __syncthreads();
#pragma unroll
    for (int i = 0; i < 8; ++i) { const int r = wave * 8 + i;
        const v2u u = *(const LAS v2u*)(cqs + r * P3_CQ_LD + lane * 4);
        const float x0 = __uint_as_float(u.x << 16), x1 = __uint_as_float(u.x & 0xffff0000u), x2 = __uint_as_float(u.y << 16), x3 = __uint_as_float(u.y & 0xffff0000u);
        const float sq = wsum((x0 * x0 + x1 * x1) + (x2 * x2 + x3 * x3));
        const unsigned v = *(const LAS unsigned*)(ckvs + r * P3_CKV_LD + lane * 2);
        const float y0 = __uint_as_float(v << 16), y1 = __uint_as_float(v & 0xffff0000u);
        const float sk = wsum(y0 * y0 + y1 * y1);
        if (lane == 0) { rq[r] = rsqrtf(sq * (1.f / 256.f) + 1e-6f); rkv[r] = rsqrtf(sk * (1.f / 128.f) + 1e-6f); } }
    __syncthreads();
    const size_t bh = (size_t)(b * NH + wave) * NS;
    {
        f32x4 acc[4][6];
#pragma unroll
        for (int m = 0; m < 4; ++m)
#pragma unroll
            for (int n = 0; n < 6; ++n) acc[m][n] = (f32x4){0.f, 0.f, 0.f, 0.f};
#pragma unroll 1
        for (int kt = 0; kt < 8; ++kt) { bf16x8 af[4], wf[6];
#pragma unroll
            for (int m = 0; m < 4; ++m) af[m] = *(const LAS bf16x8*)(cqs + (16 * m + fr) * P3_CQ_LD + kt * 32 + 8 * fq);
#pragma unroll
            for (int n = 0; n < 6; ++n) wf[n] = *(const bf16x8*)(Wuq + (size_t)(96 * wave + 16 * n + fr) * 256 + kt * 32 + 8 * fq);
#pragma unroll
            for (int m = 0; m < 4; ++m)
#pragma unroll
                for (int n = 0; n < 6; ++n) acc[m][n] = __builtin_amdgcn_mfma_f32_16x16x32_bf16(wf[n], af[m], acc[m][n], 0, 0, 0); }
#pragma unroll
        for (int m = 0; m < 4; ++m) { const int tl = 16 * m + fr, t = t0 + tl; const float sc = rq[tl] * 0.10206207261596575f;
            bf16* qrow = Qo + (bh + s0 + tl) * QKD + 4 * fq;
#pragma unroll
            for (int n = 0; n < 4; ++n) { const f32x4 v = acc[m][n] * sc; v2u w; w.x = cvt_pk_bf16(v[0], v[1]); w.y = cvt_pk_bf16(v[2], v[3]); *(v2u*)(qrow + 16 * n) = w; }
            const f32x4 cs = *(const f32x4*)(rope + (size_t)t * 16 + 4 * fq), sn = *(const f32x4*)(rope + (size_t)NT * 16 + (size_t)t * 16 + 4 * fq);
            const f32x4 t1 = acc[m][4] * sc, t2 = acc[m][5] * sc; const f32x4 o1 = t1 * cs - t2 * sn, o2 = t2 * cs + t1 * sn;
            v2u w1, w2; w1.x = cvt_pk_bf16(o1[0], o1[1]); w1.y = cvt_pk_bf16(o1[2], o1[3]); w2.x = cvt_pk_bf16(o2[0], o2[1]); w2.y = cvt_pk_bf16(o2[2], o2[3]);
            *(v2u*)(qrow + 64) = w1; *(v2u*)(qrow + 80) = w2; }
    }
#pragma unroll 1
    for (int pass = 0; pass < 2; ++pass) {
        f32x4 acc[4][4];
#pragma unroll
        for (int m = 0; m < 4; ++m)
#pragma unroll
            for (int n = 0; n < 4; ++n) acc[m][n] = (f32x4){0.f, 0.f, 0.f, 0.f};
#pragma unroll
        for (int kt = 0; kt < 4; ++kt) { bf16x8 af[4], wf[4];
#pragma unroll
            for (int m = 0; m < 4; ++m) af[m] = *(const LAS bf16x8*)(ckvs + (16 * m + fr) * P3_CKV_LD + kt * 32 + 8 * fq);
#pragma unroll
            for (int n = 0; n < 4; ++n) wf[n] = *(const bf16x8*)(Wukv + (size_t)(512 * pass + 64 * wave + 16 * n + fr) * 128 + kt * 32 + 8 * fq);
#pragma unroll
            for (int m = 0; m < 4; ++m)
#pragma unroll
                for (int n = 0; n < 4; ++n) acc[m][n] = __builtin_amdgcn_mfma_f32_16x16x32_bf16(wf[n], af[m], acc[m][n], 0, 0, 0); }
#pragma unroll
        for (int m = 0; m < 4; ++m) { const int tl = 16 * m + fr; const float sc = rkv[tl];
            bf16* orow = (pass == 0) ? (Ko + (bh + s0 + tl) * QKD + 4 * fq) : (Vo + (bh + s0 + tl) * VH + 4 * fq);
#pragma unroll
            for (int n = 0; n < 4; ++n) { const f32x4 v = acc[m][n] * sc; v2u w; w.x = cvt_pk_bf16(v[0], v[1]); w.y = cvt_pk_bf16(v[2], v[3]); *(v2u*)(orow + 16 * n) = w; } }
    }
#pragma unroll
    for (int i = 0; i < 4; ++i) { const int p = lane + 64 * i, tl = p >> 2, c = p & 3;
        *(v4u*)(Ko + (bh + s0 + tl) * QKD + 64 + 8 * c) = *(const v4u*)(KPE + (size_t)(t0 + tl) * 32 + 8 * c); }
#pragma unroll 1
    for (int pass = 0; pass < 2; ++pass) {
        f32x4 acc[4][4];
#pragma unroll
        for (int m = 0; m < 4; ++m)
#pragma unroll
            for (int n = 0; n < 4; ++n) acc[m][n] = (f32x4){0.f, 0.f, 0.f, 0.f};
#pragma unroll
        for (int kt = 0; kt < 2; ++kt) { bf16x8 af[4], wf[4];
#pragma unroll
            for (int m = 0; m < 4; ++m) af[m] = *(const LAS bf16x8*)(ufs + (16 * m + fr) * P3_UF_LD + 64 * wave + kt * 32 + 8 * fq);
#pragma unroll
            for (int n = 0; n < 4; ++n) wf[n] = *(const bf16x8*)(CSt + (size_t)(64 * pass + 16 * n + fr) * 64 + kt * 32 + 8 * fq);
#pragma unroll
            for (int m = 0; m < 4; ++m)
#pragma unroll
                for (int n = 0; n < 4; ++n) acc[m][n] = __builtin_amdgcn_mfma_f32_16x16x32_bf16(af[m], wf[n], acc[m][n], 0, 0, 0); }
#pragma unroll
        for (int m = 0; m < 4; ++m)
#pragma unroll
            for (int n = 0; n < 4; ++n) { const f32x4 v = acc[m][n];
                *(unsigned*)((unsigned char*)UCS + ((size_t)(b * 512 + 64 * wave + 16 * n + fr)) * 8192 + 4096 * pass + s0 + 16 * m + 4 * fq) = pack_fp8x4(v[0], v[1], v[2], v[3]); }
    }
    __syncthreads();
}

__device__ __forceinline__ void conv_phase(const FastArgs& a, unsigned char* ws, int vcu, int G, int tid) {
    const bf16* gbp = (const bf16*)(ws + WS_PC); const bf16* up = (const bf16*)(ws + WS_PC + (size_t)NT * DM * 2); bf16* yc = (bf16*)(ws + WS_YC); const float* cw = a.in[17];
    for (int i = vcu * 512 + tid; i < NT * 128; i += G * 512) { const int t = i >> 7, c = (i & 127) * 8, s = t & 4095;
        const bf16x8 gb = *(const bf16x8*)(gbp + (size_t)t * DM + c), u1 = *(const bf16x8*)(up + (size_t)t * DM + c);
        bf16x8 u0 = {0, 0, 0, 0, 0, 0, 0, 0}, u2 = u0;
        if (s > 0) u0 = *(const bf16x8*)(up + (size_t)(t - 1) * DM + c);
        if (s < NS - 1) u2 = *(const bf16x8*)(up + (size_t)(t + 1) * DM + c);
        const f32x4 w0a = *(const f32x4*)(cw + c), w0b = *(const f32x4*)(cw + c + 4), w1a = *(const f32x4*)(cw + 1024 + c), w1b = *(const f32x4*)(cw + 1024 + c + 4), w2a = *(const f32x4*)(cw + 2048 + c), w2b = *(const f32x4*)(cw + 2048 + c + 4);
        float y[8];
#pragma unroll
        for (int j = 0; j < 8; ++j) { const float w0 = j < 4 ? w0a[j & 3] : w0b[j & 3], w1 = j < 4 ? w1a[j & 3] : w1b[j & 3], w2 = j < 4 ? w2a[j & 3] : w2b[j & 3];
            y[j] = bf2f((bf16)gb[j]) * (bf2f((bf16)u0[j]) * w0 + bf2f((bf16)u1[j]) * w1 + bf2f((bf16)u2[j]) * w2); }
        v4u w = {cvt_pk_bf16(y[0], y[1]), cvt_pk_bf16(y[2], y[3]), cvt_pk_bf16(y[4], y[5]), cvt_pk_bf16(y[6], y[7])};
        *(v4u*)(yc + (size_t)t * DM + c) = w; }
}

constexpr int N_PHASES = 17;
#ifndef PHMASK
#define PHMASK 0x1ffff
#endif
#define PHASE_ENV() int tid = threadIdx.x; asm volatile("" : "+v"(tid)); const int lane = tid & 63, wave = __builtin_amdgcn_readfirstlane(tid >> 6); \
    int Gv_ = gridDim.x, bxv_ = blockIdx.x; unsigned wl_ = (unsigned)(unsigned long long)a.ws, wh_ = (unsigned)((unsigned long long)a.ws >> 32); asm volatile("" : "+v"(Gv_), "+v"(bxv_), "+v"(wl_), "+v"(wh_)); \
    const int G = __builtin_amdgcn_readfirstlane(Gv_), bx = __builtin_amdgcn_readfirstlane(bxv_); const int vcu = (G % 8 == 0) ? (bx % 8) * (G / 8) + bx / 8 : bx; \
    unsigned char* ws = (unsigned char*)(GAS unsigned char*)(((unsigned long long)(unsigned)__builtin_amdgcn_readfirstlane((int)wh_) << 32) | (unsigned long long)(unsigned)__builtin_amdgcn_readfirstlane((int)wl_));     \
    int lz_ = 0; asm volatile("" : "+v"(lz_)); LAS unsigned char* ldsp = lds + __builtin_amdgcn_readfirstlane(lz_);     \
    (void)lane; (void)wave; (void)vcu; (void)tid; (void)ldsp
#define IN(k) (((PHMASK >> (k)) & 1) && lo <= (k) && (k) < hi)
#ifndef DUPMASK
#define DUPMASK 0
#endif
#ifndef SEAMREP
#define SEAMREP 1
#endif
#define NREP(k) ((((DUPMASK) >> (k)) & 1) ? 2 : 1)
#define SEAM(k) do { if (IN(k) && IN((k) + 1)) { PHASE_ENV(); XcdBarrier b_; b_.bar = (unsigned*)(ws + WS_CTL) + CW_BAR + a.bar_region * XCD_BAR_WORDS; b_.x = xb_xcc_id(); \
        b_.st = (volatile LAS unsigned*)(lds + MISC_OFF) + 8; for (int sr_ = 0; sr_ < SEAMREP; ++sr_) xcd_barrier(b_); } } while (0)


template <int L> __device__ __forceinline__ void moe_block(const FastArgs& a, LAS unsigned char* lds) {
    extern __shared__ __attribute__((aligned(16))) unsigned char lds_raw[];
#if (MODE & 16)
    constexpr int lo = 0, hi = N_PHASES;
#else
    const int lo = a.ph_lo, hi = a.ph_hi;
#endif
        const int p0 = (L == 0) ? 6 : 13;
        if (IN(p0)) for (int rep_ = 0; rep_ < NREP(p0); ++rep_) { if (rep_) __syncthreads(); PHASE_ENV(); RowArgs r{}; if (L == 0) r.xin = a.in[0]; else r.xin_bf = (const bf16*)(ws + WS_XB); r.o_bf = (const bf16*)(ws + WS_O); r.xout_bf = (bf16*)(ws + WS_XA);
#if MOE_FP8
            r.h8 = (unsigned char*)(ws + WS_H8);
#else
            r.h = (bf16*)(ws + WS_H);
#endif
            r.mod = (const float*)(ws + WS_MOD) + L * 4 * 6144; r.gamma = a.in[5] + L * DM; r.beta = a.in[6] + L * DM;
            r.wr = a.in[19] + (size_t)L * DM * NE; r.br = a.in[20] + L * NE; r.topi = (int*)(ws + WS_TOPI); r.tpos = (int*)(ws + WS_TPOS); r.gate = (float*)(ws + WS_GATE); r.list = (int*)(ws + WS_LIST);
            r.cnt = (unsigned*)(ws + WS_CTL) + CW_CNT + 32 * L;
            if (NREP(p0) == 2 && rep_ == 0) { r.cnt += 1024; r.topi = (int*)(ws + WS_TMP); r.tpos = (int*)(ws + WS_TMP + MiB); r.gate = (float*)(ws + WS_TMP + 2 * MiB); r.list = (int*)(ws + WS_TMP + 4 * MiB); }
            load_wl(r.wr, (char*)lds_raw, tid); __syncthreads();
            for (int ch = vcu; ch < NT / 64; ch += G) rp_b_chunk(r, ch, wave, lane, (char*)lds_raw); }
        SEAM(p0);
        if (IN(p0 + 1)) for (int rep_ = 0; rep_ < NREP(p0 + 1); ++rep_) { if (rep_) __syncthreads(); PHASE_ENV(); const unsigned* cntL = (const unsigned*)(ws + WS_CTL) + CW_CNT + 32 * L; const size_t EW = (size_t)L * NE * DM * DM, EB = (size_t)L * NE * DM;
            compute_poff(cntL, (int*)(lds_raw + MISC_OFF + 256), tid); __syncthreads();
#if MOE_FP8
            pg8::MoeSched S{(const LAS int*)(ldsp + MISC_OFF + 256), (const char*)(ws + WS_H8), (const char*)(ws + WS_WUP) + EW * 2, (const int*)(ws + WS_LIST), cntL, 8, G, vcu, (size_t)2048 * DM, true, DM};
            pg8::EpiUp8 E{(unsigned char*)(ws + WS_AACT), a.in[22] + EB, a.in[24] + EB};
            pg8::gemm_phase<pg8::EpiUp8, pg8::MoeSched, true, true, true>(ldsp, DM, S, E); }
#else
            pg8::MoeSched S{(const LAS int*)(ldsp + MISC_OFF + 256), (const char*)(ws + WS_H), (const char*)(ws + WS_WUP) + EW * 4, (const int*)(ws + WS_LIST), cntL, 8, G, vcu, (size_t)2048 * DM * 2, true, 2 * DM};
            pg8::EpiUp E{(bf16*)(ws + WS_AACT), a.in[22] + EB, a.in[24] + EB};
            pg8::gemm_phase<pg8::EpiUp, pg8::MoeSched, true, true>(ldsp, 2 * DM, S, E); }
#endif
        SEAM(p0 + 1);
        if (IN(p0 + 2)) for (int rep_ = 0; rep_ < NREP(p0 + 2); ++rep_) { if (rep_) __syncthreads(); PHASE_ENV(); const unsigned* cntL = (const unsigned*)(ws + WS_CTL) + CW_CNT + 32 * L; const size_t EW = (size_t)L * NE * DM * DM, EB = (size_t)L * NE * DM;
            compute_poff(cntL, (int*)(lds_raw + MISC_OFF + 256), tid); __syncthreads();
#if MOE_FP8
            pg8::MoeSched S{(const LAS int*)(ldsp + MISC_OFF + 256), (const char*)(ws + WS_AACT), (const char*)(ws + WS_WDN) + EW, (const int*)(ws + WS_LIST), cntL, 4, G, vcu, (size_t)DM * DM, false, DM};
            pg8::EpiDown8 E{(bf16*)(ws + WS_Y), a.in[26] + EB};
            pg8::gemm_phase<pg8::EpiDown8, pg8::MoeSched, false, true, true>(ldsp, DM, S, E); }
#else
            pg8::MoeSched S{(const LAS int*)(ldsp + MISC_OFF + 256), (const char*)(ws + WS_AACT), (const char*)(ws + WS_WDN) + EW * 2, (const int*)(ws + WS_LIST), cntL, 4, G, vcu, (size_t)DM * DM * 2, false, 2 * DM};
            pg8::EpiDown E{(bf16*)(ws + WS_Y), a.in[26] + EB};
            pg8::gemm_phase<pg8::EpiDown, pg8::MoeSched, false, true>(ldsp, 2 * DM, S, E); }
#endif
        SEAM(p0 + 2);
        if (IN(p0 + 3)) for (int rep_ = 0; rep_ < NREP(p0 + 3); ++rep_) { if (rep_) __syncthreads(); PHASE_ENV(); RowArgs r{}; r.xin_bf = (const bf16*)(ws + WS_XA); if (L == 0) r.xout_bf = (bf16*)(ws + WS_XB); else r.xout = a.out; r.h = (bf16*)(ws + WS_H);
            r.mod = (const float*)(ws + WS_MOD) + L * 4 * 6144; r.mod_next = (const float*)(ws + WS_MOD) + 4 * 6144; r.gamma = a.in[7] + L * DM; r.beta = a.in[8] + L * DM;
            r.topi = (int*)(ws + WS_TOPI); r.tpos = (int*)(ws + WS_TPOS); r.gate = (float*)(ws + WS_GATE); r.y = (const bf16*)(ws + WS_Y); r.cntc = (const unsigned*)(ws + WS_CTL) + CW_CNT + 32 * L;
            compute_poff(r.cntc, (int*)(lds_raw + MISC_OFF + 256), tid); __syncthreads();
            for (int ch = vcu; ch < NT / 64; ch += G) rp_c_chunk(r, ch, wave, lane, (const int*)(lds_raw + MISC_OFF + 256), L == 1); }
}

__global__ void __launch_bounds__(512) mk_fwd(FastArgs a) {
    extern __shared__ __attribute__((aligned(16))) unsigned char lds_raw[];
    LAS unsigned char* lds = (LAS unsigned char*)lds_raw;
    { volatile LAS unsigned* MISC = (volatile LAS unsigned*)(lds + MISC_OFF);
      for (int u = threadIdx.x; u < (LDS_BYTES - MISC_OFF) / 4; u += 512) ((LAS unsigned*)(lds + MISC_OFF))[u] = 0u;
      __syncthreads();
      (void)xcd_barrier_post((unsigned*)(a.ws + WS_CTL) + CW_BAR + a.bar_region * XCD_BAR_WORDS, MISC + 8); }
#if (MODE & 16)
    constexpr int lo = 0, hi = N_PHASES;
#else
    const int lo = a.ph_lo, hi = a.ph_hi;
#endif
    if (IN(0)) for (int rep_ = 0; rep_ < NREP(0); ++rep_) { if (rep_) __syncthreads(); PHASE_ENV(); p0_prologue(a, ldsp, vcu, G, tid, wave, lane); } SEAM(0);
    if (IN(1)) for (int rep_ = 0; rep_ < NREP(1); ++rep_) { if (rep_) __syncthreads(); PHASE_ENV(); RowArgs r{}; r.xin = a.in[0]; r.h = (bf16*)(ws + WS_H); r.mod = (const float*)(ws + WS_MOD); for (int ch = vcu; ch < NT / 64; ch += G) rp_a_chunk(r, ch, wave, lane); } SEAM(1);
    if (IN(2)) for (int rep_ = 0; rep_ < NREP(2); ++rep_) { if (rep_) __syncthreads(); PHASE_ENV(); pg8::DenseSched S; S.init(ws + WS_H, ws + WS_WIN, NT, 1024, 1024, G, bx);
        pg8::EpiG1 E{(bf16*)(ws + WS_CQ), (bf16*)(ws + WS_CKV), (bf16*)(ws + WS_KPE), (bf16*)(ws + WS_UF), (const float*)(ws + WS_ROPE)};
        pg8::gemm_phase<pg8::EpiG1, pg8::DenseSched, false, true>(ldsp, 2048, S, E); } SEAM(2);
    if (IN(3)) for (int rep_ = 0; rep_ < NREP(3); ++rep_) { if (rep_) __syncthreads(); PHASE_ENV(); for (int ch = vcu; ch < NT / 64; ch += G) p3_unit(a, ch, ldsp); } SEAM(3);
    if (IN(4)) for (int rep_ = 0; rep_ < NREP(4); ++rep_) { if (rep_) __syncthreads(); PHASE_ENV();
        const bool deal = (G == 256);
#ifndef P4_SKIP0
#define P4_SKIP0 0
#endif
        if (!((P4_SKIP0 & 1) && NREP(4) == 2 && rep_ == 0))
        for (int u = vcu; u < 256; u += G) { pg8::ListSched S{(const char*)(ws + WS_DMAT), (const char*)(ws + WS_UCS), 4096  , 8, u, 1, 1};
            pg8::EpiOutBf E{(bf16*)(ws + WS_OCAT), DM, 1, 1.f / 512.f}; pg8::gemm_phase<pg8::EpiOutBf, pg8::ListSched, false, true, true>(ldsp, 8192, S, E); }
        const int ufirst = deal ? 2 * vcu : vcu, ucount = deal ? 2 : (512 - vcu + G - 1) / G, ustep = deal ? 1 : G;
        const bf16* Qb = (const bf16*)(ws + WS_Q); const bf16* Kb = (const bf16*)(ws + WS_K); const bf16* Vb = (const bf16*)(ws + WS_V); bf16* OC = (bf16*)(ws + WS_OCAT);
        const float* bg_src0 = a.in[21]; const float* bg_src1 = a.in[23]; const float* bg_src2 = a.in[25]; unsigned char* bg_wup = (unsigned char*)(ws + WS_WUP); unsigned char* bg_wdn = (unsigned char*)(ws + WS_WDN);
        const int gw_ = __builtin_amdgcn_readfirstlane(vcu * NWAVES + (tid >> 6));
        int c_it = deal ? gw_ * 64 : 0; const int c_end = deal ? gw_ * 64 + 64 : 0;
        const bool bg_on = deal && !(NREP(4) == 2 && rep_ == 0);
        if (!((P4_SKIP0 & 2) && NREP(4) == 2 && rep_ == 0))
        for (int i = 0; i < ucount; ++i) { const int u = ufirst + i * ustep; if (u < 512) { const int bhh = u >> 4, qb = u & 15, b = bhh >> 3, h = bhh & 7;
            const bf16* q_ = Qb + ((size_t)bhh * NS + qb * 256) * QKD; const bf16* k_ = Kb + (size_t)bhh * NS * QKD; const bf16* v_ = Vb + (size_t)bhh * NS * VH; bf16* o_ = OC + ((size_t)(b * NS + qb * 256)) * DM + h * 64;
            if (bg_on) att::attn_unit<true>(q_, k_, v_, o_, DM, NS, (char*)lds_raw, bg_src0, bg_src1, bg_src2, bg_wup, bg_wdn, c_it, c_end);
            else att::attn_unit<false>(q_, k_, v_, o_, DM, NS, (char*)lds_raw, bg_src0, bg_src1, bg_src2, bg_wup, bg_wdn, c_it, c_end); } }
    } SEAM(4);
    if (IN(5)) for (int rep_ = 0; rep_ < NREP(5); ++rep_) { if (rep_) __syncthreads(); PHASE_ENV(); pg8::DenseSched S; S.init(ws + WS_OCAT, ws + WS_WOUT0, NT, 1024, 1024, G, bx); pg8::EpiOutBf E{(bf16*)(ws + WS_O), DM, 0, 1.f};
        pg8::gemm_phase<pg8::EpiOutBf, pg8::DenseSched, false, true>(ldsp, 2048, S, E); } SEAM(5);
    moe_block<0>(a, lds);

            SEAM(9);
            if (IN(10)) for (int rep_ = 0; rep_ < NREP(10); ++rep_) { if (rep_) __syncthreads(); PHASE_ENV(); pg8::DenseSched S; S.init(ws + WS_H, ws + WS_WCIN, NT, 3072, 1024, G, bx); pg8::EpiConv E{(bf16*)(ws + WS_PC), (bf16*)(ws + WS_PC + (size_t)NT * DM * 2)};
                pg8::gemm_phase<pg8::EpiConv, pg8::DenseSched, false, true>(ldsp, 2048, S, E); } SEAM(10);
            if (IN(11)) for (int rep_ = 0; rep_ < NREP(11); ++rep_) { if (rep_) __syncthreads(); PHASE_ENV(); conv_phase(a, ws, vcu, G, tid); } SEAM(11);
            if (IN(12)) for (int rep_ = 0; rep_ < NREP(12); ++rep_) { if (rep_) __syncthreads(); PHASE_ENV(); pg8::DenseSched S; S.init(ws + WS_YC, ws + WS_WCOUT, NT, 1024, 1024, G, bx); pg8::EpiOutBf E{(bf16*)(ws + WS_O), DM, 0, 1.f};
                pg8::gemm_phase<pg8::EpiOutBf, pg8::DenseSched, false, true>(ldsp, 2048, S, E); } SEAM(12);

    moe_block<1>(a, lds);
#undef IN
#undef SEAM
}
#if HYBRID
template <typename TA, bool BNT, typename Epi>
static void gemm(hipStream_t st, const TA* A, int lda, const void* B, int ldb, int M, int N, int K, const float* ascale, Epi epi) {
    dim3 g((N + 63) / 64, (M + 63) / 64);
    hipLaunchKernelGGL((n_gemm<TA, BNT, Epi>), g, dim3(256), 0, st, A, B, ascale, epi, lda, ldb, M, N, K, 0);
}
#endif

extern "C" void kernel_launch(void* const* d_in, const int* in_sizes, int n_in, void* d_out, int out_size, void* d_ws, size_t ws_size, hipStream_t stream) {
    static int inited = 0; static int grid = 0;
    if (!inited) {
        if (ws_size < WS_END2 || n_in != 27) { fprintf(stderr, "kernel_launch: workspace too small (%zu < %zu) or n_in %d != 27\n", ws_size, (size_t)WS_END2, n_in); inited = -1; return; }
#if HYBRID
        (void)hipFuncSetAttribute((const void*)k_rp_b, hipFuncAttributeMaxDynamicSharedMemorySize, RP_LDS_BYTES);
#endif
        if (hipFuncSetAttribute((const void*)mk_fwd, hipFuncAttributeMaxDynamicSharedMemorySize, LDS_BYTES) != hipSuccess) { fprintf(stderr, "kernel_launch: hipFuncSetAttribute(mk_fwd) failed\n"); inited = -1; return; }
        int dev = 0, cus = 0;
        if (hipGetDevice(&dev) != hipSuccess || hipDeviceGetAttribute(&cus, hipDeviceAttributeMultiprocessorCount, dev) != hipSuccess) { inited = -1; return; }
        int per_cu = 0;
        if (hipOccupancyMaxActiveBlocksPerMultiprocessor(&per_cu, (const void*)mk_fwd, 512, LDS_BYTES) != hipSuccess || per_cu < 1) { fprintf(stderr, "kernel_launch: occupancy query says %d blocks per CU\n", per_cu); }
        (void)hipGetLastError();
        grid = cus;
        inited = 1;
    }
    if (inited < 0) return;
    const float* x = (const float*)d_in[0]; const float* c = (const float*)d_in[1]; const int* positions = (const int*)d_in[2];
    const float* ada_w = (const float*)d_in[3]; const float* ada_b = (const float*)d_in[4];
    const float* ln_mix_g = (const float*)d_in[5]; const float* ln_mix_b = (const float*)d_in[6]; const float* ln_ffn_g = (const float*)d_in[7]; const float* ln_ffn_b = (const float*)d_in[8];
    const float* mla_w_in = (const float*)d_in[9]; const float* q_norm_g = (const float*)d_in[10]; const float* kv_norm_g = (const float*)d_in[11];
    const float* w_uq = (const float*)d_in[12]; const float* w_uk = (const float*)d_in[13]; const float* w_uv = (const float*)d_in[14]; const float* mix_a_w_out = (const float*)d_in[15];
    const float* conv_w_in = (const float*)d_in[16]; const float* conv_w = (const float*)d_in[17]; const float* conv_w_out = (const float*)d_in[18];
    const float* w_router = (const float*)d_in[19]; const float* b_router = (const float*)d_in[20];
    const float* w_glu = (const float*)d_in[21]; const float* b_glu = (const float*)d_in[22]; const float* w_lin = (const float*)d_in[23]; const float* b_lin = (const float*)d_in[24];
    const float* w_down = (const float*)d_in[25]; const float* b_down = (const float*)d_in[26];
    char* ws = (char*)d_ws;
    unsigned* ctl = (unsigned*)(ws + WS_CTL);
    float* MOD = (float*)(ws + WS_MOD); float* ROPE = (float*)(ws + WS_ROPE); float* RQ = (float*)(ws + WS_RQ); float* RKV = RQ + NT;
    int* TOPI = (int*)(ws + WS_TOPI); int* TPOS = (int*)(ws + WS_TPOS); float* GATE = (float*)(ws + WS_GATE); int* LIST = (int*)(ws + WS_LIST);
    bf16* H = (bf16*)(ws + WS_H); bf16* CQ = (bf16*)(ws + WS_CQ); bf16* CKV = (bf16*)(ws + WS_CKV); bf16* KPE = (bf16*)(ws + WS_KPE); bf16* UF = (bf16*)(ws + WS_UF);
    bf16* Qb = (bf16*)(ws + WS_Q); bf16* Kb = (bf16*)(ws + WS_K); bf16* Vb = (bf16*)(ws + WS_V); bf16* UCS = (bf16*)(ws + WS_UCS); bf16* DMAT = (bf16*)(ws + WS_DMAT);
    bf16* OCAT = (bf16*)(ws + WS_OCAT); float* O = (float*)(ws + WS_O); float* XA = (float*)(ws + WS_XA); float* XB = (float*)(ws + WS_XB);
    float* TMP = (float*)(ws + WS_TMP); bf16* PC = (bf16*)(ws + WS_PC); bf16* YC = (bf16*)(ws + WS_YC); bf16* AACT = (bf16*)(ws + WS_AACT); bf16* Yb = (bf16*)(ws + WS_Y);
    float* KR = TMP + (size_t)NT * 768;
    const float* MOD0 = MOD; const float* MOD1 = MOD + 4 * 6144;
    const size_t EW = (size_t)NE * DM * DM, EB = (size_t)NE * DM;

    (void)hipMemsetAsync(ws + WS_CTL, 0, CTL_BYTES, stream);
    FastArgs fa{};
    for (int i = 0; i < 27; ++i) fa.in[i] = (const float*)d_in[i];
    fa.out = (float*)d_out; fa.ws = (unsigned char*)d_ws;
    int region = 0;
    auto fast = [&](int lo, int hi) { fa.ph_lo = lo; fa.ph_hi = hi; fa.bar_region = region++; hipLaunchKernelGGL(mk_fwd, dim3(grid), dim3(512), LDS_BYTES, stream, fa); };
    constexpr bool F_GEMM = (MODE & 1) != 0, F_MOE = (MODE & 2) != 0, F_ATT = (MODE & 4) != 0, F_P3 = (MODE & 8) != 0, F_ONE = (MODE & 16) != 0;
    if (F_ONE) { fast(0, N_PHASES); return; }
#if HYBRID

    if (F_GEMM) fast(0, 3);
    else {
        hipLaunchKernelGGL(n_mod, dim3(6144 / 256, 2), dim3(256), 0, stream, c, ada_w, ada_b, MOD);
        hipLaunchKernelGGL(n_rope, dim3(NT * 16 / 256), dim3(256), 0, stream, positions, ROPE);
        hipLaunchKernelGGL(n_dmat, dim3(4096 * 8192 / 256), dim3(256), 0, stream, DMAT);
        { RowArgs a{}; a.xin = x; a.h = H; a.mod = MOD0; hipLaunchKernelGGL(k_rp_a, dim3(256), dim3(512), 0, stream, a); }
        gemm<bf16, false>(stream, H, DM, mla_w_in, PROJ_A, NT, PROJ_A, DM, nullptr, EpiP2{CQ, CKV, KR, UF});
        hipLaunchKernelGGL(n_kpe, dim3(NT * 16 / 256), dim3(256), 0, stream, KR, ROPE, KPE);
    }
    if (F_P3) fast(3, 4);
    else {
        hipLaunchKernelGGL(n_rms, dim3(NT / 256), dim3(256), 0, stream, CQ, CKV, RQ, RKV);
        gemm<bf16, false>(stream, CQ, 256, w_uq, 768, NT, 768, 256, q_norm_g, EpiQ{TMP, RQ});
        hipLaunchKernelGGL(n_qfin, dim3(NT * 768 / 256), dim3(256), 0, stream, TMP, ROPE, Qb);
        gemm<bf16, false>(stream, CKV, 128, w_uk, 512, NT, 512, 128, kv_norm_g, EpiKV{Kb, RKV, QKD});
        gemm<bf16, false>(stream, CKV, 128, w_uv, 512, NT, 512, 128, kv_norm_g, EpiKV{Vb, RKV, VH});
        hipLaunchKernelGGL(n_kcopy, dim3(NT * NH * 32 / 256), dim3(256), 0, stream, KPE, Kb);
        hipLaunchKernelGGL(n_fnet_ch, dim3(NS / 256, 512, NB), dim3(256), 0, stream, UF, UCS);
    }
    if (F_ATT) fast(4, 5);
    else {
        hipLaunchKernelGGL(n_attn, dim3(NS / 256, NH, NB), dim3(256), 0, stream, Qb, Kb, Vb, OCAT);
        gemm<bf16, true>(stream, DMAT, 8192, UCS, 8192, NS, NB * 512, 8192, nullptr, EpiFnet{OCAT});
    }
    if (F_GEMM) fast(5, 6);
    else gemm<bf16, false>(stream, OCAT, DM, mix_a_w_out, DM, NT, DM, DM, nullptr, EpiF32{O, DM});
    for (int L = 0; L < 2; ++L) {
        unsigned* cntL = ctl + CW_CNT + 32 * L;
        const int p0 = L == 0 ? 6 : 13;
        if (F_MOE) fast(p0, p0 + 4);
        else {
            { RowArgs a{}; a.xin = L == 0 ? x : XB; a.o = O; a.xout = XA; a.h = H; a.mod = L == 0 ? MOD0 : MOD1; a.gamma = ln_mix_g + L * DM; a.beta = ln_mix_b + L * DM;
              a.wr = w_router + (size_t)L * DM * NE; a.br = b_router + L * NE; a.topi = TOPI; a.tpos = TPOS; a.gate = GATE; a.list = LIST; a.cnt = cntL;
              hipLaunchKernelGGL(k_rp_b, dim3(256), dim3(512), RP_LDS_BYTES, stream, a); }
            hipLaunchKernelGGL(n_moe_up, dim3(16, NT / 64, NE), dim3(256), 0, stream, H, w_glu + L * EW, b_glu + L * EB, w_lin + L * EW, b_lin + L * EB, LIST, cntL, AACT);
            hipLaunchKernelGGL(n_moe_down, dim3(16, NT / 64, NE), dim3(256), 0, stream, AACT, w_down + L * EW, b_down + L * EB, cntL, Yb);
            { RowArgs a{}; a.xin = XA; a.xout = L == 0 ? XB : (float*)d_out; a.h = H; a.mod = L == 0 ? MOD0 : MOD1; a.mod_next = MOD1; a.gamma = ln_ffn_g + L * DM; a.beta = ln_ffn_b + L * DM;
              a.topi = TOPI; a.tpos = TPOS; a.gate = GATE; a.y = Yb; a.cntc = cntL; a.final_ = L;
              hipLaunchKernelGGL(k_rp_c, dim3(256), dim3(512), 0, stream, a); }
        }
        if (L == 0) {
            if (F_GEMM) fast(10, 13);
            else {
                gemm<bf16, false>(stream, H, DM, conv_w_in, 3072, NT, 3072, DM, nullptr, EpiBf{PC, 3072});
                hipLaunchKernelGGL(n_conv, dim3(NT * DM / 256), dim3(256), 0, stream, PC, conv_w, YC);
                gemm<bf16, false>(stream, YC, DM, conv_w_out, DM, NT, DM, DM, nullptr, EpiF32{O, DM});
            }
        }
    }
#endif
}
```

```cpp
#include <hip/hip_runtime.h>
#include <cstdio>
#include <cstdint>

#ifndef MODE
#define MODE 31
#endif
#define HYBRID (!(MODE & 16))

constexpr int NB = 4, NS = 4096, DM = 1024, NT = NB * NS;
constexpr int NH = 8, QKN = 64, QKR = 32, QKD = 96, VH = 64, QRANK = 256, KVRANK = 128;
constexpr int PROJ_A = 928;
constexpr int NE = 32, TOPK = 4;
constexpr float ALPHA = 1.4142135623730951f;
constexpr float SWL = 7.0f, SWA = 1.702f;
constexpr int SLOTS = NT * TOPK + NE * 256;

typedef unsigned short bf16;
__device__ __forceinline__ float bf2f(bf16 v) { return __uint_as_float(((unsigned)v) << 16); }
__device__ __forceinline__ bf16 f2bf(float f) { unsigned u = __float_as_uint(f); return (bf16)((u + 0x7fffu + ((u >> 16) & 1u)) >> 16); }
__device__ __forceinline__ float tof(float v) { return v; }
__device__ __forceinline__ float tof(bf16 v) { return bf2f(v); }

constexpr size_t MiB = 1u << 20;
constexpr size_t WS_CTL = 0;
constexpr size_t CTL_BYTES = 1 * MiB;
constexpr size_t WS_MOD = 1 * MiB;
constexpr size_t WS_ROPE = 2 * MiB;
constexpr size_t WS_RQ = 4 * MiB;
constexpr size_t WS_TOPI = 5 * MiB;
constexpr size_t WS_TPOS = 6 * MiB;
constexpr size_t WS_GATE = 7 * MiB;
constexpr size_t WS_LIST = 8 * MiB;
constexpr size_t WS_H = 16 * MiB;
constexpr size_t WS_O = 48 * MiB;
constexpr size_t WS_XA = 112 * MiB;
constexpr size_t WS_XB = 176 * MiB;
constexpr size_t WS_CQ = 240 * MiB;
constexpr size_t WS_CKV = 248 * MiB;
constexpr size_t WS_KPE = 252 * MiB;
constexpr size_t WS_UF = 256 * MiB;
constexpr size_t WS_Q = 272 * MiB;
constexpr size_t WS_K = 296 * MiB;
constexpr size_t WS_V = 320 * MiB;
constexpr size_t WS_UCS = 336 * MiB;
constexpr size_t WS_DMAT = 368 * MiB;
constexpr size_t WS_OCAT = 432 * MiB;
constexpr size_t WS_TMP = 464 * MiB;
constexpr size_t WS_PC = 240 * MiB;
constexpr size_t WS_YC = 336 * MiB;
constexpr size_t WS_AACT = 240 * MiB;
constexpr size_t WS_Y = 384 * MiB;
constexpr size_t WS_END = 528 * MiB;
constexpr int CW_CNT = 64;

template <int CTRL> __device__ __forceinline__ float dppf(float v) { return __int_as_float(__builtin_amdgcn_update_dpp(0, __float_as_int(v), CTRL, 0xf, 0xf, false)); }
__device__ __forceinline__ float wsum(float v) {
    v += dppf<0xB1>(v); v += dppf<0x4E>(v); v += dppf<0x141>(v); v += dppf<0x140>(v);
    { auto rr = __builtin_amdgcn_permlane16_swap(__float_as_uint(v), __float_as_uint(v), false, false); v = __uint_as_float(rr[0]) + __uint_as_float(rr[1]); }
    { auto rr = __builtin_amdgcn_permlane32_swap(__float_as_uint(v), __float_as_uint(v), false, false); v = __uint_as_float(rr[0]) + __uint_as_float(rr[1]); }
    return v;
}
__device__ __forceinline__ float swiglu(float g, float l) {
    g = fminf(g, SWL); l = fminf(fmaxf(l, -SWL), SWL);
    const float e = __builtin_amdgcn_exp2f(g * (-SWA * 1.4426950408889634f));
    return g * __builtin_amdgcn_rcpf(1.f + e) * (l + 1.f);
}

#if HYBRID
__global__ void __launch_bounds__(256) n_mod(const float* __restrict__ c, const float* __restrict__ ada_w, const float* __restrict__ ada_b, float* __restrict__ mod) {
    __shared__ float cond[4][1024];
    const int tid = threadIdx.x, n = blockIdx.x * 256 + tid, l = blockIdx.y;
    for (int i = tid; i < 4096; i += 256) { float v = c[i]; cond[i >> 10][i & 1023] = v / (1.f + expf(-v)); }
    __syncthreads();
    float a0 = 0.f, a1 = 0.f, a2 = 0.f, a3 = 0.f;
    const float* w = ada_w + (size_t)l * 1024 * 6144 + n;
    for (int k = 0; k < 1024; ++k) { float wv = w[(size_t)k * 6144]; a0 += cond[0][k] * wv; a1 += cond[1][k] * wv; a2 += cond[2][k] * wv; a3 += cond[3][k] * wv; }
    float bb = ada_b[l * 6144 + n];
    mod[(l * 4 + 0) * 6144 + n] = a0 + bb; mod[(l * 4 + 1) * 6144 + n] = a1 + bb; mod[(l * 4 + 2) * 6144 + n] = a2 + bb; mod[(l * 4 + 3) * 6144 + n] = a3 + bb;
}

__global__ void __launch_bounds__(256) n_rope(const int* __restrict__ pos, float* __restrict__ rope) {
    const int i = blockIdx.x * 256 + threadIdx.x;
    if (i >= NT * 16) return;
    const int t = i >> 4, j = i & 15;
    const float inv = exp2f(-(float)j * (13.287712379549449f / 16.f));
    const float ang = (float)pos[t] * inv;
    const double rev = (double)ang * 0.15915494309189535;
    const float fr = (float)(rev - rint(rev));
    rope[i] = __builtin_amdgcn_cosf(fr);
    rope[NT * 16 + i] = __builtin_amdgcn_sinf(fr);
}

__global__ void __launch_bounds__(256) n_dmat(bf16* __restrict__ dm) {
    const size_t i = (size_t)blockIdx.x * 256 + threadIdx.x;
    const int sp = (int)(i >> 13), k = (int)(i & 8191), s = k & 4095;
    const float fr = (float)((sp * s) & 4095) * (1.f / 4096.f);
    const float v = (k < 4096) ? __builtin_amdgcn_cosf(fr) : -__builtin_amdgcn_sinf(fr);
    dm[i] = f2bf(v * (1.f / 512.f));
}

#endif
__device__ __forceinline__ void ld_row(const float* p, int lane, float4 (&v)[4]) {
#pragma unroll
    for (int j = 0; j < 4; ++j) v[j] = ((const float4*)p)[lane + 64 * j];
}
__device__ __forceinline__ void st_row(float* p, int lane, const float4 (&v)[4]) {
#pragma unroll
    for (int j = 0; j < 4; ++j) ((float4*)p)[lane + 64 * j] = v[j];
}
__device__ __forceinline__ void ld_row_bf(const bf16* p, int lane, float4 (&v)[4]) {
#pragma unroll
    for (int j = 0; j < 4; ++j) { uint2 u = ((const uint2*)p)[lane + 64 * j];
        v[j].x = __uint_as_float(u.x << 16); v[j].y = __uint_as_float(u.x & 0xffff0000u); v[j].z = __uint_as_float(u.y << 16); v[j].w = __uint_as_float(u.y & 0xffff0000u); }
}
typedef __bf16 nbf2_t __attribute__((ext_vector_type(2))); typedef float nf2_t __attribute__((ext_vector_type(2)));
__device__ __forceinline__ unsigned pkbf(float lo, float hi) { nf2_t v = {lo, hi}; nbf2_t b = __builtin_convertvector(v, nbf2_t); return __builtin_bit_cast(unsigned, b); }
__device__ __forceinline__ void st_row_bf(bf16* p, int lane, const float4 (&v)[4]) {
#pragma unroll
    for (int j = 0; j < 4; ++j) { uint2 u; u.x = pkbf(v[j].x, v[j].y); u.y = pkbf(v[j].z, v[j].w); ((uint2*)p)[lane + 64 * j] = u; }
}
__device__ __forceinline__ unsigned pack_fp8x4(float a, float b, float c, float d) { int w = __builtin_amdgcn_cvt_pk_fp8_f32(a, b, 0, false); w = __builtin_amdgcn_cvt_pk_fp8_f32(c, d, w, true); return (unsigned)w; }
__device__ __forceinline__ void st_row_fp8(unsigned char* p, int lane, const float4 (&v)[4]) {
#pragma unroll
    for (int j = 0; j < 4; ++j) ((unsigned*)p)[lane + 64 * j] = pack_fp8x4(v[j].x, v[j].y, v[j].z, v[j].w);
}
__device__ __forceinline__ void ln_inplace(float4 (&v)[4], float eps) {
    float s = 0.f;
#pragma unroll
    for (int j = 0; j < 4; ++j) s += (v[j].x + v[j].y) + (v[j].z + v[j].w);
    const float mean = wsum(s) * (1.f / 1024.f);
    float s2 = 0.f;
#pragma unroll
    for (int j = 0; j < 4; ++j) { v[j].x -= mean; v[j].y -= mean; v[j].z -= mean; v[j].w -= mean; s2 += (v[j].x * v[j].x + v[j].y * v[j].y) + (v[j].z * v[j].z + v[j].w * v[j].w); }
    const float rstd = rsqrtf(wsum(s2) * (1.f / 1024.f) + eps);
#pragma unroll
    for (int j = 0; j < 4; ++j) { v[j].x *= rstd; v[j].y *= rstd; v[j].z *= rstd; v[j].w *= rstd; }
}
struct PVec { float4 v[4]; };
__device__ __forceinline__ void ld_pvec(const float* p, int lane, PVec& o) {
#pragma unroll
    for (int j = 0; j < 4; ++j) o.v[j] = ((const float4*)p)[lane + 64 * j];
}
__device__ __forceinline__ void modulate(float4 (&v)[4], const PVec& sc, const PVec& sh) {
#pragma unroll
    for (int j = 0; j < 4; ++j) { const float4 a = sc.v[j], b = sh.v[j];
        v[j].x = v[j].x * (1.f + a.x) + b.x; v[j].y = v[j].y * (1.f + a.y) + b.y; v[j].z = v[j].z * (1.f + a.z) + b.z; v[j].w = v[j].w * (1.f + a.w) + b.w; }
}
__device__ __forceinline__ void resid_ln(float4 (&x)[4], const float4 (&o)[4], const PVec& g, const PVec& gamma, const PVec& beta) {
#pragma unroll
    for (int j = 0; j < 4; ++j) { const float4 a = g.v[j];
        x[j].x = ALPHA * x[j].x + a.x * o[j].x; x[j].y = ALPHA * x[j].y + a.y * o[j].y; x[j].z = ALPHA * x[j].z + a.z * o[j].z; x[j].w = ALPHA * x[j].w + a.w * o[j].w; }
    ln_inplace(x, 1e-5f);
#pragma unroll
    for (int j = 0; j < 4; ++j) { const float4 a = gamma.v[j], b = beta.v[j];
        x[j].x = x[j].x * a.x + b.x; x[j].y = x[j].y * a.y + b.y; x[j].z = x[j].z * a.z + b.z; x[j].w = x[j].w * a.w + b.w; }
}

__device__ __forceinline__ float wmax(float v) {
    v = fmaxf(v, dppf<0xB1>(v)); v = fmaxf(v, dppf<0x4E>(v)); v = fmaxf(v, dppf<0x141>(v)); v = fmaxf(v, dppf<0x140>(v));
    { auto rr = __builtin_amdgcn_permlane16_swap(__float_as_uint(v), __float_as_uint(v), false, false); v = fmaxf(__uint_as_float(rr[0]), __uint_as_float(rr[1])); }
    { auto rr = __builtin_amdgcn_permlane32_swap(__float_as_uint(v), __float_as_uint(v), false, false); v = fmaxf(__uint_as_float(rr[0]), __uint_as_float(rr[1])); }
    return v;
}
__device__ __forceinline__ float xpose_reduce32(const float (&p)[32], int lane) {
    const bool b5 = (lane & 32) != 0, b4 = (lane & 16) != 0, b3 = (lane & 8) != 0, b2 = (lane & 4) != 0, b1 = (lane & 2) != 0;
    float q[16];
#pragma unroll
    for (int e = 0; e < 16; ++e) { const float send = b5 ? p[e] : p[e + 16], keep = b5 ? p[e + 16] : p[e];
        auto rr = __builtin_amdgcn_permlane32_swap(__float_as_uint(send), __float_as_uint(send), false, false);
        q[e] = keep + (b5 ? __uint_as_float(rr[0]) : __uint_as_float(rr[1])); }
    float r8[8];
#pragma unroll
    for (int e = 0; e < 8; ++e) { const float send = b4 ? q[e] : q[e + 8], keep = b4 ? q[e + 8] : q[e];
        auto rr = __builtin_amdgcn_permlane16_swap(__float_as_uint(send), __float_as_uint(send), false, false);
        r8[e] = keep + (b4 ? __uint_as_float(rr[0]) : __uint_as_float(rr[1])); }
    float r4[4];
#pragma unroll
    for (int e = 0; e < 4; ++e) { const float send = b3 ? r8[e] : r8[e + 4], keep = b3 ? r8[e + 4] : r8[e]; r4[e] = keep + dppf<0x128>(send); }
    float r2[2];
#pragma unroll
    for (int e = 0; e < 2; ++e) { const float send = b2 ? r4[e] : r4[e + 2], keep = b2 ? r4[e + 2] : r4[e]; r2[e] = keep + __shfl_xor(send, 4); }
    float r1;
    { const float send = b1 ? r2[0] : r2[1], keep = b1 ? r2[1] : r2[0]; r1 = keep + dppf<0x4E>(send); }
    r1 += dppf<0xB1>(r1);
    return r1;
}
__device__ __forceinline__ void top4_gates(float lg, int lane, int (&ei)[4], float (&gv)[4]) {
    float tv[4];
#pragma unroll
    for (int k = 0; k < 4; ++k) { const float m = wmax(lg); const unsigned long long bal = __ballot(lg == m); const int e = (__builtin_ctzll(bal) >> 1) & 31;
        ei[k] = e; tv[k] = m; lg = (((lane >> 1) & 31) == e) ? -3.0e38f : lg; }
    float s = 0.f;
#pragma unroll
    for (int k = 0; k < 4; ++k) { gv[k] = expf(tv[k] - tv[0]); s += gv[k]; }
    const float inv = 1.f / s;
#pragma unroll
    for (int k = 0; k < 4; ++k) gv[k] *= inv;
}
__device__ __forceinline__ void route_rows2(const float4 (&h0)[4], const float4 (&h1)[4], const float* wl, const float* __restrict__ br, int lane, int (&ei0)[4], float (&gv0)[4], int (&ei1)[4], float (&gv1)[4]) {
    float p0[32], p1[32];
#pragma unroll
    for (int e = 0; e < 32; ++e) { const float4* w = (const float4*)(wl + e * 1024); float a0 = 0.f, a1 = 0.f;
#pragma unroll
        for (int j = 0; j < 4; ++j) { const float4 ww = w[lane + 64 * j];
            a0 += (h0[j].x * ww.x + h0[j].y * ww.y) + (h0[j].z * ww.z + h0[j].w * ww.w);
            a1 += (h1[j].x * ww.x + h1[j].y * ww.y) + (h1[j].z * ww.z + h1[j].w * ww.w); }
        p0[e] = a0; p1[e] = a1; }
    const float bias = br[(lane >> 1) & 31];
    const float l0 = xpose_reduce32(p0, lane) + bias, l1 = xpose_reduce32(p1, lane) + bias;
    top4_gates(l0, lane, ei0, gv0); top4_gates(l1, lane, ei1, gv1);
}

struct RowArgs {
    const float* xin;
    const float* o;
    float* xout;
    bf16* h;
    const float* mod;
    const float* mod_next;
    const float* gamma; const float* beta;
    const float* wr; const float* br;
    int* topi; int* tpos; float* gate; int* list; unsigned* cnt;
    const bf16* y; const unsigned* cntc;
    unsigned char* h8;
    const bf16* xin_bf; bf16* xout_bf; const bf16* o_bf;
    int final_; int pad;
};

constexpr int RP_LDS_W = 32 * 1024 * 4;
constexpr int RP_LDS_BYTES = RP_LDS_W + 2048 + 512;

__device__ __forceinline__ void rp_a_chunk(const RowArgs& a, int chunk, int wave, int lane) {
    const int b = (chunk * 64) >> 12; PVec sc, sh; ld_pvec(a.mod + b * 6144 + 1024, lane, sc); ld_pvec(a.mod + b * 6144, lane, sh);
    for (int i0 = wave; i0 < 64; i0 += 16) {
        float4 v[2][4];
#pragma unroll
        for (int u = 0; u < 2; ++u) ld_row(a.xin + (size_t)(chunk * 64 + i0 + 8 * u) * DM, lane, v[u]);
#pragma unroll
        for (int u = 0; u < 2; ++u) { ln_inplace(v[u], 1e-6f); modulate(v[u], sc, sh); st_row_bf(a.h + (size_t)(chunk * 64 + i0 + 8 * u) * DM, lane, v[u]); } }
}
__device__ __forceinline__ void rp_b_chunk(const RowArgs& a, int chunk, int wave, int lane, char* lds) {
    const float* wl = (const float*)lds;
    int* se = (int*)(lds + RP_LDS_W); int* sp = se + 256; int* lcnt = sp + 256; int* base = lcnt + 32;
    const int tid = wave * 64 + lane;
    if (tid < 32) lcnt[tid] = 0;
    __syncthreads();
    const float* mb = a.mod + ((chunk * 64) >> 12) * 6144;
    float4 xrf[2][4]; uint2 xrb[2][4], orb[2][4]; float4 orf[2][4];
#define RPB_LOADX(ii) do { _Pragma("unroll") for (int u = 0; u < 2; ++u) { const size_t ro_ = (size_t)(chunk * 64 + (ii) + 8 * u) * DM; \
        if (a.xin_bf) { _Pragma("unroll") for (int j = 0; j < 4; ++j) xrb[u][j] = ((const uint2*)(a.xin_bf + ro_))[lane + 64 * j]; } \
        else { _Pragma("unroll") for (int j = 0; j < 4; ++j) xrf[u][j] = ((const float4*)(a.xin + ro_))[lane + 64 * j]; } } } while (0)
#define RPB_LOADO(ii) do { _Pragma("unroll") for (int u = 0; u < 2; ++u) { const size_t ro_ = (size_t)(chunk * 64 + (ii) + 8 * u) * DM; \
        if (a.o_bf) { _Pragma("unroll") for (int j = 0; j < 4; ++j) orb[u][j] = ((const uint2*)(a.o_bf + ro_))[lane + 64 * j]; } \
        else { _Pragma("unroll") for (int j = 0; j < 4; ++j) orf[u][j] = ((const float4*)(a.o + ro_))[lane + 64 * j]; } } } while (0)
#define RPB_LOADRAW(ii) do { RPB_LOADX(ii); if (a.xin_bf) RPB_LOADO(ii); } while (0)
    RPB_LOADRAW(wave);
    for (int i0 = wave; i0 < 64; i0 += 16) {
        float4 x[2][4], o[2][4];
        if (!a.xin_bf) RPB_LOADO(i0);
#pragma unroll
        for (int u = 0; u < 2; ++u)
#pragma unroll
            for (int j = 0; j < 4; ++j) {
                if (a.xin_bf) { const uint2 w = xrb[u][j]; x[u][j] = make_float4(__uint_as_float(w.x << 16), __uint_as_float(w.x & 0xffff0000u), __uint_as_float(w.y << 16), __uint_as_float(w.y & 0xffff0000u)); } else x[u][j] = xrf[u][j];
                if (a.o_bf) { const uint2 w = orb[u][j]; o[u][j] = make_float4(__uint_as_float(w.x << 16), __uint_as_float(w.x & 0xffff0000u), __uint_as_float(w.y << 16), __uint_as_float(w.y & 0xffff0000u)); } else o[u][j] = orf[u][j]; }
        PVec pg, pgam, pbet, psc, psh; ld_pvec(mb + 2048, lane, pg); ld_pvec(a.gamma, lane, pgam); ld_pvec(a.beta, lane, pbet); ld_pvec(mb + 4096, lane, psc); ld_pvec(mb + 3072, lane, psh);
#pragma unroll
        for (int u = 0; u < 2; ++u) { const int r = chunk * 64 + i0 + 8 * u;
            resid_ln(x[u], o[u], pg, pgam, pbet);
            if (a.xout_bf) st_row_bf(a.xout_bf + (size_t)r * DM, lane, x[u]); else st_row(a.xout + (size_t)r * DM, lane, x[u]);
            ln_inplace(x[u], 1e-6f);
            modulate(x[u], psc, psh);
            if (a.h) st_row_bf(a.h + (size_t)r * DM, lane, x[u]);
            if (a.h8) st_row_fp8(a.h8 + (size_t)r * DM, lane, x[u]); }
        { const int inext = (i0 + 16 < 64) ? i0 + 16 : i0; RPB_LOADRAW(inext); }
        int ei[2][4]; float gv[2][4]; route_rows2(x[0], x[1], wl, a.br, lane, ei[0], gv[0], ei[1], gv[1]);
#pragma unroll
        for (int u = 0; u < 2; ++u) { const int i = i0 + 8 * u, r = chunk * 64 + i;
            if (lane < 4) { const int e = (lane == 0) ? ei[u][0] : (lane == 1) ? ei[u][1] : (lane == 2) ? ei[u][2] : ei[u][3];
                const float g = (lane == 0) ? gv[u][0] : (lane == 1) ? gv[u][1] : (lane == 2) ? gv[u][2] : gv[u][3];
                const int lp = atomicAdd(&lcnt[e], 1);
                se[i * 4 + lane] = e; sp[i * 4 + lane] = lp;
                a.topi[r * 4 + lane] = e; a.gate[r * 4 + lane] = g; } }
    }
#undef RPB_LOADRAW
#undef RPB_LOADX
#undef RPB_LOADO
    __syncthreads();
    if (tid < 32) base[tid] = (int)atomicAdd(&a.cnt[tid], (unsigned)lcnt[tid]);
    __syncthreads();
    if (tid < 256) { const int r = chunk * 64 + (tid >> 2), e = se[tid], pos = base[e] + sp[tid];
        a.tpos[r * 4 + (tid & 3)] = pos; a.list[e * NT + pos] = r; }
    __syncthreads();
}
__device__ __forceinline__ void rp_c_chunk(const RowArgs& a, int chunk, int wave, int lane, const int* poff, bool final_) {
    int myslot = 0; float myg = 0.f;
    if (lane < 32) { const int r = chunk * 64 + wave + 8 * (lane >> 2), k = lane & 3; const int e = a.topi[r * 4 + k]; myslot = poff[e] + a.tpos[r * 4 + k]; myg = a.gate[r * 4 + k]; }
    const float* mb = a.mod + ((chunk * 64) >> 12) * 6144;
    PVec pg, pgam, pbet, psc, psh; ld_pvec(mb + 5120, lane, pg); ld_pvec(a.gamma, lane, pgam); ld_pvec(a.beta, lane, pbet);
    if (!final_) { const float* mn = a.mod_next + ((chunk * 64) >> 12) * 6144; ld_pvec(mn + 1024, lane, psc); ld_pvec(mn, lane, psh); }
    for (int it = 0; it < 8; it += 2) {
        float4 x[2][4]; uint2 yr[2][4][4]; float g[2][4];
#pragma unroll
        for (int u = 0; u < 2; ++u) { const int r = chunk * 64 + wave + 8 * (it + u);
            if (a.xin_bf) ld_row_bf(a.xin_bf + (size_t)r * DM, lane, x[u]); else ld_row(a.xin + (size_t)r * DM, lane, x[u]);
#pragma unroll
            for (int k = 0; k < 4; ++k) { const int slot = __builtin_amdgcn_readlane(myslot, 4 * (it + u) + k); g[u][k] = __int_as_float(__builtin_amdgcn_readlane(__float_as_int(myg), 4 * (it + u) + k));
                const uint2* yp = (const uint2*)(a.y + (size_t)slot * DM);
#pragma unroll
                for (int j = 0; j < 4; ++j) yr[u][k][j] = yp[lane + 64 * j]; } }
#pragma unroll
        for (int u = 0; u < 2; ++u) { const int r = chunk * 64 + wave + 8 * (it + u);
            float4 o[4];
#pragma unroll
            for (int j = 0; j < 4; ++j) { o[j] = make_float4(0.f, 0.f, 0.f, 0.f);
#pragma unroll
                for (int k = 0; k < 4; ++k) { const uint2 w = yr[u][k][j]; const float gg = g[u][k];
                    o[j].x += gg * __uint_as_float(w.x << 16); o[j].y += gg * __uint_as_float(w.x & 0xffff0000u); o[j].z += gg * __uint_as_float(w.y << 16); o[j].w += gg * __uint_as_float(w.y & 0xffff0000u); } }
            resid_ln(x[u], o, pg, pgam, pbet);
            if (a.xout_bf) st_row_bf(a.xout_bf + (size_t)r * DM, lane, x[u]); else st_row(a.xout + (size_t)r * DM, lane, x[u]);
            if (!final_) { ln_inplace(x[u], 1e-6f); modulate(x[u], psc, psh); st_row_bf(a.h + (size_t)r * DM, lane, x[u]); } }
    }
}
__device__ __forceinline__ void compute_poff(const unsigned* cnt, int* poff, int tid) {
    if (tid < 64) { const int v = (tid < 32) ? (((int)cnt[tid] + 255) & ~255) : 0; int x = v;
#pragma unroll
        for (int o = 1; o < 32; o <<= 1) { const int y = __shfl_up(x, o); if (tid >= o) x += y; }
        if (tid < 32) poff[tid] = x - v;
        if (tid == 31) poff[32] = x; }
}
__device__ __forceinline__ void load_wl(const float* wr, char* lds, int tid) {
    float* wl = (float*)lds; float4 v[16];
#pragma unroll
    for (int k = 0; k < 16; ++k) v[k] = ((const float4*)wr)[tid + 512 * k];
#pragma unroll
    for (int k = 0; k < 16; ++k) { const int i4 = tid + 512 * k, c = i4 >> 3, e0 = (i4 & 7) * 4;
        wl[(e0 + 0) * 1024 + c] = v[k].x; wl[(e0 + 1) * 1024 + c] = v[k].y; wl[(e0 + 2) * 1024 + c] = v[k].z; wl[(e0 + 3) * 1024 + c] = v[k].w; }
}

#if HYBRID
__global__ void __launch_bounds__(512) k_rp_a(RowArgs a) {
    const int wave = threadIdx.x >> 6, lane = threadIdx.x & 63;
    for (int ch = blockIdx.x; ch < NT / 64; ch += gridDim.x) rp_a_chunk(a, ch, wave, lane);
}
__global__ void __launch_bounds__(512) k_rp_b(RowArgs a) {
    extern __shared__ __attribute__((aligned(16))) char lds[];
    const int wave = threadIdx.x >> 6, lane = threadIdx.x & 63;
    load_wl(a.wr, lds, threadIdx.x);
    __syncthreads();
    for (int ch = blockIdx.x; ch < NT / 64; ch += gridDim.x) rp_b_chunk(a, ch, wave, lane, lds);
}
__global__ void __launch_bounds__(512) k_rp_c(RowArgs a) {
    __shared__ int poff[36];
    const int wave = threadIdx.x >> 6, lane = threadIdx.x & 63;
    compute_poff(a.cntc, poff, threadIdx.x);
    __syncthreads();
    for (int ch = blockIdx.x; ch < NT / 64; ch += gridDim.x) rp_c_chunk(a, ch, wave, lane, poff, a.final_ != 0);
}

#endif
#if HYBRID
struct EpiF32 { float* C; int ldc; int pad; __device__ void operator()(int r, int c, float v) const { C[(size_t)r * ldc + c] = v; } };
struct EpiBf { bf16* C; int ldc; int pad; __device__ void operator()(int r, int c, float v) const { C[(size_t)r * ldc + c] = f2bf(v); } };
struct EpiP2 { bf16* cq; bf16* ckv; float* kr; bf16* uf;
    __device__ void operator()(int r, int c, float v) const {
        if (c < 256) cq[(size_t)r * 256 + c] = f2bf(v); else if (c < 384) ckv[(size_t)r * 128 + c - 256] = f2bf(v);
        else if (c < 416) kr[(size_t)r * 32 + c - 384] = v; else uf[(size_t)r * 512 + c - 416] = f2bf(v); } };
struct EpiQ { float* tq; const float* rq; __device__ void operator()(int r, int c, float v) const { tq[(size_t)r * 768 + c] = v * rq[r] * 0.10206207261596575f; } };
struct EpiKV { bf16* o; const float* rkv; int hd; int pad;
    __device__ void operator()(int r, int c, float v) const { const int b = r >> 12, s = r & 4095, h = c >> 6, d = c & 63;
        o[(((size_t)(b * NH + h)) * NS + s) * hd + d] = f2bf(v * rkv[r]); } };
struct EpiFnet { bf16* ocat;
    __device__ void operator()(int r, int c, float v) const { const int b = c >> 9, cc = c & 511; ocat[((size_t)(b * NS + r)) * DM + 512 + cc] = f2bf(v); } };

template <typename TA, bool BNT, typename Epi>
__global__ void __launch_bounds__(256) n_gemm(const TA* __restrict__ A, const void* __restrict__ Bp, const float* __restrict__ ascale, Epi epi, int lda, int ldb, int M, int N, int K, int pad_) {
    __shared__ float As[16][68];
    __shared__ float Bs[16][68];
    const int tid = threadIdx.x, tx = tid & 15, ty = tid >> 4, m0 = blockIdx.y * 64, n0 = blockIdx.x * 64;
    float acc[4][4];
#pragma unroll
    for (int i = 0; i < 4; ++i)
#pragma unroll
        for (int j = 0; j < 4; ++j) acc[i][j] = 0.f;
    for (int k0 = 0; k0 < K; k0 += 16) {
        { const int r = tid >> 2, kk = (tid & 3) * 4, gr = m0 + r;
#pragma unroll
          for (int i = 0; i < 4; ++i) { float v = 0.f; if (gr < M) { v = tof(A[(size_t)gr * lda + k0 + kk + i]); if (ascale) v *= ascale[k0 + kk + i]; } As[kk + i][r] = v; } }
        if (!BNT) { const float* B = (const float*)Bp; const int kk = tid >> 4, n = (tid & 15) * 4;
#pragma unroll
          for (int i = 0; i < 4; ++i) Bs[kk][n + i] = (n0 + n + i < N) ? B[(size_t)(k0 + kk) * ldb + n0 + n + i] : 0.f; }
        else { const bf16* B = (const bf16*)Bp; const int n = tid >> 2, kk = (tid & 3) * 4;
#pragma unroll
          for (int i = 0; i < 4; ++i) Bs[kk + i][n] = (n0 + n < N) ? bf2f(B[(size_t)(n0 + n) * ldb + k0 + kk + i]) : 0.f; }
        __syncthreads();
#pragma unroll
        for (int kk = 0; kk < 16; ++kk) { float a[4], b[4];
#pragma unroll
            for (int i = 0; i < 4; ++i) { a[i] = As[kk][ty * 4 + i]; b[i] = Bs[kk][tx * 4 + i]; }
#pragma unroll
            for (int i = 0; i < 4; ++i)
#pragma unroll
                for (int j = 0; j < 4; ++j) acc[i][j] += a[i] * b[j]; }
        __syncthreads();
    }
#pragma unroll
    for (int i = 0; i < 4; ++i)
#pragma unroll
        for (int j = 0; j < 4; ++j) { const int r = m0 + ty * 4 + i, c = n0 + tx * 4 + j; if (r < M && c < N) epi(r, c, acc[i][j]); }
}

__global__ void __launch_bounds__(256) n_moe_up(const bf16* __restrict__ H, const float* __restrict__ wg, const float* __restrict__ bg, const float* __restrict__ wlin, const float* __restrict__ blin,
                                               const int* __restrict__ list, const unsigned* __restrict__ cnt, bf16* __restrict__ aact) {
    __shared__ float As[16][68];
    __shared__ float Bg[16][68];
    __shared__ float Bl[16][68];
    __shared__ int poff[36];
    const int e = blockIdx.z, M = (int)cnt[e], m0 = blockIdx.y * 64, n0 = blockIdx.x * 64;
    if (m0 >= M) return;
    const int tid = threadIdx.x, tx = tid & 15, ty = tid >> 4;
    compute_poff(cnt, poff, tid);
    const float* W1 = wg + (size_t)e * DM * DM; const float* W2 = wlin + (size_t)e * DM * DM;
    float ag[4][4], al[4][4];
#pragma unroll
    for (int i = 0; i < 4; ++i)
#pragma unroll
        for (int j = 0; j < 4; ++j) { ag[i][j] = 0.f; al[i][j] = 0.f; }
    const int r = tid >> 2, gr = m0 + r; const int src = (gr < M) ? list[e * NT + gr] : 0;
    for (int k0 = 0; k0 < DM; k0 += 16) {
        { const int kk = (tid & 3) * 4;
#pragma unroll
          for (int i = 0; i < 4; ++i) As[kk + i][r] = (gr < M) ? bf2f(H[(size_t)src * DM + k0 + kk + i]) : 0.f; }
        { const int kk = tid >> 4, n = (tid & 15) * 4;
#pragma unroll
          for (int i = 0; i < 4; ++i) { Bg[kk][n + i] = W1[(size_t)(k0 + kk) * DM + n0 + n + i]; Bl[kk][n + i] = W2[(size_t)(k0 + kk) * DM + n0 + n + i]; } }
        __syncthreads();
#pragma unroll
        for (int kk = 0; kk < 16; ++kk) { float a[4], b1[4], b2[4];
#pragma unroll
            for (int i = 0; i < 4; ++i) { a[i] = As[kk][ty * 4 + i]; b1[i] = Bg[kk][tx * 4 + i]; b2[i] = Bl[kk][tx * 4 + i]; }
#pragma unroll
            for (int i = 0; i < 4; ++i)
#pragma unroll
                for (int j = 0; j < 4; ++j) { ag[i][j] += a[i] * b1[j]; al[i][j] += a[i] * b2[j]; } }
        __syncthreads();
    }
    const int po = poff[e];
#pragma unroll
    for (int i = 0; i < 4; ++i)
#pragma unroll
        for (int j = 0; j < 4; ++j) { const int rr = m0 + ty * 4 + i, c = n0 + tx * 4 + j;
            if (rr < M) aact[(size_t)(po + rr) * DM + c] = f2bf(swiglu(ag[i][j] + bg[e * DM + c], al[i][j] + blin[e * DM + c])); }
}
__global__ void __launch_bounds__(256) n_moe_down(const bf16* __restrict__ aact, const float* __restrict__ wd, const float* __restrict__ bd, const unsigned* __restrict__ cnt, bf16* __restrict__ Y) {
    __shared__ float As[16][68];
    __shared__ float Bs[16][68];
    __shared__ int poff[36];
    const int e = blockIdx.z, M = (int)cnt[e], m0 = blockIdx.y * 64, n0 = blockIdx.x * 64;
    if (m0 >= M) return;
    const int tid = threadIdx.x, tx = tid & 15, ty = tid >> 4;
    compute_poff(cnt, poff, tid);
    __syncthreads();
    const int po = poff[e];
    const float* W = wd + (size_t)e * DM * DM;
    float acc[4][4];
#pragma unroll
    for (int i = 0; i < 4; ++i)
#pragma unroll
        for (int j = 0; j < 4; ++j) acc[i][j] = 0.f;
    const int r = tid >> 2, gr = m0 + r;
    for (int k0 = 0; k0 < DM; k0 += 16) {
        { const int kk = (tid & 3) * 4;
#pragma unroll
          for (int i = 0; i < 4; ++i) As[kk + i][r] = (gr < M) ? bf2f(aact[(size_t)(po + gr) * DM + k0 + kk + i]) : 0.f; }
        { const int kk = tid >> 4, n = (tid & 15) * 4;
#pragma unroll
          for (int i = 0; i < 4; ++i) Bs[kk][n + i] = W[(size_t)(k0 + kk) * DM + n0 + n + i]; }
        __syncthreads();
#pragma unroll
        for (int kk = 0; kk < 16; ++kk) { float a[4], b[4];
#pragma unroll
            for (int i = 0; i < 4; ++i) { a[i] = As[kk][ty * 4 + i]; b[i] = Bs[kk][tx * 4 + i]; }
#pragma unroll
            for (int i = 0; i < 4; ++i)
#pragma unroll
                for (int j = 0; j < 4; ++j) acc[i][j] += a[i] * b[j]; }
        __syncthreads();
    }
#pragma unroll
    for (int i = 0; i < 4; ++i)
#pragma unroll
        for (int j = 0; j < 4; ++j) { const int rr = m0 + ty * 4 + i, c = n0 + tx * 4 + j;
            if (rr < M) Y[(size_t)(po + rr) * DM + c] = f2bf(acc[i][j] + bd[e * DM + c]); }
}

__global__ void __launch_bounds__(256) n_kpe(const float* __restrict__ kr, const float* __restrict__ rope, bf16* __restrict__ kpe) {
    const int i = blockIdx.x * 256 + threadIdx.x; if (i >= NT * 16) return;
    const int t = i >> 4, j = i & 15; const float c = rope[i], s = rope[NT * 16 + i];
    const float t1 = kr[t * 32 + j], t2 = kr[t * 32 + 16 + j];
    kpe[t * 32 + j] = f2bf(t1 * c - t2 * s); kpe[t * 32 + 16 + j] = f2bf(t2 * c + t1 * s);
}
__global__ void __launch_bounds__(256) n_rms(const bf16* __restrict__ cq, const bf16* __restrict__ ckv, float* __restrict__ rq, float* __restrict__ rkv) {
    const int t = blockIdx.x * 256 + threadIdx.x; if (t >= NT) return;
    float s = 0.f; for (int k = 0; k < 256; ++k) { float v = bf2f(cq[(size_t)t * 256 + k]); s += v * v; }
    rq[t] = rsqrtf(s * (1.f / 256.f) + 1e-6f);
    s = 0.f; for (int k = 0; k < 128; ++k) { float v = bf2f(ckv[(size_t)t * 128 + k]); s += v * v; }
    rkv[t] = rsqrtf(s * (1.f / 128.f) + 1e-6f);
}
__global__ void __launch_bounds__(256) n_qfin(const float* __restrict__ tq, const float* __restrict__ rope, bf16* __restrict__ Q) {
    const int i = blockIdx.x * 256 + threadIdx.x; if (i >= NT * 768) return;
    const int t = i / 768, c = i % 768, h = c / 96, d = c % 96, b = t >> 12, s = t & 4095;
    float v;
    if (d < 64) v = tq[i];
    else { const int j = (d - 64) & 15; const float cs = rope[t * 16 + j], sn = rope[NT * 16 + t * 16 + j];
        const float t1 = tq[(size_t)t * 768 + h * 96 + 64 + j], t2 = tq[(size_t)t * 768 + h * 96 + 80 + j];
        v = (d < 80) ? (t1 * cs - t2 * sn) : (t2 * cs + t1 * sn); }
    Q[(((size_t)(b * NH + h)) * NS + s) * QKD + d] = f2bf(v);
}
__global__ void __launch_bounds__(256) n_kcopy(const bf16* __restrict__ kpe, bf16* __restrict__ K) {
    const int i = blockIdx.x * 256 + threadIdx.x; if (i >= NT * NH * 32) return;
    const int j = i & 31, h = (i >> 5) & 7, t = i >> 8, b = t >> 12, s = t & 4095;
    K[(((size_t)(b * NH + h)) * NS + s) * QKD + 64 + j] = kpe[t * 32 + j];
}
__global__ void __launch_bounds__(256) n_fnet_ch(const bf16* __restrict__ uf, bf16* __restrict__ ucs) {
    const int s = blockIdx.x * 256 + threadIdx.x, j = blockIdx.y, b = blockIdx.z, g = j >> 6, jj = j & 63, t = b * NS + s;
    float uc = 0.f, us = 0.f;
    for (int c = 0; c < 64; ++c) { const float fr = (float)((c * jj) & 63) * (1.f / 64.f); const float u = bf2f(uf[(size_t)t * 512 + g * 64 + c]);
        uc += u * __builtin_amdgcn_cosf(fr); us += u * __builtin_amdgcn_sinf(fr); }
    ucs[((size_t)(b * 512 + j)) * 8192 + s] = f2bf(uc); ucs[((size_t)(b * 512 + j)) * 8192 + 4096 + s] = f2bf(us);
}
__global__ void __launch_bounds__(256) n_attn(const bf16* __restrict__ Q, const bf16* __restrict__ K, const bf16* __restrict__ V, bf16* __restrict__ ocat) {
    __shared__ float Ks[32][96];
    __shared__ float Vs[32][64];
    const int tid = threadIdx.x, b = blockIdx.z, h = blockIdx.y, s = blockIdx.x * 256 + tid;
    const size_t bh = (size_t)(b * NH + h) * NS;
    float q[96], o[64];
#pragma unroll
    for (int d = 0; d < 96; ++d) q[d] = bf2f(Q[(bh + s) * QKD + d]);
#pragma unroll
    for (int d = 0; d < 64; ++d) o[d] = 0.f;
    float m = -1e30f, l = 0.f;
    for (int kt = 0; kt < NS / 32; ++kt) {
        __syncthreads();
        for (int i = tid; i < 32 * 96; i += 256) Ks[i / 96][i % 96] = bf2f(K[(bh + kt * 32) * QKD + i]);
        for (int i = tid; i < 32 * 64; i += 256) Vs[i >> 6][i & 63] = bf2f(V[(bh + kt * 32) * VH + i]);
        __syncthreads();
        for (int j = 0; j < 32; ++j) {
            float sc = 0.f;
#pragma unroll
            for (int d = 0; d < 96; ++d) sc += q[d] * Ks[j][d];
            if (sc > m) { const float a = __expf(m - sc); l *= a;
#pragma unroll
                for (int d = 0; d < 64; ++d) o[d] *= a;
                m = sc; }
            const float p = __expf(sc - m); l += p;
#pragma unroll
            for (int d = 0; d < 64; ++d) o[d] += p * Vs[j][d];
        }
    }
    const float inv = 1.f / l;
#pragma unroll
    for (int d = 0; d < 64; ++d) ocat[((size_t)(b * NS + s)) * DM + h * 64 + d] = f2bf(o[d] * inv);
}
__global__ void __launch_bounds__(256) n_conv(const bf16* __restrict__ pc, const float* __restrict__ cw, bf16* __restrict__ yc) {
    const int i = blockIdx.x * 256 + threadIdx.x; if (i >= NT * DM) return;
    const int t = i >> 10, c = i & 1023, s = t & 4095;
    const bf16* row = pc + (size_t)t * 3072;
    const float u1 = bf2f(row[1024 + c]) * bf2f(row[2048 + c]);
    const float u0 = (s > 0) ? bf2f(row[1024 + c - 3072]) * bf2f(row[2048 + c - 3072]) : 0.f;
    const float u2 = (s < NS - 1) ? bf2f(row[1024 + c + 3072]) * bf2f(row[2048 + c + 3072]) : 0.f;
    const float y = u0 * cw[c] + u1 * cw[1024 + c] + u2 * cw[2048 + c];
    yc[i] = f2bf(bf2f(row[c]) * y);
}

#endif
#define GAS __attribute__((address_space(1)))
#define LAS __attribute__((address_space(3)))
typedef unsigned v4u __attribute__((ext_vector_type(4)));
typedef unsigned v2u __attribute__((ext_vector_type(2)));
typedef float f32x4 __attribute__((ext_vector_type(4)));
typedef float f32x2 __attribute__((ext_vector_type(2)));
typedef short bf16x8 __attribute__((ext_vector_type(8)));
typedef short bf16x16 __attribute__((ext_vector_type(16)));
typedef float f32x16 __attribute__((ext_vector_type(16)));
typedef short s16x4 __attribute__((ext_vector_type(4)));
typedef GAS unsigned gu32;
#define RLX_AGENT __ATOMIC_RELAXED, __HIP_MEMORY_SCOPE_AGENT
#define LDS_WAIT() asm volatile("s_waitcnt lgkmcnt(0)" ::: "memory")
#define VM_WAIT() asm volatile("s_waitcnt vmcnt(0)" ::: "memory")

constexpr int NWAVES = 8;
constexpr int SCR_BYTES = 151552;
constexpr int MISC_OFF = SCR_BYTES;
constexpr int LDS_BYTES = 155648;

constexpr size_t WS_WIN = 528 * MiB, WS_WUQ = 530 * MiB, WS_WUKV = 531 * MiB, WS_WOUT0 = 532 * MiB, WS_WCIN = 534 * MiB, WS_WCOUT = 540 * MiB, WS_CST = 542 * MiB;
constexpr size_t WS_WUP = 544 * MiB, WS_WDN = 800 * MiB, WS_H8 = 928 * MiB, WS_END2 = 944 * MiB;
#ifndef MOE_FP8
#define MOE_FP8 1
#endif
typedef int v8i __attribute__((ext_vector_type(8)));
typedef int v4i __attribute__((ext_vector_type(4)));
constexpr int CW_BAR = 4096;

__device__ __forceinline__ unsigned pk2(float lo, float hi) { return (unsigned)f2bf(lo) | ((unsigned)f2bf(hi) << 16); }
typedef __bf16 bf16x2_t __attribute__((ext_vector_type(2)));
__device__ __forceinline__ unsigned cvt_pk_bf16(float lo, float hi) { f32x2 v = {lo, hi}; bf16x2_t b = __builtin_convertvector(v, bf16x2_t); return __builtin_bit_cast(unsigned, b); }

#define XB_TMO      128
#define XB_XCNT(j)  (256  + 64 * (j))
#define XB_XSUB(j)  (1280 + 64 * (j))
#define XB_XGEN(j)  (2304 + 64 * (j))
#define XB_TOP      3328
#define XB_TOPGEN   3392
#define XCD_BAR_WORDS 3456
#define XB_SPIN_CAP (1u << 20)
__device__ __forceinline__ unsigned xb_ld(unsigned* p)              { return __hip_atomic_load(p, __ATOMIC_RELAXED, __HIP_MEMORY_SCOPE_AGENT); }
__device__ __forceinline__ unsigned xb_add(unsigned* p, unsigned v) { return __hip_atomic_fetch_add(p, v, __ATOMIC_RELAXED, __HIP_MEMORY_SCOPE_AGENT); }
__device__ __forceinline__ unsigned xb_xcc_id() { return (unsigned)__builtin_amdgcn_s_getreg((3 << 11) | 20) & 0xFu; }
#define XB_SPIN(cond, bar) do { unsigned _sp = 0; while (cond) { __builtin_amdgcn_s_sleep(1); \
    if ((++_sp & 255u) == 0u) { if (xb_ld(&(bar)[XB_TMO])) break; if (_sp > XB_SPIN_CAP) { atomicAdd(&(bar)[XB_TMO], 1u); break; } } } } while (0)
struct XcdBarrier { unsigned* bar; unsigned x; volatile LAS unsigned* st; };
__device__ __forceinline__ XcdBarrier xcd_barrier_post(unsigned* bar, volatile LAS unsigned* st) {
    XcdBarrier b; b.bar = bar; b.x = xb_xcc_id(); b.st = st;
    if (threadIdx.x == 0) (void)xb_add(&bar[XB_XCNT(b.x)], 1u);
    return b;
}
__device__ __forceinline__ void xcd_barrier_complete(unsigned* bar, unsigned x, unsigned& nloc, unsigned& nx) {
    const unsigned G = gridDim.x * gridDim.y * gridDim.z;
    unsigned sum, cnt, mine, sp = 0u;
    for (;;) {
        sum = 0u; cnt = 0u; mine = 0u;
#pragma unroll
        for (unsigned j = 0; j < 16; ++j) { const unsigned c = xb_ld(&bar[XB_XCNT(j)]); sum += c; cnt += (c > 0u) ? 1u : 0u; mine = (j == x) ? c : mine; }
        if (sum == G) break;
        __builtin_amdgcn_s_sleep(1);
        if ((++sp & 255u) == 0u) { if (xb_ld(&bar[XB_TMO])) break; if (sp > XB_SPIN_CAP) { atomicAdd(&bar[XB_TMO], 1u); break; } }
    }
    nloc = mine > 0u ? mine : 1u; nx = cnt > 0u ? cnt : 1u;
}
__device__ __forceinline__ void xcd_barrier(const XcdBarrier& b) {
    asm volatile("s_waitcnt vmcnt(0)" ::: "memory");
    __syncthreads();
    if (threadIdx.x == 0) {
        unsigned* bar = b.bar;
        __builtin_amdgcn_s_waitcnt(0);
        unsigned nloc = b.st[0], nx = b.st[1];
        if (nloc == 0u) { xcd_barrier_complete(bar, b.x, nloc, nx); b.st[0] = nloc; b.st[1] = nx; }
        const unsigned old = xb_add(&bar[XB_XSUB(b.x)], 1u);
        const unsigned gen = old / nloc;
        if (old + 1u == (gen + 1u) * nloc) {
            __builtin_amdgcn_fence(__ATOMIC_RELEASE, "agent");
            asm volatile("s_waitcnt vmcnt(0)" ::: "memory");
            const unsigned og = xb_add(&bar[XB_TOP], 1u);
            const unsigned tg = og / nx;
            if (og + 1u == (tg + 1u) * nx) xb_add(&bar[XB_TOPGEN], 1u);
            else XB_SPIN(xb_ld(&bar[XB_TOPGEN]) == tg, bar);
            __builtin_amdgcn_fence(__ATOMIC_ACQUIRE, "agent");
            xb_add(&bar[XB_XGEN(b.x)], 1u);
            asm volatile("s_waitcnt vmcnt(0)" ::: "memory");
        } else {
            XB_SPIN(xb_ld(&bar[XB_XGEN(b.x)]) == gen, bar);
            __builtin_amdgcn_fence(__ATOMIC_ACQUIRE, "agent");
            asm volatile("s_waitcnt vmcnt(0)" ::: "memory");
        }
    }
    __syncthreads();
}

namespace pg8 {
constexpr int BM = 256, BK = 64, HALF = 128, HTB = HALF * BK * 2, STAGE_BYTES = 8 * HTB, NXCD = 8, WGM = 8;
__host__ __device__ __forceinline__ int lds_byte(int r, int c) { const int st = (r >> 4) * 2 + (c >> 5), rr = r & 15, cc = c & 31, ob = rr * 64 + cc * 2; return st * 1024 + (ob ^ (((ob >> 9) & 1) << 5)); }
__host__ __device__ __forceinline__ void stage_rc(int b, int& R, int& C) { const int st = b / 1024, sb = b % 1024, swz = sb ^ (((sb >> 9) & 1) << 5); R = (st >> 1) * 16 + swz / 64; C = (st & 1) * 32 + (swz % 64) / 2; }
__host__ __device__ __forceinline__ int perm32(int rho) { const int n = rho >> 4, i = rho & 15; return 8 * (i >> 2) + 4 * n + (i & 3); }

struct Unit { int pm, pn, e, nvalid, local, halfm, roff, rbase; };

struct DenseSched {
    const char* A; const char* B; int K; int nM, nN, nwg, G, c;
    __device__ void init(const void* A_, const void* B_, int M, int N, int K_, int G_, int c_) { A = (const char*)A_; B = (const char*)B_; K = K_; nM = M / BM; nN = N / BM; nwg = nM * nN; G = G_; c = c_; }
    __device__ bool next(int i, Unit& u) const {
        const long L = (long)i * G + c; if (L >= nwg) return false;
        int wgid = (int)L; { const int q = nwg / NXCD, r = nwg % NXCD, xcd = wgid % NXCD, off = wgid / NXCD; wgid = (xcd < r ? xcd * (q + 1) : r * (q + 1) + (xcd - r) * q) + off; }
        const int nig = WGM * nN, gid = wgid / nig, fm = gid * WGM, gsz = (nM - fm) < WGM ? (nM - fm) : WGM;
        u.pm = fm + ((wgid % nig) % gsz); u.pn = (wgid % nig) / gsz; u.e = 0; u.nvalid = 256; u.local = 0; u.halfm = 0; u.roff = 0; u.rbase = u.pm * BM; return true;
    }
    __device__ __forceinline__ const char* aptr(const Unit& u) const { return A + (size_t)u.pm * BM * K * 2; }
    __device__ __forceinline__ const char* bptr(const Unit& u) const { return B + (size_t)u.pn * BM * K * 2; }
    __device__ __forceinline__ const int* rows(const Unit&) const { return nullptr; }
};
struct ListSched {
    const char* A; const char* B; int K, nN, first, count, halfm;
    __device__ bool next(int i, Unit& u) const {
        if (i >= count) return false; const int idx = first + i;
        u.pm = idx / nN; u.pn = idx % nN; u.e = 0; u.nvalid = 256; u.local = 0; u.halfm = halfm; u.roff = 0; u.rbase = u.pm * (halfm ? HALF : BM); return true;
    }
    __device__ __forceinline__ const char* aptr(const Unit& u) const { return A + (size_t)u.pm * (halfm ? HALF : BM) * K * 2; }
    __device__ __forceinline__ const char* bptr(const Unit& u) const { return B + (size_t)u.pn * BM * K * 2; }
    __device__ __forceinline__ const int* rows(const Unit&) const { return nullptr; }
};
struct MoeSched {
    const LAS int* poff; const char* A; const char* B; const int* list; const unsigned* cnt; int npn, G, vcu; size_t bexp; bool gather; int rb;
    __device__ bool next(int i, Unit& u) const {
        const int MT = __builtin_amdgcn_readfirstlane(poff[32]) >> 8, total = MT * npn, nfull = (total / G) * G;
        int L = i * G + vcu, half = 0, hm = 0;
        if (L >= nfull) {
            const int hidx = L - nfull; if (hidx >= 2 * (total - nfull)) return false;
            L = nfull + (hidx >> 1); half = hidx & 1; hm = 1; }
        const int pm = L / npn, pn = L % npn, row0 = pm << 8;
        int e = 0;
        for (int j = 1; j < 32; ++j) e = (poff[j] <= row0) ? j : e;
        e = __builtin_amdgcn_readfirstlane(e);
        u.pm = pm; u.pn = pn; u.e = e; u.halfm = hm; u.roff = half * HALF; u.rbase = row0 + half * HALF;
        const int local = row0 - __builtin_amdgcn_readfirstlane(poff[e]), left = __builtin_amdgcn_readfirstlane((int)cnt[e]) - local;
        u.nvalid = left < 256 ? left : 256; u.local = local;
        return true;
    }
    __device__ __forceinline__ const char* aptr(const Unit& u) const { return gather ? A : A + (size_t)u.rbase * rb; }
    __device__ __forceinline__ const char* bptr(const Unit& u) const { return B + (size_t)u.e * bexp + (size_t)u.pn * BM * rb; }
    __device__ __forceinline__ const int* rows(const Unit& u) const { return list + (size_t)u.e * NT + u.local; }
};

template <class Epi, class Sched, bool GATHER, bool ALIGN_EPI, bool F8 = false>
__device__ __forceinline__ void gemm_phase(LAS unsigned char* lds, const int RB  , const Sched& S, const Epi& E) {
    int tid = threadIdx.x; asm volatile("" : "+v"(tid));
    const int wid = __builtin_amdgcn_readfirstlane(tid >> 6), lane = tid & 63, wr = wid >> 2, wc = wid & 3, fr = lane & 15, fq = lane >> 4;
    const int nt = RB / (BK * 2);
    LAS v2u* tbl = (LAS v2u*)(lds + STAGE_BYTES) + tid;
    { v2u ob;
#pragma unroll
      for (int i = 0; i < 2; ++i) { int R, C; stage_rc(tid * 16 + i * 8192, R, C); const int Rb = Epi::PERM ? ((R & ~31) + perm32(R & 31)) : R; ob[i] = (unsigned)(Rb * RB + C * 2); }
      tbl[0] = ob; }
    const size_t kstep = (size_t)(BK * 2);
    const size_t hstepB = (size_t)HALF * RB;
    const unsigned ldsw = (unsigned)wid * 1024u;
    const int aoff = lds_byte(wr * 64 + fr, fq * 8), boff = lds_byte(wc * 32 + fr, fq * 8);
#define PG8_SA(b, h) (((b) * 2 + (h)) * HTB)
#define PG8_SB(b, h) ((4 + (b) * 2 + (h)) * HTB)
#define PG8_STAGE_T(bufoff, gbase, k) do { const v2u _o = tbl[(k) * 512]; \
        __builtin_amdgcn_global_load_lds((const unsigned*)((const char*)(gbase) + _o.x), (LAS unsigned*)(lds + (bufoff) + ldsw), 16, 0, 0); \
        __builtin_amdgcn_global_load_lds((const unsigned*)((const char*)(gbase) + _o.y), (LAS unsigned*)(lds + (bufoff) + ldsw + 8192), 16, 0, 0); } while (0)
#define PG8_STAGE_A(bufoff, gbase, k) PG8_STAGE_T(bufoff, gbase, k)
#define PG8_STAGE_B(bufoff, gbase) PG8_STAGE_T(bufoff, gbase, 0)
#define PG8_SETV(kb, u) do { int _t = tid; asm volatile("" : "+v"(_t));   _Pragma("unroll") for (int _h = 0; _h < 2; ++_h) { v2u _o; _Pragma("unroll") for (int _i = 0; _i < 2; ++_i) { int _R, _C; stage_rc(_t * 16 + _i * 8192, _R, _C); const int _r = _R + 128 * _h; \
        if constexpr (GATHER) { const int _rq = _r + (u).roff, _rr = _rq < (u).nvalid ? _rq : (u).nvalid - 1; _o[_i] = (unsigned)S.rows(u)[_rr] * (unsigned)RB + (unsigned)_C * 2u; } \
        else _o[_i] = (unsigned)(_r * RB) + (unsigned)_C * 2u; } tbl[((kb) + _h) * 512] = _o; } } while (0)
#define PG8_LDA(dst, b, h) do { _Pragma("unroll") for (int m = 0; m < 4; ++m) _Pragma("unroll") for (int k = 0; k < 2; ++k) dst[m][k] = *(const LAS v4i*)(lds + PG8_SA(b, h) + aoff + m * 2048 + k * 1024); } while (0)
#define PG8_LDB(dst, b, h) do { _Pragma("unroll") for (int n = 0; n < 2; ++n) _Pragma("unroll") for (int k = 0; k < 2; ++k) dst[n][k] = *(const LAS v4i*)(lds + PG8_SB(b, h) + boff + n * 2048 + k * 1024); } while (0)
#define PG8_CAT(x) __builtin_shufflevector(x[0], x[1], 0, 1, 2, 3, 4, 5, 6, 7)
#define PG8_MMA(ai, bj, At, Bt) do { __builtin_amdgcn_s_setprio(1); _Pragma("unroll") for (int m = 0; m < 4; ++m) _Pragma("unroll") for (int n = 0; n < 2; ++n) { \
        if constexpr (F8) acc[ai][bj][m][n] = __builtin_amdgcn_mfma_scale_f32_16x16x128_f8f6f4(PG8_CAT(Bt[n]), PG8_CAT(At[m]), acc[ai][bj][m][n], 0, 0, 0, 0, 0, 0);   \
        else { _Pragma("unroll") for (int k = 0; k < 2; ++k) acc[ai][bj][m][n] = __builtin_amdgcn_mfma_f32_16x16x32_bf16(__builtin_bit_cast(bf16x8, Bt[n][k]), __builtin_bit_cast(bf16x8, At[m][k]), acc[ai][bj][m][n], 0, 0, 0); } } \
        __builtin_amdgcn_s_setprio(0); } while (0)
#define PG8_WAIT_V(n) asm volatile("s_waitcnt vmcnt(" #n ")" ::: "memory")
#define PG8_WAIT_L(n) asm volatile("s_waitcnt lgkmcnt(" #n ")" ::: "memory")
#define PG8_BAR __builtin_amdgcn_s_barrier()
#define PG8_SCHED __builtin_amdgcn_sched_barrier(0)
    Unit cur, nxt; int ui = 0;
    if (!S.next(0, cur)) return;
    f32x4 acc[2][2][4][2];
#pragma unroll
    for (int a = 0; a < 2; ++a)
#pragma unroll
        for (int b = 0; b < 2; ++b)
#pragma unroll
            for (int m = 0; m < 4; ++m)
#pragma unroll
                for (int n = 0; n < 2; ++n) acc[a][b][m][n] = (f32x4){0.f, 0.f, 0.f, 0.f};
    v4i At[4][2], B0[2][2], B1[2][2];
    const char* cA = S.aptr(cur); const char* cB = S.bptr(cur);
    PG8_SETV(1, cur);
    PG8_STAGE_B(PG8_SB(0, 0), cB); PG8_STAGE_B(PG8_SB(0, 1), cB + hstepB); PG8_STAGE_A(PG8_SA(0, 0), cA, 1); PG8_STAGE_A(PG8_SA(0, 1), cA, 2);
    if (wr == 1) PG8_BAR;
    PG8_WAIT_V(2); PG8_BAR;
    PG8_STAGE_B(PG8_SB(1, 0), cB + kstep); PG8_STAGE_A(PG8_SA(1, 0), cA + kstep, 1); PG8_STAGE_B(PG8_SB(1, 1), cB + hstepB + kstep);
    PG8_WAIT_V(6); PG8_BAR;
    for (;;) {
        const bool has_next = S.next(ui + 1, nxt);
        const char* nA = has_next ? S.aptr(nxt) : cA; const char* nB = has_next ? S.bptr(nxt) : cB;
        if (has_next) { PG8_SETV(3, nxt); } else { tbl[3 * 512] = tbl[1 * 512]; tbl[4 * 512] = tbl[2 * 512]; }
#pragma unroll 1
        for (int t = 0; t < nt; t += 2) {
            const bool last = (t == nt - 2);
            const char* a1 = cA + (size_t)(t + 1) * kstep;
            const char* a2 = last ? nA : cA + (size_t)(t + 2) * kstep; const char* b2 = last ? nB : cB + (size_t)(t + 2) * kstep;
            const char* a3 = a2 + kstep; const char* b3 = b2 + kstep;
            const int k2 = last ? 3 : 1;
            PG8_LDB(B0, 0, 0); PG8_LDB(B1, 0, 1); PG8_SCHED; PG8_LDA(At, 0, 0); PG8_STAGE_A(PG8_SA(1, 1), a1, 2);
            PG8_WAIT_V(8); PG8_WAIT_L(0); PG8_BAR; PG8_MMA(0, 0, At, B0); PG8_MMA(0, 1, At, B1); PG8_BAR; PG8_SCHED;
            PG8_LDA(At, 0, 1); PG8_STAGE_B(PG8_SB(0, 0), b2); PG8_STAGE_B(PG8_SB(0, 1), b2 + hstepB); PG8_STAGE_A(PG8_SA(0, 0), a2, k2);
            PG8_WAIT_V(8); PG8_WAIT_L(0); PG8_BAR; if (!cur.halfm) { PG8_MMA(1, 0, At, B0); PG8_MMA(1, 1, At, B1); } PG8_BAR; PG8_SCHED;
            PG8_LDB(B0, 1, 0); PG8_LDB(B1, 1, 1); PG8_SCHED; PG8_LDA(At, 1, 0); PG8_STAGE_A(PG8_SA(0, 1), a2, k2 + 1);
            PG8_WAIT_V(8); PG8_WAIT_L(0); PG8_BAR; PG8_MMA(0, 0, At, B0); PG8_MMA(0, 1, At, B1); PG8_BAR; PG8_SCHED;
            PG8_LDA(At, 1, 1); PG8_STAGE_B(PG8_SB(1, 0), b3); PG8_STAGE_B(PG8_SB(1, 1), b3 + hstepB); PG8_STAGE_A(PG8_SA(1, 0), a3, k2);
            PG8_WAIT_V(8); PG8_WAIT_L(0); PG8_BAR; if (!cur.halfm) { PG8_MMA(1, 0, At, B0); PG8_MMA(1, 1, At, B1); } PG8_BAR; PG8_SCHED;
        }
        if constexpr (ALIGN_EPI) { if (wr == 0) PG8_BAR; }
        { int te = threadIdx.x; asm volatile("" : "+v"(te));
          E(acc, cur, wr, wc, te & 15, (te & 63) >> 4); }
        if (!has_next) break;
#pragma unroll
        for (int a = 0; a < 2; ++a)
#pragma unroll
            for (int b = 0; b < 2; ++b)
#pragma unroll
                for (int m = 0; m < 4; ++m)
#pragma unroll
                    for (int n = 0; n < 2; ++n) acc[a][b][m][n] = (f32x4){0.f, 0.f, 0.f, 0.f};
        cur = nxt; cA = nA; cB = nB; ++ui;
        tbl[1 * 512] = tbl[3 * 512]; tbl[2 * 512] = tbl[4 * 512];
        if constexpr (ALIGN_EPI) { if (wr == 1) PG8_BAR; }
    }
    PG8_WAIT_V(0);
    if constexpr (!ALIGN_EPI) { if (wr == 0) PG8_BAR; }
    PG8_BAR;
#undef PG8_SA
#undef PG8_SB
#undef PG8_STAGE_T
#undef PG8_STAGE_A
#undef PG8_STAGE_B
#undef PG8_SETV
#undef PG8_LDA
#undef PG8_LDB
#undef PG8_MMA
#undef PG8_CAT
#undef PG8_WAIT_V
#undef PG8_WAIT_L
#undef PG8_BAR
#undef PG8_SCHED
}

typedef const f32x4 (&AccRef)[2][2][4][2];
struct EpiOutF32 {
    static constexpr bool PERM = true; float* O; int ldc; int pad;
    __device__ __forceinline__ void operator()(AccRef acc, const Unit& u, int wr, int wc, int fr, int fq) const {
        const int row0 = u.rbase + wr * 64 + fr, col0 = u.pn * BM + wc * 32 + 8 * fq;
#pragma unroll
        for (int ai = 0; ai < 2; ++ai)
#pragma unroll
            for (int m = 0; m < 4; ++m) { float* rowp = O + (size_t)(row0 + ai * HALF + m * 16) * ldc + col0;
#pragma unroll
                for (int bj = 0; bj < 2; ++bj) { *(f32x4*)(rowp + bj * HALF) = acc[ai][bj][m][0]; *(f32x4*)(rowp + bj * HALF + 4) = acc[ai][bj][m][1]; } }
    }
};
struct EpiOutBf {
    static constexpr bool PERM = true; bf16* O; int ldc; int fnet; float scale;
    __device__ __forceinline__ void operator()(AccRef acc, const Unit& u, int wr, int wc, int fr, int fq) const {
        const int row0 = u.rbase + wr * 64 + fr; bf16* base; int colt;
        if (fnet) { const int b = u.pn >> 1; base = O + (size_t)b * NS * DM + 512; colt = (u.pn & 1) * 256; }
        else { base = O; colt = u.pn * BM; }
        const int col0 = colt + wc * 32 + 8 * fq;
#pragma unroll
        for (int ai = 0; ai < 2; ++ai) { if (ai == 1 && u.halfm) break;
#pragma unroll
            for (int m = 0; m < 4; ++m) { bf16* rowp = base + (size_t)(row0 + ai * HALF + m * 16) * ldc + col0;
#pragma unroll
                for (int bj = 0; bj < 2; ++bj) { const f32x4 v0 = acc[ai][bj][m][0] * scale, v1 = acc[ai][bj][m][1] * scale;
                    v4u w; w.x = cvt_pk_bf16(v0[0], v0[1]); w.y = cvt_pk_bf16(v0[2], v0[3]); w.z = cvt_pk_bf16(v1[0], v1[1]); w.w = cvt_pk_bf16(v1[2], v1[3]);
                    *(v4u*)(rowp + bj * HALF) = w; } } }
    }
};
struct EpiConv {
    static constexpr bool PERM = true; bf16* gb; bf16* uu;
    __device__ __forceinline__ void operator()(AccRef acc, const Unit& u, int wr, int wc, int fr, int fq) const {
        const int row0 = u.rbase + wr * 64 + fr;
        if (u.pn < 4) { const int col0 = u.pn * BM + wc * 32 + 8 * fq;
#pragma unroll
            for (int ai = 0; ai < 2; ++ai)
#pragma unroll
                for (int m = 0; m < 4; ++m) { bf16* rowp = gb + (size_t)(row0 + ai * HALF + m * 16) * DM + col0;
#pragma unroll
                    for (int bj = 0; bj < 2; ++bj) { const f32x4 v0 = acc[ai][bj][m][0], v1 = acc[ai][bj][m][1];
                        v4u w; w.x = cvt_pk_bf16(v0[0], v0[1]); w.y = cvt_pk_bf16(v0[2], v0[3]); w.z = cvt_pk_bf16(v1[0], v1[1]); w.w = cvt_pk_bf16(v1[2], v1[3]);
                        *(v4u*)(rowp + bj * HALF) = w; } }
        } else { const int col0 = (u.pn - 4) * 128 + wc * 32 + 8 * fq;
#pragma unroll
            for (int ai = 0; ai < 2; ++ai)
#pragma unroll
                for (int m = 0; m < 4; ++m) { const f32x4 v0 = acc[ai][0][m][0] * acc[ai][1][m][0], v1 = acc[ai][0][m][1] * acc[ai][1][m][1];
                    v4u w; w.x = cvt_pk_bf16(v0[0], v0[1]); w.y = cvt_pk_bf16(v0[2], v0[3]); w.z = cvt_pk_bf16(v1[0], v1[1]); w.w = cvt_pk_bf16(v1[2], v1[3]);
                    *(v4u*)(uu + (size_t)(row0 + ai * HALF + m * 16) * DM + col0) = w; }
        }
    }
};
struct EpiG1 {
    static constexpr bool PERM = false; bf16* cq; bf16* ckv; bf16* kpe; bf16* uf; const float* rope;
    __device__ __forceinline__ void operator()(AccRef acc, const Unit& u, int wr, int wc, int fr, int fq) const {
        const int row0 = u.rbase + wr * 64 + fr;
#pragma unroll
        for (int ai = 0; ai < 2; ++ai)
#pragma unroll
            for (int m = 0; m < 4; ++m) { const int row = row0 + ai * HALF + m * 16;
#pragma unroll
                for (int bj = 0; bj < 2; ++bj) {
                    if (u.pn == 1 && bj == 1) {
                        if (wc == 0) { const f32x4 t1 = acc[ai][1][m][0], t2 = acc[ai][1][m][1];
                            const f32x4 cs = *(const f32x4*)(rope + (size_t)row * 16 + 4 * fq), sn = *(const f32x4*)(rope + (size_t)NT * 16 + (size_t)row * 16 + 4 * fq);
                            v2u w1, w2; w1.x = cvt_pk_bf16(t1[0] * cs[0] - t2[0] * sn[0], t1[1] * cs[1] - t2[1] * sn[1]); w1.y = cvt_pk_bf16(t1[2] * cs[2] - t2[2] * sn[2], t1[3] * cs[3] - t2[3] * sn[3]);
                            w2.x = cvt_pk_bf16(t2[0] * cs[0] + t1[0] * sn[0], t2[1] * cs[1] + t1[1] * sn[1]); w2.y = cvt_pk_bf16(t2[2] * cs[2] + t1[2] * sn[2], t2[3] * cs[3] + t1[3] * sn[3]);
                            *(v2u*)(kpe + (size_t)row * 32 + 4 * fq) = w1; *(v2u*)(kpe + (size_t)row * 32 + 16 + 4 * fq) = w2; }
                    } else {
#pragma unroll
                        for (int n = 0; n < 2; ++n) { const f32x4 v = acc[ai][bj][m][n]; v2u w; w.x = cvt_pk_bf16(v[0], v[1]); w.y = cvt_pk_bf16(v[2], v[3]);
                            const int ct = bj * HALF + wc * 32 + 16 * n + 4 * fq;
                            bf16* p;
                            if (u.pn == 0) p = cq + (size_t)row * 256 + ct;
                            else if (u.pn == 1) p = ckv + (size_t)row * 128 + ct;
                            else p = uf + (size_t)row * 512 + (u.pn - 2) * 256 + ct;
                            *(v2u*)p = w; }
                    } } }
    }
};
struct EpiUp {
    static constexpr bool PERM = true; bf16* aact; const float* bg; const float* bl;
    __device__ __forceinline__ void operator()(AccRef acc, const Unit& u, int wr, int wc, int fr, int fq) const {
        const int row0 = u.rbase + wr * 64 + fr, col0 = u.pn * 128 + wc * 32 + 8 * fq;
        const float* pg = bg + (size_t)u.e * DM + col0; const float* pl = bl + (size_t)u.e * DM + col0;
        const f32x4 g0 = *(const f32x4*)pg, g1 = *(const f32x4*)(pg + 4), l0 = *(const f32x4*)pl, l1 = *(const f32x4*)(pl + 4);
#pragma unroll
        for (int ai = 0; ai < 2; ++ai)
#pragma unroll
            for (int m = 0; m < 4; ++m) { const f32x4 a0 = acc[ai][0][m][0] + g0, a1 = acc[ai][0][m][1] + g1, b0 = acc[ai][1][m][0] + l0, b1 = acc[ai][1][m][1] + l1;
                v4u w; w.x = cvt_pk_bf16(swiglu(a0[0], b0[0]), swiglu(a0[1], b0[1])); w.y = cvt_pk_bf16(swiglu(a0[2], b0[2]), swiglu(a0[3], b0[3]));
                w.z = cvt_pk_bf16(swiglu(a1[0], b1[0]), swiglu(a1[1], b1[1])); w.w = cvt_pk_bf16(swiglu(a1[2], b1[2]), swiglu(a1[3], b1[3]));
                *(v4u*)(aact + (size_t)(row0 + ai * HALF + m * 16) * DM + col0) = w; }
    }
};
struct EpiDown {
    static constexpr bool PERM = true; bf16* y; const float* bd;
    __device__ __forceinline__ void operator()(AccRef acc, const Unit& u, int wr, int wc, int fr, int fq) const {
        const int row0 = u.rbase + wr * 64 + fr, col0 = u.pn * BM + wc * 32 + 8 * fq;
#pragma unroll
        for (int bj = 0; bj < 2; ++bj) { const float* pb = bd + (size_t)u.e * DM + col0 + bj * HALF; const f32x4 c0 = *(const f32x4*)pb, c1 = *(const f32x4*)(pb + 4);
#pragma unroll
            for (int ai = 0; ai < 2; ++ai)
#pragma unroll
                for (int m = 0; m < 4; ++m) { const f32x4 v0 = acc[ai][bj][m][0] + c0, v1 = acc[ai][bj][m][1] + c1;
                    v4u w; w.x = cvt_pk_bf16(v0[0], v0[1]); w.y = cvt_pk_bf16(v0[2], v0[3]); w.z = cvt_pk_bf16(v1[0], v1[1]); w.w = cvt_pk_bf16(v1[2], v1[3]);
                    *(v4u*)(y + (size_t)(row0 + ai * HALF + m * 16) * DM + col0 + bj * HALF) = w; } }
    }
};
struct EpiUp8 {
    static constexpr bool PERM = true; unsigned char* aact; const float* bg; const float* bl;
    __device__ __forceinline__ void operator()(AccRef acc, const Unit& u, int wr, int wc, int fr, int fq) const {
        const int row0 = u.rbase + wr * 64 + fr, col0 = u.pn * 128 + wc * 32 + 8 * fq;
        const float* pg = bg + (size_t)u.e * DM + col0; const float* pl = bl + (size_t)u.e * DM + col0;
        const f32x4 g0 = *(const f32x4*)pg, g1 = *(const f32x4*)(pg + 4), l0 = *(const f32x4*)pl, l1 = *(const f32x4*)(pl + 4);
        constexpr float S = 1.f / 32.f;
#pragma unroll
        for (int ai = 0; ai < 2; ++ai) { if (ai == 1 && u.halfm) break;
#pragma unroll
            for (int m = 0; m < 4; ++m) { const f32x4 a0 = acc[ai][0][m][0] * S + g0, a1 = acc[ai][0][m][1] * S + g1, b0 = acc[ai][1][m][0] * S + l0, b1 = acc[ai][1][m][1] * S + l1;
                v2u w; w.x = pack_fp8x4(swiglu(a0[0], b0[0]), swiglu(a0[1], b0[1]), swiglu(a0[2], b0[2]), swiglu(a0[3], b0[3]));
                w.y = pack_fp8x4(swiglu(a1[0], b1[0]), swiglu(a1[1], b1[1]), swiglu(a1[2], b1[2]), swiglu(a1[3], b1[3]));
                *(v2u*)(aact + (size_t)(row0 + ai * HALF + m * 16) * DM + col0) = w; } }
    }
};
struct EpiDown8 {
    static constexpr bool PERM = true; bf16* y; const float* bd;
    __device__ __forceinline__ void operator()(AccRef acc, const Unit& u, int wr, int wc, int fr, int fq) const {
        const int row0 = u.rbase + wr * 64 + fr, col0 = u.pn * BM + wc * 32 + 8 * fq;
        constexpr float S = 1.f / 64.f;
#pragma unroll
        for (int bj = 0; bj < 2; ++bj) { const float* pb = bd + (size_t)u.e * DM + col0 + bj * HALF; const f32x4 c0 = *(const f32x4*)pb, c1 = *(const f32x4*)(pb + 4);
#pragma unroll
            for (int ai = 0; ai < 2; ++ai) { if (ai == 1 && u.halfm) break;
#pragma unroll
                for (int m = 0; m < 4; ++m) { const f32x4 v0 = acc[ai][bj][m][0] * S + c0, v1 = acc[ai][bj][m][1] * S + c1;
                    v4u w; w.x = cvt_pk_bf16(v0[0], v0[1]); w.y = cvt_pk_bf16(v0[2], v0[3]); w.z = cvt_pk_bf16(v1[0], v1[1]); w.w = cvt_pk_bf16(v1[2], v1[3]);
                    *(v4u*)(y + (size_t)(row0 + ai * HALF + m * 16) * DM + col0 + bj * HALF) = w; } } }
    }
};
}

__device__ __forceinline__ void tr_item(const float* __restrict__ W, int ldn, int K, int k0, int n0, bf16* __restrict__ WT, int drow0, const float* __restrict__ ks, LAS float* scr, int lane) {
    float v[32];
#pragma unroll
    for (int i = 0; i < 32; ++i) v[i] = __builtin_nontemporal_load(W + (size_t)(k0 + 2 * i + (lane >> 5)) * ldn + n0 + (lane & 31));
#pragma unroll
    for (int i = 0; i < 32; ++i) { const int kk = 2 * i + (lane >> 5); float x = v[i]; if (ks) x *= ks[k0 + kk]; scr[kk * 33 + (lane & 31)] = x; }
    LDS_WAIT(); asm volatile("" ::: "memory");
    const int c = lane & 7;
#pragma unroll
    for (int j = 0; j < 4; ++j) { const int n = (lane >> 3) + 8 * j; const LAS float* s = scr + (8 * c) * 33 + n;
        v4u o; o.x = pk2(s[0 * 33], s[1 * 33]); o.y = pk2(s[2 * 33], s[3 * 33]); o.z = pk2(s[4 * 33], s[5 * 33]); o.w = pk2(s[6 * 33], s[7 * 33]);
        *(v4u*)(WT + (size_t)(drow0 + n) * K + k0 + 8 * c) = o; }
    LDS_WAIT(); asm volatile("" ::: "memory");
}

__device__ __forceinline__ void tr_item8(const float* __restrict__ W, int ldn, int K, int k0, int n0, unsigned char* __restrict__ WT, int drow0, float scale, LAS float* scr, int lane) {
    float v[32];
#pragma unroll
    for (int i = 0; i < 32; ++i) v[i] = __builtin_nontemporal_load(W + (size_t)(k0 + 2 * i + (lane >> 5)) * ldn + n0 + (lane & 31));
#pragma unroll
    for (int i = 0; i < 32; ++i) { const int kk = 2 * i + (lane >> 5); scr[kk * 33 + (lane & 31)] = v[i] * scale; }
    LDS_WAIT(); asm volatile("" ::: "memory");
    const int c = lane & 3;
#pragma unroll
    for (int j = 0; j < 2; ++j) { const int n = (lane >> 2) + 16 * j; const LAS float* s = scr + (16 * c) * 33 + n;
        v4u o; o.x = pack_fp8x4(s[0 * 33], s[1 * 33], s[2 * 33], s[3 * 33]); o.y = pack_fp8x4(s[4 * 33], s[5 * 33], s[6 * 33], s[7 * 33]);
        o.z = pack_fp8x4(s[8 * 33], s[9 * 33], s[10 * 33], s[11 * 33]); o.w = pack_fp8x4(s[12 * 33], s[13 * 33], s[14 * 33], s[15 * 33]);
        *(v4u*)(WT + (size_t)(drow0 + n) * K + k0 + 16 * c) = o; }
    LDS_WAIT(); asm volatile("" ::: "memory");
}

struct FastArgs {
    const float* in[27];
    float* out; unsigned char* ws;
    int ph_lo, ph_hi, bar_region, pad;
};

constexpr int IT_WIN = 16 * 29, IT_WUQ = 4 * 24, IT_WUK = 2 * 16, IT_WUV = 2 * 16, IT_WOUT0 = 16 * 32, IT_WCIN = 16 * 96, IT_WCOUT = 16 * 32, IT_MOE = 64 * 512;
constexpr int IT_SMALL = IT_WIN + IT_WUQ + IT_WUK + IT_WUV + IT_WOUT0 + IT_WCIN + IT_WCOUT;
constexpr int IT_TOTAL = IT_SMALL + 3 * IT_MOE;

__device__ __forceinline__ void conv_item(const FastArgs& a, int it, LAS float* scr, int lane) {
    unsigned char* ws = a.ws;
    int r = it;
    if (r < IT_WIN) { const int kb = r / 29, nb = r % 29; tr_item(a.in[9], PROJ_A, 1024, kb * 64, nb * 32, (bf16*)(ws + WS_WIN), nb < 13 ? nb * 32 : nb * 32 + 96, nullptr, scr, lane); return; } r -= IT_WIN;
    if (r < IT_WUQ) { const int kb = r / 24, nb = r % 24; tr_item(a.in[12], 768, 256, kb * 64, nb * 32, (bf16*)(ws + WS_WUQ), nb * 32, a.in[10], scr, lane); return; } r -= IT_WUQ;
    if (r < IT_WUK) { const int kb = r / 16, nb = r % 16; tr_item(a.in[13], 512, 128, kb * 64, nb * 32, (bf16*)(ws + WS_WUKV), nb * 32, a.in[11], scr, lane); return; } r -= IT_WUK;
    if (r < IT_WUV) { const int kb = r / 16, nb = r % 16; tr_item(a.in[14], 512, 128, kb * 64, nb * 32, (bf16*)(ws + WS_WUKV), 512 + nb * 32, a.in[11], scr, lane); return; } r -= IT_WUV;
    if (r < IT_WOUT0) { const int kb = r / 32, nb = r % 32; tr_item(a.in[15], 1024, 1024, kb * 64, nb * 32, (bf16*)(ws + WS_WOUT0), nb * 32, nullptr, scr, lane); return; } r -= IT_WOUT0;
    if (r < IT_WCIN) { const int kb = r / 96, nb = r % 96, reg = nb >> 5, ch = (nb & 31) * 32;
        const int drow = (reg == 0) ? ch : 1024 + (ch >> 7) * 256 + (reg - 1) * 128 + (ch & 127);
        tr_item(a.in[16], 3072, 1024, kb * 64, nb * 32, (bf16*)(ws + WS_WCIN), drow, nullptr, scr, lane); return; } r -= IT_WCIN;
    if (r < IT_WCOUT) { const int kb = r / 32, nb = r % 32; tr_item(a.in[18], 1024, 1024, kb * 64, nb * 32, (bf16*)(ws + WS_WCOUT), nb * 32, nullptr, scr, lane); return; } r -= IT_WCOUT;
    const int which = r / IT_MOE; r -= which * IT_MOE;
    const int mat = r >> 9, rem = r & 511, kb = rem >> 5, nb = rem & 31;
    const float* src = a.in[which == 0 ? 21 : (which == 1 ? 23 : 25)] + (size_t)mat * DM * DM;
#if MOE_FP8
    if (which == 2) tr_item8(src, 1024, 1024, kb * 64, nb * 32, (unsigned char*)(ws + WS_WDN) + (size_t)mat * DM * DM, nb * 32, 64.f, scr, lane);
    else tr_item8(src, 1024, 1024, kb * 64, nb * 32, (unsigned char*)(ws + WS_WUP) + (size_t)mat * 2048 * DM, (nb >> 2) * 256 + which * 128 + (nb & 3) * 32, 32.f, scr, lane);
#else
    if (which == 2) tr_item(src, 1024, 1024, kb * 64, nb * 32, (bf16*)(ws + WS_WDN) + (size_t)mat * DM * DM, nb * 32, nullptr, scr, lane);
    else tr_item(src, 1024, 1024, kb * 64, nb * 32, (bf16*)(ws + WS_WUP) + (size_t)mat * 2048 * DM, (nb >> 2) * 256 + which * 128 + (nb & 3) * 32, nullptr, scr, lane);
#endif
}

__device__ __forceinline__ void mod_unit(const FastArgs& a, int unit, LAS float* lds, int tid) {
    LAS float* cond = lds; LAS float* part = lds + 4096;
    const float* c = a.in[1]; const float* ada_w = a.in[3]; const float* ada_b = a.in[4]; float* mod = (float*)(a.ws + WS_MOD);
    for (int i = tid; i < 4096; i += 512) { const float v = c[i]; cond[i] = v / (1.f + expf(-v)); }
    __syncthreads();
    const int l = unit >> 7, n0 = (unit & 127) * 48, ks = tid / 12, c4 = tid % 12;
    if (ks < 42) {
        f32x4 s0 = {0.f, 0.f, 0.f, 0.f}, s1 = s0, s2 = s0, s3 = s0;
        for (int k = ks; k < 1024; k += 42) { const f32x4 w = *(const f32x4*)(ada_w + ((size_t)l * 1024 + k) * 6144 + n0 + 4 * c4);
            s0 += w * cond[k]; s1 += w * cond[1024 + k]; s2 += w * cond[2048 + k]; s3 += w * cond[3072 + k]; }
        *(LAS f32x4*)(part + (ks * 4 + 0) * 48 + 4 * c4) = s0; *(LAS f32x4*)(part + (ks * 4 + 1) * 48 + 4 * c4) = s1;
        *(LAS f32x4*)(part + (ks * 4 + 2) * 48 + 4 * c4) = s2; *(LAS f32x4*)(part + (ks * 4 + 3) * 48 + 4 * c4) = s3;
    }
    __syncthreads();
    if (tid < 192) { const int b = tid / 48, col = tid % 48; float s = 0.f;
        for (int k = 0; k < 42; ++k) s += part[(k * 4 + b) * 48 + col];
        mod[(l * 4 + b) * 6144 + n0 + col] = s + ada_b[l * 6144 + n0 + col]; }
    __syncthreads();
}

__device__ __forceinline__ void p0_prologue(const FastArgs& a, LAS unsigned char* lds, int vcu, int G, int tid, int wave, int lane) {
    unsigned char* ws = a.ws;
    for (int u = vcu; u < 256; u += G) mod_unit(a, u, (LAS float*)lds, tid);
    { float* rope = (float*)(ws + WS_ROPE); const int* pos = (const int*)a.in[2];
      for (int i = vcu * 512 + tid; i < NT * 16; i += G * 512) { const int t = i >> 4, j = i & 15;
          const float inv = exp2f(-(float)j * (13.287712379549449f / 16.f)); const float ang = (float)pos[t] * inv;
          const double rev = (double)ang * 0.15915494309189535; const float fr = (float)(rev - rint(rev));
          rope[i] = __builtin_amdgcn_cosf(fr); rope[NT * 16 + i] = __builtin_amdgcn_sinf(fr); } }
    { bf16* cst = (bf16*)(ws + WS_CST);
      for (int i = vcu * 512 + tid; i < 128 * 64; i += G * 512) { const int n = i >> 6, c = i & 63; const float fr = (float)((c * (n & 63)) & 63) * (1.f / 64.f);
          cst[i] = f2bf(n < 64 ? __builtin_amdgcn_cosf(fr) : __builtin_amdgcn_sinf(fr)); } }
    { v4u* p = (v4u*)((bf16*)(ws + WS_WIN) + 416 * 1024); const v4u z = {0u, 0u, 0u, 0u};
      for (int i = vcu * 512 + tid; i < 96 * 1024 / 8; i += G * 512) p[i] = z; }
    { unsigned char* dm = (unsigned char*)(ws + WS_DMAT);
      for (int i = vcu * 512 + tid; i < 4096 * 8192 / 16; i += G * 512) { const int sp = i >> 9, k0 = (i & 511) * 16; unsigned w[4];
#pragma unroll
          for (int q = 0; q < 4; ++q) { float v[4];
#pragma unroll
              for (int e = 0; e < 4; ++e) { const int k = k0 + 4 * q + e, sq = k & 4095; const float fr = (float)((sp * sq) & 4095) * (1.f / 4096.f);
                  v[e] = (k < 4096) ? __builtin_amdgcn_cosf(fr) : -__builtin_amdgcn_sinf(fr); }
              w[q] = pack_fp8x4(v[0], v[1], v[2], v[3]); }
          v4u o = {w[0], w[1], w[2], w[3]}; *(v4u*)(dm + (size_t)i * 16) = o; } }
    { LAS float* scr = (LAS float*)(lds + wave * 16384);
      const int gw = vcu * NWAVES + wave, NGW = G * NWAVES;
      for (int it = gw; it < IT_SMALL; it += NGW) conv_item(a, it, scr, lane);
#if MOE_FP8
      float v[32], vn[32];
#define MOE_SRC(it_) ({ const int r_ = (it_) - IT_SMALL, wh_ = r_ / IT_MOE, q_ = r_ - wh_ * IT_MOE, mat_ = q_ >> 9, rem_ = q_ & 511; \
          a.in[wh_ == 0 ? 21 : (wh_ == 1 ? 23 : 25)] + (size_t)mat_ * DM * DM + (size_t)((rem_ >> 5) * 64 + (lane >> 5)) * DM + (rem_ & 31) * 32 + (lane & 31); })
      int it = IT_SMALL + ((G == 256) ? 2 * IT_MOE : 0) + gw;
      if (it < IT_TOTAL) { const float* sp = MOE_SRC(it);
#pragma unroll
          for (int i = 0; i < 32; ++i) v[i] = __builtin_nontemporal_load(sp + (size_t)(2 * i) * DM); }
      for (; it < IT_TOTAL; it += NGW) {
          const int nx = it + NGW;
          if (nx < IT_TOTAL) { const float* sp = MOE_SRC(nx);
#pragma unroll
              for (int i = 0; i < 32; ++i) vn[i] = __builtin_nontemporal_load(sp + (size_t)(2 * i) * DM); }
          const int r = it - IT_SMALL, which = r / IT_MOE, q = r - which * IT_MOE, mat = q >> 9, rem = q & 511, kb = rem >> 5, nb = rem & 31;
          const float scale = (which == 2) ? 64.f : 32.f;
          unsigned char* WT = (which == 2) ? (unsigned char*)(ws + WS_WDN) + (size_t)mat * DM * DM : (unsigned char*)(ws + WS_WUP) + (size_t)mat * 2048 * DM;
          const int drow0 = (which == 2) ? nb * 32 : (nb >> 2) * 256 + which * 128 + (nb & 3) * 32, k0 = kb * 64;
#pragma unroll
          for (int i = 0; i < 32; ++i) { const int kk = 2 * i + (lane >> 5); scr[kk * 33 + (lane & 31)] = v[i] * scale; }
          LDS_WAIT(); asm volatile("" ::: "memory");
          const int c = lane & 3;
#pragma unroll
          for (int j = 0; j < 2; ++j) { const int n = (lane >> 2) + 16 * j; const LAS float* sq = scr + (16 * c) * 33 + n;
              v4u o; o.x = pack_fp8x4(sq[0 * 33], sq[1 * 33], sq[2 * 33], sq[3 * 33]); o.y = pack_fp8x4(sq[4 * 33], sq[5 * 33], sq[6 * 33], sq[7 * 33]);
              o.z = pack_fp8x4(sq[8 * 33], sq[9 * 33], sq[10 * 33], sq[11 * 33]); o.w = pack_fp8x4(sq[12 * 33], sq[13 * 33], sq[14 * 33], sq[15 * 33]);
              *(v4u*)(WT + (size_t)(drow0 + n) * DM + k0 + 16 * c) = o; }
          LDS_WAIT(); asm volatile("" ::: "memory");
#pragma unroll
          for (int i = 0; i < 32; ++i) v[i] = vn[i];
      }
#undef MOE_SRC
#else
      for (int it = IT_SMALL + gw; it < IT_TOTAL; it += NGW) conv_item(a, it, scr, lane);
#endif
    }
}
namespace att {
constexpr int QBLK = 32, KVBLK = 64;
constexpr int SHM_V = KVBLK * 128 * 2, SHM_K = KVBLK * 128 * 2, SHM_ATTN = 2 * SHM_V + 2 * SHM_K + NWAVES * 64 * 4;
constexpr float THR = 8.f;
#define KSWZ(row, colB) ((row) * 256 + ((colB) ^ (((row) & 7) << 4)))
#define SBAR() __builtin_amdgcn_sched_barrier(0)
__device__ __forceinline__ int crow(int r, int hi) { return (r & 3) + 8 * (r >> 2) + 4 * hi; }
__device__ __forceinline__ unsigned cvtpk(float lo, float hi) { unsigned r; asm volatile("v_cvt_pk_bf16_f32 %0, %1, %2" : "=v"(r) : "v"(lo), "v"(hi)); return r; }
__device__ __forceinline__ bf16x8 ld8(const bf16* p) { return *reinterpret_cast<const bf16x8*>(p); }

template <bool FIRST> __device__ __forceinline__ void partialSM(f32x16& p0, f32x16& p1, float& m_reg, f32x16& negm, float& alpha) {
  constexpr float THRL = THR * 1.4426950408889634f;
  float pmax = p0[0];
#pragma unroll
  for (int r = 1; r < 16; ++r) pmax = fmaxf(pmax, p0[r]);
#pragma unroll
  for (int r = 0; r < 16; ++r) pmax = fmaxf(pmax, p1[r]);
  { auto rr = __builtin_amdgcn_permlane32_swap(__float_as_uint(pmax), __float_as_uint(pmax), false, false);
    pmax = fmaxf(__uint_as_float(rr[0]), __uint_as_float(rr[1])); }
  if (!FIRST && __builtin_expect(__all(pmax <= THRL), 1)) { alpha = 1.f; }
  else { const float dl = FIRST ? pmax : fmaxf(pmax, 0.f); m_reg += dl; alpha = __builtin_amdgcn_exp2f(-dl);
#pragma unroll
    for (int r = 0; r < 16; ++r) { p0[r] -= dl; p1[r] -= dl; }
#pragma unroll
    for (int r = 0; r < 16; ++r) negm[r] = -m_reg; }
#pragma unroll
  for (int r = 0; r < 16; ++r) p0[r] = __builtin_amdgcn_exp2f(p0[r]);
}
__device__ __forceinline__ void finishSM(f32x16& p0, f32x16& p1, float alpha, float& l_reg, bf16x8& pa0, bf16x8& pa1, bf16x8& pa2, bf16x8& pa3) {
#pragma unroll
  for (int r = 0; r < 16; ++r) p1[r] = __builtin_amdgcn_exp2f(p1[r]);
  float ps = 0;
#pragma unroll
  for (int r = 0; r < 16; ++r) ps += p0[r];
#pragma unroll
  for (int r = 0; r < 16; ++r) ps += p1[r];
  { auto rr = __builtin_amdgcn_permlane32_swap(__float_as_uint(ps), __float_as_uint(ps), false, false);
    ps = __uint_as_float(rr[0]) + __uint_as_float(rr[1]); }
  l_reg = l_reg * alpha + ps;
#define PK4(P, BASE, OUT) do { unsigned a0 = cvtpk(P[BASE + 0], P[BASE + 1]), a1 = cvtpk(P[BASE + 2], P[BASE + 3]);   \
    unsigned b0 = cvtpk(P[BASE + 4], P[BASE + 5]), b1 = cvtpk(P[BASE + 6], P[BASE + 7]);                              \
    auto r0 = __builtin_amdgcn_permlane32_swap(a0, b0, false, false); auto r1 = __builtin_amdgcn_permlane32_swap(a1, b1, false, false); \
    v4u w = {r0[0], r1[0], r0[1], r1[1]}; OUT = *reinterpret_cast<bf16x8*>(&w); } while (0)
  PK4(p0, 0, pa0); PK4(p0, 8, pa1); PK4(p1, 0, pa2); PK4(p1, 8, pa3);
#undef PK4
}
__device__ __forceinline__ void qkt(f32x16& p0, f32x16& p1, const bf16* Ks, const bf16x8* qr, int r32, int hi, const f32x16& negm) {
  p0 = negm; p1 = negm;
#pragma unroll
  for (int d0 = 0; d0 < 6; ++d0) { const int cb = (d0 * 16 + hi * 8) * 2;
    bf16x8 b0 = *reinterpret_cast<const bf16x8*>((const char*)Ks + KSWZ(r32, cb));
    bf16x8 b1 = *reinterpret_cast<const bf16x8*>((const char*)Ks + KSWZ(32 + r32, cb));
    p0 = __builtin_amdgcn_mfma_f32_32x32x16_bf16(b0, qr[d0], p0, 0, 0, 0);
    p1 = __builtin_amdgcn_mfma_f32_32x32x16_bf16(b1, qr[d0], p1, 0, 0, 0); }
}
__device__ __forceinline__ int v_st(int k, int c) { const int kk = (k & ~0xC) | ((k & 4) << 1) | ((k & 8) >> 1); return ((kk >> 3) * 4 + (c >> 5)) * 512 + ((kk & 7) * 32 + (c & 31)) * 2; }
__device__ __forceinline__ int v_rd_base(int lane) { return ((lane & 3) << 3) | (((lane >> 2) & 3) << 6) | (((lane >> 4) & 1) << 5) | (((lane >> 5) & 1) << 8); }
constexpr int v_rd_off(int d0, int ks, int half) { return d0 * 512 + ks * 4096 + half * 2048; }
template <int OFF> __device__ __forceinline__ s16x4 tr_read(int vb) {
  s16x4 r; asm volatile("ds_read_b64_tr_b16 %0, %1 offset:%2" : "=&v"(r) : "v"(vb), "i"(OFF) : "memory"); return r;
}
template <int D0> __device__ __forceinline__ void pv_one(f32x16& od, int vb, bf16x8 pa0, bf16x8 pa1, bf16x8 pa2, bf16x8 pa3) {
  const s16x4 l0 = tr_read<v_rd_off(D0, 0, 0)>(vb), h0 = tr_read<v_rd_off(D0, 0, 1)>(vb), l1 = tr_read<v_rd_off(D0, 1, 0)>(vb), h1 = tr_read<v_rd_off(D0, 1, 1)>(vb);
  const s16x4 l2 = tr_read<v_rd_off(D0, 2, 0)>(vb), h2 = tr_read<v_rd_off(D0, 2, 1)>(vb), l3 = tr_read<v_rd_off(D0, 3, 0)>(vb), h3 = tr_read<v_rd_off(D0, 3, 1)>(vb);
  asm volatile("s_waitcnt lgkmcnt(0)" ::: "memory"); SBAR();
#define PK(L, H) (bf16x8){L[0], L[1], L[2], L[3], H[0], H[1], H[2], H[3]}
  od = __builtin_amdgcn_mfma_f32_32x32x16_bf16(pa0, PK(l0, h0), od, 0, 0, 0);
  od = __builtin_amdgcn_mfma_f32_32x32x16_bf16(pa1, PK(l1, h1), od, 0, 0, 0);
  od = __builtin_amdgcn_mfma_f32_32x32x16_bf16(pa2, PK(l2, h2), od, 0, 0, 0);
  od = __builtin_amdgcn_mfma_f32_32x32x16_bf16(pa3, PK(l3, h3), od, 0, 0, 0);
#undef PK
}
__device__ __forceinline__ void pv_d0(f32x16* o, int vb, bf16x8 pa0, bf16x8 pa1, bf16x8 pa2, bf16x8 pa3) {
  pv_one<0>(o[0], vb, pa0, pa1, pa2, pa3); pv_one<1>(o[1], vb, pa0, pa1, pa2, pa3);
}
template <bool BG> __device__ __forceinline__ void attn_unit(const bf16* __restrict__ Qb, const bf16* __restrict__ Kh, const bf16* __restrict__ Vh, bf16* __restrict__ Ob, int ldo, int seq, char* lds, const float* bg_src0, const float* bg_src1, const float* bg_src2, unsigned char* bg_wup, unsigned char* bg_wdn, int& c_it, const int c_end) {
  int tid = threadIdx.x; asm volatile("" : "+v"(tid));
  const int wid = tid >> 6, lane = tid & 63, r32 = lane & 31, hi = lane >> 5;
  bf16* V_lds = (bf16*)lds; bf16* K_lds = (bf16*)(lds + 2 * SHM_V);
  float* ws = (float*)(lds + 2 * SHM_V + 2 * SHM_K) + wid * 64; float* li_l = ws; float* al_l = ws + 32;
  float m_reg = 0.f, l_reg = 0; f32x16 o[2] = {}; bf16x8 qr[6]; f32x16 negm = {};
  const bf16* Qw = Qb + (long)(wid * QBLK + r32) * QKD + hi * 8;
#pragma unroll
  for (int d0 = 0; d0 < 6; ++d0) qr[d0] = ld8(Qw + d0 * 16);
  const bool lowh = tid < 256;
  const int cA = tid, rA = cA / 12, qA = cA - rA * 12;
  const int cBk = 512 + (tid & 255), rBk = cBk / 12, qBk = cBk - rBk * 12, cBv = tid & 255, rBv = cBv >> 3, qBv = cBv & 7;
  const int cCv = lowh ? 256 + tid : (tid & 255), rCv = cCv >> 3, qCv = cCv & 7;
  const bf16* pA = Kh + (long)rA * QKD + qA * 8;
  const bf16* pB = lowh ? Kh + (long)rBk * QKD + qBk * 8 : Vh + (long)rBv * VH + qBv * 8; const int sB = lowh ? QKD : VH;
  const bf16* pC = Vh + (long)rCv * VH + qCv * 8;
  const int wA = 2 * SHM_V + KSWZ(rA, qA * 16), wB = lowh ? 2 * SHM_V + KSWZ(rBk, qBk * 16) : v_st(rBv, qBv * 8), wC = v_st(rCv, qCv * 8);
  const int vb0 = (int)(uintptr_t)V_lds + v_rd_base(lane);
  struct { bf16x8 x0, x1, x2; } sr_[2];
#define SLOAD(i, k0) do { sr_[i].x0 = ld8(pA + (long)(k0) * QKD); sr_[i].x1 = ld8(pB + (long)(k0) * sB); sr_[i].x2 = ld8(pC + (long)(k0) * VH); } while (0)
#define SWRITE(bb, i) do { *(bf16x8*)(lds + wA + (bb) * SHM_K) = sr_[i].x0; *(bf16x8*)(lds + wB + (bb) * SHM_K) = sr_[i].x1; *(bf16x8*)(lds + wC + (bb) * SHM_K) = sr_[i].x2; } while (0)
#define RESC(a) do { if (__any((a) < 1.f)) { if (hi == 0) al_l[r32] = (a); asm volatile("s_waitcnt lgkmcnt(0)" ::: "memory"); \
    _Pragma("unroll") for (int d = 0; d < 2; ++d) _Pragma("unroll") for (int r = 0; r < 16; ++r) o[d][r] *= al_l[crow(r, hi)]; } } while (0)
  float cv[16];
#define BG_LOAD() do { if constexpr (BG) { const int wh_ = c_it / 65536, q_ = c_it & 65535, mat_ = q_ >> 10, nb_ = (q_ >> 6) & 15, kc_ = q_ & 63; \
      const float* s_ = (wh_ == 0 ? bg_src0 : (wh_ == 1 ? bg_src1 : bg_src2)) + (size_t)mat_ * DM * DM + (size_t)(16 * kc_) * DM + 64 * nb_ + lane; \
      _Pragma("unroll") for (int i_ = 0; i_ < 16; ++i_) cv[i_] = __builtin_nontemporal_load(s_ + (size_t)i_ * DM); } } while (0)
#define BG_STORE() do { if constexpr (BG) { const int wh_ = c_it / 65536, q_ = c_it & 65535, mat_ = q_ >> 10, nb_ = (q_ >> 6) & 15, kc_ = q_ & 63, n_ = 64 * nb_ + lane; const float sc_ = (wh_ == 2) ? 64.f : 32.f; \
      unsigned char* d_ = (wh_ == 2) ? bg_wdn + ((size_t)mat_ * DM + n_) * DM + 16 * kc_ : bg_wup + ((size_t)mat_ * 2048 + (n_ >> 7) * 256 + wh_ * 128 + (n_ & 127)) * DM + 16 * kc_; \
      v4u o_; o_.x = pack_fp8x4(cv[0] * sc_, cv[1] * sc_, cv[2] * sc_, cv[3] * sc_); o_.y = pack_fp8x4(cv[4] * sc_, cv[5] * sc_, cv[6] * sc_, cv[7] * sc_); \
      o_.z = pack_fp8x4(cv[8] * sc_, cv[9] * sc_, cv[10] * sc_, cv[11] * sc_); o_.w = pack_fp8x4(cv[12] * sc_, cv[13] * sc_, cv[14] * sc_, cv[15] * sc_); \
      *(v4u*)d_ = o_; } } while (0)
#define BG_STEP() do { if constexpr (BG) { BG_STORE(); c_it = (c_it + 1 < c_end) ? c_it + 1 : c_end - 1; BG_LOAD(); } } while (0)
  f32x16 pA0, pA1, pB0, pB1; float alA, alB; bf16x8 pa0, pa1, pa2, pa3; const int NTL = seq / KVBLK;
  constexpr int SE = 0, SO = 1;
  SLOAD(SE, 0); asm volatile("s_waitcnt vmcnt(0)" ::: "memory"); SWRITE(0, SE); __syncthreads();
  qkt(pA0, pA1, K_lds, qr, r32, hi, negm); partialSM<true>(pA0, pA1, m_reg, negm, alA); alA = 1.f;
  SLOAD(SO, KVBLK); SLOAD(SE, 2 * KVBLK); BG_LOAD();
  SWRITE(1, SO); __syncthreads();
  for (int j = 1; j + 1 < NTL; j += 2) {
    SBAR(); qkt(pB0, pB1, (bf16*)((char*)K_lds + SHM_K), qr, r32, hi, negm);
    finishSM(pA0, pA1, alA, l_reg, pa0, pa1, pa2, pa3); SBAR();
    SLOAD(SO, (j + 2) * KVBLK); BG_STEP(); SBAR();
    pv_d0(o, vb0, pa0, pa1, pa2, pa3); partialSM<false>(pB0, pB1, m_reg, negm, alB);
    __syncthreads(); SWRITE(0, SE);
    RESC(alB); __syncthreads();
    SBAR(); qkt(pA0, pA1, K_lds, qr, r32, hi, negm);
    finishSM(pB0, pB1, alB, l_reg, pa0, pa1, pa2, pa3); SBAR();
    { const int kn_ = (j + 3 < NTL) ? (j + 3) * KVBLK : seq - KVBLK; SLOAD(SE, kn_); } SBAR();
    pv_d0(o, vb0 + (int)SHM_V, pa0, pa1, pa2, pa3); partialSM<false>(pA0, pA1, m_reg, negm, alA);
    __syncthreads(); SWRITE(1, SO);
    RESC(alA); __syncthreads();
  }
  SBAR(); qkt(pB0, pB1, (bf16*)((char*)K_lds + SHM_K), qr, r32, hi, negm);
  finishSM(pA0, pA1, alA, l_reg, pa0, pa1, pa2, pa3); SBAR();
  pv_d0(o, vb0, pa0, pa1, pa2, pa3); partialSM<false>(pB0, pB1, m_reg, negm, alB);
  __syncthreads(); RESC(alB);
  finishSM(pB0, pB1, alB, l_reg, pa0, pa1, pa2, pa3); SBAR();
  pv_d0(o, vb0 + (int)SHM_V, pa0, pa1, pa2, pa3);
  if (hi == 0) li_l[r32] = l_reg; asm volatile("s_waitcnt lgkmcnt(0)" ::: "memory");
  float rli[16];
#pragma unroll
  for (int r = 0; r < 16; ++r) rli[r] = __builtin_amdgcn_rcpf(li_l[crow(r, hi)]);
  bf16* Ow = Ob + (long)(wid * QBLK) * ldo;
#pragma unroll
  for (int r = 0; r < 16; ++r) { const int orow = crow(r, hi);
#pragma unroll
    for (int d0 = 0; d0 < 2; ++d0) Ow[(long)orow * ldo + d0 * 32 + r32] = f2bf(o[d0][r] * rli[r]); }
  BG_STORE(); if constexpr (BG) c_it = (c_it + 1 < c_end) ? c_it + 1 : c_end - 1;
  __syncthreads();
#undef BG_STEP
#undef BG_LOAD
#undef BG_STORE
#undef SLOAD
#undef SWRITE
#undef RESC
}
#undef KSWZ
#undef SBAR
}

constexpr int P3_CQ_LD = 264, P3_CKV_LD = 136, P3_UF_LD = 520;
constexpr int P3_CQ_OFF = 0, P3_CKV_OFF = 64 * P3_CQ_LD * 2, P3_UF_OFF = P3_CKV_OFF + 64 * P3_CKV_LD * 2, P3_R_OFF = P3_UF_OFF + 64 * P3_UF_LD * 2, P3_BYTES = P3_R_OFF + 512;
__device__ __forceinline__ void p3_unit(const FastArgs& a, int chunk, LAS unsigned char* lds) {
    int tid = threadIdx.x; asm volatile("" : "+v"(tid));
    const int lane = tid & 63, wave = __builtin_amdgcn_readfirstlane(tid >> 6);
    unsigned char* ws = a.ws;
    const bf16* CQ = (const bf16*)(ws + WS_CQ); const bf16* CKV = (const bf16*)(ws + WS_CKV); const bf16* KPE = (const bf16*)(ws + WS_KPE); const bf16* UF = (const bf16*)(ws + WS_UF);
    const bf16* Wuq = (const bf16*)(ws + WS_WUQ); const bf16* Wukv = (const bf16*)(ws + WS_WUKV); const bf16* CSt = (const bf16*)(ws + WS_CST); const float* rope = (const float*)(ws + WS_ROPE);
    bf16* Qo = (bf16*)(ws + WS_Q); bf16* Ko = (bf16*)(ws + WS_K); bf16* Vo = (bf16*)(ws + WS_V); bf16* UCS = (bf16*)(ws + WS_UCS);
    LAS bf16* cqs = (LAS bf16*)(lds + P3_CQ_OFF); LAS bf16* ckvs = (LAS bf16*)(lds + P3_CKV_OFF); LAS bf16* ufs = (LAS bf16*)(lds + P3_UF_OFF);
    LAS float* rq = (LAS float*)(lds + P3_R_OFF); LAS float* rkv = rq + 64;
    const int t0 = chunk * 64, b = t0 >> 12, s0 = t0 & 4095, fr = lane & 15, fq = lane >> 4;
#pragma unroll
    for (int i = 0; i < 4; ++i) { const int p = tid + 512 * i, r = p >> 5, c = p & 31; *(LAS v4u*)(cqs + r * P3_CQ_LD + c * 8) = *(const v4u*)(CQ + (size_t)(t0 + r) * 256 + c * 8); }
#pragma unroll
    for (int i = 0; i < 2; ++i) { const int p = tid + 512 * i, r = p >> 4, c = p & 15; *(LAS v4u*)(ckvs + r * P3_CKV_LD + c * 8) = *(const v4u*)(CKV + (size_t)(t0 + r) * 128 + c * 8); }
#pragma unroll
    for (int i = 0; i < 8; ++i) { const int p = tid + 512 * i, r = p >> 6, c = p & 63; *(LAS v4u*)(ufs + r * P3_UF_LD + c * 8) = *(const v4u*)(UF + (size_t)(t0 + r) * 512 + c * 8); }
    __syncthreads();
#pragma unroll
    for (int i = 0; i < 8; ++i) { const int r = wave * 8 + i;
        const v2u u = *(const LAS v2u*)(cqs + r * P3_CQ_LD + lane * 4);
        const float x0 = __uint_as_float(u.x << 16), x1 = __uint_as_float(u.x & 0xffff0000u), x2 = __uint_as_float(u.y << 16), x3 = __uint_as_float(u.y & 0xffff0000u);
        const float sq = wsum((x0 * x0 + x1 * x1) + (x2 * x2 + x3 * x3));
        const unsigned v = *(const LAS unsigned*)(ckvs + r * P3_CKV_LD + lane * 2);
        const float y0 = __uint_as_float(v << 16), y1 = __uint_as_float(v & 0xffff0000u);
        const float sk = wsum(y0 * y0 + y1 * y1);
        if (lane == 0) { rq[r] = rsqrtf(sq * (1.f / 256.f) + 1e-6f); rkv[r] = rsqrtf(sk * (1.f / 128.f) + 1e-6f); } }
    __syncthreads();
    const size_t bh = (size_t)(b * NH + wave) * NS;
    {
        f32x4 acc[4][6];
#pragma unroll
        for (int m = 0; m < 4; ++m)
#pragma unroll
            for (int n = 0; n < 6; ++n) acc[m][n] = (f32x4){0.f, 0.f, 0.f, 0.f};
#pragma unroll 1
        for (int kt = 0; kt < 8; ++kt) { bf16x8 af[4], wf[6];
#pragma unroll
            for (int m = 0; m < 4; ++m) af[m] = *(const LAS bf16x8*)(cqs + (16 * m + fr) * P3_CQ_LD + kt * 32 + 8 * fq);
#pragma unroll
            for (int n = 0; n < 6; ++n) wf[n] = *(const bf16x8*)(Wuq + (size_t)(96 * wave + 16 * n + fr) * 256 + kt * 32 + 8 * fq);
#pragma unroll
            for (int m = 0; m < 4; ++m)
#pragma unroll
                for (int n = 0; n < 6; ++n) acc[m][n] = __builtin_amdgcn_mfma_f32_16x16x32_bf16(wf[n], af[m], acc[m][n], 0, 0, 0); }
#pragma unroll
        for (int m = 0; m < 4; ++m) { const int tl = 16 * m + fr, t = t0 + tl; const float sc = rq[tl] * (0.10206207261596575f * 1.4426950408889634f);
            bf16* qrow = Qo + (bh + s0 + tl) * QKD + 4 * fq;
#pragma unroll
            for (int n = 0; n < 4; ++n) { const f32x4 v = acc[m][n] * sc; v2u w; w.x = cvt_pk_bf16(v[0], v[1]); w.y = cvt_pk_bf16(v[2], v[3]); *(v2u*)(qrow + 16 * n) = w; }
            const f32x4 cs = *(const f32x4*)(rope + (size_t)t * 16 + 4 * fq), sn = *(const f32x4*)(rope + (size_t)NT * 16 + (size_t)t * 16 + 4 * fq);
            const f32x4 t1 = acc[m][4] * sc, t2 = acc[m][5] * sc; const f32x4 o1 = t1 * cs - t2 * sn, o2 = t2 * cs + t1 * sn;
            v2u w1, w2; w1.x = cvt_pk_bf16(o1[0], o1[1]); w1.y = cvt_pk_bf16(o1[2], o1[3]); w2.x = cvt_pk_bf16(o2[0], o2[1]); w2.y = cvt_pk_bf16(o2[2], o2[3]);
            *(v2u*)(qrow + 64) = w1; *(v2u*)(qrow + 80) = w2; }
    }
#pragma unroll 1
    for (int pass = 0; pass < 2; ++pass) {
        f32x4 acc[4][4];
#pragma unroll
        for (int m = 0; m < 4; ++m)
#pragma unroll
            for (int n = 0; n < 4; ++n) acc[m][n] = (f32x4){0.f, 0.f, 0.f, 0.f};
#pragma unroll
        for (int kt = 0; kt < 4; ++kt) { bf16x8 af[4], wf[4];
#pragma unroll
            for (int m = 0; m < 4; ++m) af[m] = *(const LAS bf16x8*)(ckvs + (16 * m + fr) * P3_CKV_LD + kt * 32 + 8 * fq);
#pragma unroll
            for (int n = 0; n < 4; ++n) wf[n] = *(const bf16x8*)(Wukv + (size_t)(512 * pass + 64 * wave + 16 * n + fr) * 128 + kt * 32 + 8 * fq);
#pragma unroll
            for (int m = 0; m < 4; ++m)
#pragma unroll
                for (int n = 0; n < 4; ++n) acc[m][n] = __builtin_amdgcn_mfma_f32_16x16x32_bf16(wf[n], af[m], acc[m][n], 0, 0, 0); }
#pragma unroll
        for (int m = 0; m < 4; ++m) { const int tl = 16 * m + fr; const float sc = rkv[tl];
            bf16* orow = (pass == 0) ? (Ko + (bh + s0 + tl) * QKD + 4 * fq) : (Vo + (bh + s0 + tl) * VH + 4 * fq);
#pragma unroll
            for (int n = 0; n < 4; ++n) { const f32x4 v = acc[m][n] * sc; v2u w; w.x = cvt_pk_bf16(v[0], v[1]); w.y = cvt_pk_bf16(v[2], v[3]); *(v2u*)(orow + 16 * n) = w; } }
    }
#pragma unroll
    for (int i = 0; i < 4; ++i) { const int p = lane + 64 * i, tl = p >> 2, c = p & 3;
        *(v4u*)(Ko + (bh + s0 + tl) * QKD + 64 + 8 * c) = *(const v4u*)(KPE + (size_t)(t0 + tl) * 32 + 8 * c); }
#pragma unroll 1
    for (int pass = 0; pass < 2; ++pass) {
        f32x4 acc[4][4];
#pragma unroll
        for (int m = 0; m < 4; ++m)
#pragma unroll
            for (int n = 0; n < 4; ++n) acc[m][n] = (f32x4){0.f, 0.f, 0.f, 0.f};
#pragma unroll
        for (int kt = 0; kt < 2; ++kt) { bf16x8 af[4], wf[4];
#pragma unroll
            for (int m = 0; m < 4; ++m) af[m] = *(const LAS bf16x8*)(ufs + (16 * m + fr) * P3_UF_LD + 64 * wave + kt * 32 + 8 * fq);
#pragma unroll
            for (int n = 0; n < 4; ++n) wf[n] = *(const bf16x8*)(CSt + (size_t)(64 * pass + 16 * n + fr) * 64 + kt * 32 + 8 * fq);
#pragma unroll
            for (int m = 0; m < 4; ++m)
#pragma unroll
                for (int n = 0; n < 4; ++n) acc[m][n] = __builtin_amdgcn_mfma_f32_16x16x32_bf16(af[m], wf[n], acc[m][n], 0, 0, 0); }
#pragma unroll
        for (int m = 0; m < 4; ++m)
#pragma unroll
            for (int n = 0; n < 4; ++n) { const f32x4 v = acc[m][n];
                *(unsigned*)((unsigned char*)UCS + ((size_t)(b * 512 + 64 * wave + 16 * n + fr)) * 8192 + 4096 * pass + s0 + 16 * m + 4 * fq) = pack_fp8x4(v[0], v[1], v[2], v[3]); }
    }
    __syncthreads();
}

__device__ __forceinline__ void conv_phase(const FastArgs& a, unsigned char* ws, int vcu, int G, int tid) {
    const bf16* gbp = (const bf16*)(ws + WS_PC); const bf16* up = (const bf16*)(ws + WS_PC + (size_t)NT * DM * 2); bf16* yc = (bf16*)(ws + WS_YC); const float* cw = a.in[17];
    for (int i = vcu * 512 + tid; i < NT * 128; i += G * 512) { const int t = i >> 7, c = (i & 127) * 8, s = t & 4095;
        const bf16x8 gb = *(const bf16x8*)(gbp + (size_t)t * DM + c), u1 = *(const bf16x8*)(up + (size_t)t * DM + c);
        bf16x8 u0 = {0, 0, 0, 0, 0, 0, 0, 0}, u2 = u0;
        if (s > 0) u0 = *(const bf16x8*)(up + (size_t)(t - 1) * DM + c);
        if (s < NS - 1) u2 = *(const bf16x8*)(up + (size_t)(t + 1) * DM + c);
        const f32x4 w0a = *(const f32x4*)(cw + c), w0b = *(const f32x4*)(cw + c + 4), w1a = *(const f32x4*)(cw + 1024 + c), w1b = *(const f32x4*)(cw + 1024 + c + 4), w2a = *(const f32x4*)(cw + 2048 + c), w2b = *(const f32x4*)(cw + 2048 + c + 4);
        float y[8];
#pragma unroll
        for (int j = 0; j < 8; ++j) { const float w0 = j < 4 ? w0a[j & 3] : w0b[j & 3], w1 = j < 4 ? w1a[j & 3] : w1b[j & 3], w2 = j < 4 ? w2a[j & 3] : w2b[j & 3];
            y[j] = bf2f((bf16)gb[j]) * (bf2f((bf16)u0[j]) * w0 + bf2f((bf16)u1[j]) * w1 + bf2f((bf16)u2[j]) * w2); }
        v4u w = {cvt_pk_bf16(y[0], y[1]), cvt_pk_bf16(y[2], y[3]), cvt_pk_bf16(y[4], y[5]), cvt_pk_bf16(y[6], y[7])};
        *(v4u*)(yc + (size_t)t * DM + c) = w; }
}

constexpr int N_PHASES = 17;
#ifndef PHMASK
#define PHMASK 0x1ffff
#endif
#define PHASE_ENV() int tid = threadIdx.x; asm volatile("" : "+v"(tid)); const int lane = tid & 63, wave = __builtin_amdgcn_readfirstlane(tid >> 6); \
    int Gv_ = gridDim.x, bxv_ = blockIdx.x; unsigned wl_ = (unsigned)(unsigned long long)a.ws, wh_ = (unsigned)((unsigned long long)a.ws >> 32); asm volatile("" : "+v"(Gv_), "+v"(bxv_), "+v"(wl_), "+v"(wh_)); \
    const int G = __builtin_amdgcn_readfirstlane(Gv_), bx = __builtin_amdgcn_readfirstlane(bxv_); const int vcu = (G % 8 == 0) ? (bx % 8) * (G / 8) + bx / 8 : bx; \
    unsigned char* ws = (unsigned char*)(GAS unsigned char*)(((unsigned long long)(unsigned)__builtin_amdgcn_readfirstlane((int)wh_) << 32) | (unsigned long long)(unsigned)__builtin_amdgcn_readfirstlane((int)wl_));     \
    int lz_ = 0; asm volatile("" : "+v"(lz_)); LAS unsigned char* ldsp = lds + __builtin_amdgcn_readfirstlane(lz_);     \
    (void)lane; (void)wave; (void)vcu; (void)tid; (void)ldsp
#define IN(k) (((PHMASK >> (k)) & 1) && lo <= (k) && (k) < hi)
#ifndef DUPMASK
#define DUPMASK 0
#endif
#ifndef SEAMREP
#define SEAMREP 1
#endif
#define NREP(k) ((((DUPMASK) >> (k)) & 1) ? 2 : 1)
#define SEAM(k) do { if (IN(k) && IN((k) + 1)) { PHASE_ENV(); XcdBarrier b_; b_.bar = (unsigned*)(ws + WS_CTL) + CW_BAR + a.bar_region * XCD_BAR_WORDS; b_.x = xb_xcc_id(); \
        b_.st = (volatile LAS unsigned*)(lds + MISC_OFF) + 8; for (int sr_ = 0; sr_ < SEAMREP; ++sr_) xcd_barrier(b_); } } while (0)


template <int L> __device__ __forceinline__ void moe_block(const FastArgs& a, LAS unsigned char* lds) {
    extern __shared__ __attribute__((aligned(16))) unsigned char lds_raw[];
#if (MODE & 16)
    constexpr int lo = 0, hi = N_PHASES;
#else
    const int lo = a.ph_lo, hi = a.ph_hi;
#endif
        const int p0 = (L == 0) ? 6 : 13;
        if (IN(p0)) for (int rep_ = 0; rep_ < NREP(p0); ++rep_) { if (rep_) __syncthreads(); PHASE_ENV(); RowArgs r{}; if (L == 0) r.xin = a.in[0]; else r.xin_bf = (const bf16*)(ws + WS_XB); r.o_bf = (const bf16*)(ws + WS_O); r.xout_bf = (bf16*)(ws + WS_XA);
#if MOE_FP8
            r.h8 = (unsigned char*)(ws + WS_H8);
#else
            r.h = (bf16*)(ws + WS_H);
#endif
            r.mod = (const float*)(ws + WS_MOD) + L * 4 * 6144; r.gamma = a.in[5] + L * DM; r.beta = a.in[6] + L * DM;
            r.wr = a.in[19] + (size_t)L * DM * NE; r.br = a.in[20] + L * NE; r.topi = (int*)(ws + WS_TOPI); r.tpos = (int*)(ws + WS_TPOS); r.gate = (float*)(ws + WS_GATE); r.list = (int*)(ws + WS_LIST);
            r.cnt = (unsigned*)(ws + WS_CTL) + CW_CNT + 32 * L;
            if (NREP(p0) == 2 && rep_ == 0) { r.cnt += 1024; r.topi = (int*)(ws + WS_TMP); r.tpos = (int*)(ws + WS_TMP + MiB); r.gate = (float*)(ws + WS_TMP + 2 * MiB); r.list = (int*)(ws + WS_TMP + 4 * MiB); }
            load_wl(r.wr, (char*)lds_raw, tid); __syncthreads();
            for (int ch = vcu; ch < NT / 64; ch += G) rp_b_chunk(r, ch, wave, lane, (char*)lds_raw); }
        SEAM(p0);
        if (IN(p0 + 1)) for (int rep_ = 0; rep_ < NREP(p0 + 1); ++rep_) { if (rep_) __syncthreads(); PHASE_ENV(); const unsigned* cntL = (const unsigned*)(ws + WS_CTL) + CW_CNT + 32 * L; const size_t EW = (size_t)L * NE * DM * DM, EB = (size_t)L * NE * DM;
            compute_poff(cntL, (int*)(lds_raw + MISC_OFF + 256), tid); __syncthreads();
#if MOE_FP8
            pg8::MoeSched S{(const LAS int*)(ldsp + MISC_OFF + 256), (const char*)(ws + WS_H8), (const char*)(ws + WS_WUP) + EW * 2, (const int*)(ws + WS_LIST), cntL, 8, G, vcu, (size_t)2048 * DM, true, DM};
            pg8::EpiUp8 E{(unsigned char*)(ws + WS_AACT), a.in[22] + EB, a.in[24] + EB};
            pg8::gemm_phase<pg8::EpiUp8, pg8::MoeSched, true, true, true>(ldsp, DM, S, E); }
#else
            pg8::MoeSched S{(const LAS int*)(ldsp + MISC_OFF + 256), (const char*)(ws + WS_H), (const char*)(ws + WS_WUP) + EW * 4, (const int*)(ws + WS_LIST), cntL, 8, G, vcu, (size_t)2048 * DM * 2, true, 2 * DM};
            pg8::EpiUp E{(bf16*)(ws + WS_AACT), a.in[22] + EB, a.in[24] + EB};
            pg8::gemm_phase<pg8::EpiUp, pg8::MoeSched, true, true>(ldsp, 2 * DM, S, E); }
#endif
        SEAM(p0 + 1);
        if (IN(p0 + 2)) for (int rep_ = 0; rep_ < NREP(p0 + 2); ++rep_) { if (rep_) __syncthreads(); PHASE_ENV(); const unsigned* cntL = (const unsigned*)(ws + WS_CTL) + CW_CNT + 32 * L; const size_t EW = (size_t)L * NE * DM * DM, EB = (size_t)L * NE * DM;
            compute_poff(cntL, (int*)(lds_raw + MISC_OFF + 256), tid); __syncthreads();
#if MOE_FP8
            pg8::MoeSched S{(const LAS int*)(ldsp + MISC_OFF + 256), (const char*)(ws + WS_AACT), (const char*)(ws + WS_WDN) + EW, (const int*)(ws + WS_LIST), cntL, 4, G, vcu, (size_t)DM * DM, false, DM};
            pg8::EpiDown8 E{(bf16*)(ws + WS_Y), a.in[26] + EB};
            pg8::gemm_phase<pg8::EpiDown8, pg8::MoeSched, false, true, true>(ldsp, DM, S, E); }
#else
            pg8::MoeSched S{(const LAS int*)(ldsp + MISC_OFF + 256), (const char*)(ws + WS_AACT), (const char*)(ws + WS_WDN) + EW * 2, (const int*)(ws + WS_LIST), cntL, 4, G, vcu, (size_t)DM * DM * 2, false, 2 * DM};
            pg8::EpiDown E{(bf16*)(ws + WS_Y), a.in[26] + EB};
            pg8::gemm_phase<pg8::EpiDown, pg8::MoeSched, false, true>(ldsp, 2 * DM, S, E); }
#endif
        SEAM(p0 + 2);
        if (IN(p0 + 3)) for (int rep_ = 0; rep_ < NREP(p0 + 3); ++rep_) { if (rep_) __syncthreads(); PHASE_ENV(); RowArgs r{}; r.xin_bf = (const bf16*)(ws + WS_XA); if (L == 0) r.xout_bf = (bf16*)(ws + WS_XB); else r.xout = a.out; r.h = (bf16*)(ws + WS_H);
            r.mod = (const float*)(ws + WS_MOD) + L * 4 * 6144; r.mod_next = (const float*)(ws + WS_MOD) + 4 * 6144; r.gamma = a.in[7] + L * DM; r.beta = a.in[8] + L * DM;
            r.topi = (int*)(ws + WS_TOPI); r.tpos = (int*)(ws + WS_TPOS); r.gate = (float*)(ws + WS_GATE); r.y = (const bf16*)(ws + WS_Y); r.cntc = (const unsigned*)(ws + WS_CTL) + CW_CNT + 32 * L;
            compute_poff(r.cntc, (int*)(lds_raw + MISC_OFF + 256), tid); __syncthreads();
            for (int ch = vcu; ch < NT / 64; ch += G) rp_c_chunk(r, ch, wave, lane, (const int*)(lds_raw + MISC_OFF + 256), L == 1); }
}

__global__ void __launch_bounds__(512) mk_fwd(FastArgs a) {
    extern __shared__ __attribute__((aligned(16))) unsigned char lds_raw[];
    LAS unsigned char* lds = (LAS unsigned char*)lds_raw;
    { volatile LAS unsigned* MISC = (volatile LAS unsigned*)(lds + MISC_OFF);
      for (int u = threadIdx.x; u < (LDS_BYTES - MISC_OFF) / 4; u += 512) ((LAS unsigned*)(lds + MISC_OFF))[u] = 0u;
      __syncthreads();
      (void)xcd_barrier_post((unsigned*)(a.ws + WS_CTL) + CW_BAR + a.bar_region * XCD_BAR_WORDS, MISC + 8); }
#if (MODE & 16)
    constexpr int lo = 0, hi = N_PHASES;
#else
    const int lo = a.ph_lo, hi = a.ph_hi;
#endif
    if (IN(0)) for (int rep_ = 0; rep_ < NREP(0); ++rep_) { if (rep_) __syncthreads(); PHASE_ENV(); p0_prologue(a, ldsp, vcu, G, tid, wave, lane); } SEAM(0);
    if (IN(1)) for (int rep_ = 0; rep_ < NREP(1); ++rep_) { if (rep_) __syncthreads(); PHASE_ENV(); RowArgs r{}; r.xin = a.in[0]; r.h = (bf16*)(ws + WS_H); r.mod = (const float*)(ws + WS_MOD); for (int ch = vcu; ch < NT / 64; ch += G) rp_a_chunk(r, ch, wave, lane); } SEAM(1);
    if (IN(2)) for (int rep_ = 0; rep_ < NREP(2); ++rep_) { if (rep_) __syncthreads(); PHASE_ENV(); pg8::DenseSched S; S.init(ws + WS_H, ws + WS_WIN, NT, 1024, 1024, G, bx);
        pg8::EpiG1 E{(bf16*)(ws + WS_CQ), (bf16*)(ws + WS_CKV), (bf16*)(ws + WS_KPE), (bf16*)(ws + WS_UF), (const float*)(ws + WS_ROPE)};
        pg8::gemm_phase<pg8::EpiG1, pg8::DenseSched, false, true>(ldsp, 2048, S, E); } SEAM(2);
    if (IN(3)) for (int rep_ = 0; rep_ < NREP(3); ++rep_) { if (rep_) __syncthreads(); PHASE_ENV(); for (int ch = vcu; ch < NT / 64; ch += G) p3_unit(a, ch, ldsp); } SEAM(3);
    if (IN(4)) for (int rep_ = 0; rep_ < NREP(4); ++rep_) { if (rep_) __syncthreads(); PHASE_ENV();
        const bool deal = (G == 256);
#ifndef P4_SKIP0
#define P4_SKIP0 0
#endif
        if (!((P4_SKIP0 & 1) && NREP(4) == 2 && rep_ == 0))
        for (int u = vcu; u < 256; u += G) { pg8::ListSched S{(const char*)(ws + WS_DMAT), (const char*)(ws + WS_UCS), 4096  , 8, u, 1, 1};
            pg8::EpiOutBf E{(bf16*)(ws + WS_OCAT), DM, 1, 1.f / 512.f}; pg8::gemm_phase<pg8::EpiOutBf, pg8::ListSched, false, true, true>(ldsp, 8192, S, E); }
        const int ufirst = deal ? 2 * vcu : vcu, ucount = deal ? 2 : (512 - vcu + G - 1) / G, ustep = deal ? 1 : G;
        const bf16* Qb = (const bf16*)(ws + WS_Q); const bf16* Kb = (const bf16*)(ws + WS_K); const bf16* Vb = (const bf16*)(ws + WS_V); bf16* OC = (bf16*)(ws + WS_OCAT);
        const float* bg_src0 = a.in[21]; const float* bg_src1 = a.in[23]; const float* bg_src2 = a.in[25]; unsigned char* bg_wup = (unsigned char*)(ws + WS_WUP); unsigned char* bg_wdn = (unsigned char*)(ws + WS_WDN);
        const int gw_ = __builtin_amdgcn_readfirstlane(vcu * NWAVES + (tid >> 6));
        int c_it = deal ? gw_ * 64 : 0; const int c_end = deal ? gw_ * 64 + 64 : 0;
        const bool bg_on = deal && !(NREP(4) == 2 && rep_ == 0);
        if (!((P4_SKIP0 & 2) && NREP(4) == 2 && rep_ == 0))
        for (int i = 0; i < ucount; ++i) { const int u = ufirst + i * ustep; if (u < 512) { const int bhh = u >> 4, qb = u & 15, b = bhh >> 3, h = bhh & 7;
            const bf16* q_ = Qb + ((size_t)bhh * NS + qb * 256) * QKD; const bf16* k_ = Kb + (size_t)bhh * NS * QKD; const bf16* v_ = Vb + (size_t)bhh * NS * VH; bf16* o_ = OC + ((size_t)(b * NS + qb * 256)) * DM + h * 64;
            if (bg_on) att::attn_unit<true>(q_, k_, v_, o_, DM, NS, (char*)lds_raw, bg_src0, bg_src1, bg_src2, bg_wup, bg_wdn, c_it, c_end);
            else att::attn_unit<false>(q_, k_, v_, o_, DM, NS, (char*)lds_raw, bg_src0, bg_src1, bg_src2, bg_wup, bg_wdn, c_it, c_end); } }
    } SEAM(4);
    if (IN(5)) for (int rep_ = 0; rep_ < NREP(5); ++rep_) { if (rep_) __syncthreads(); PHASE_ENV(); pg8::DenseSched S; S.init(ws + WS_OCAT, ws + WS_WOUT0, NT, 1024, 1024, G, bx); pg8::EpiOutBf E{(bf16*)(ws + WS_O), DM, 0, 1.f};
        pg8::gemm_phase<pg8::EpiOutBf, pg8::DenseSched, false, true>(ldsp, 2048, S, E); } SEAM(5);
    moe_block<0>(a, lds);

            SEAM(9);
            if (IN(10)) for (int rep_ = 0; rep_ < NREP(10); ++rep_) { if (rep_) __syncthreads(); PHASE_ENV(); pg8::DenseSched S; S.init(ws + WS_H, ws + WS_WCIN, NT, 3072, 1024, G, bx); pg8::EpiConv E{(bf16*)(ws + WS_PC), (bf16*)(ws + WS_PC + (size_t)NT * DM * 2)};
                pg8::gemm_phase<pg8::EpiConv, pg8::DenseSched, false, true>(ldsp, 2048, S, E); } SEAM(10);
            if (IN(11)) for (int rep_ = 0; rep_ < NREP(11); ++rep_) { if (rep_) __syncthreads(); PHASE_ENV(); conv_phase(a, ws, vcu, G, tid); } SEAM(11);
            if (IN(12)) for (int rep_ = 0; rep_ < NREP(12); ++rep_) { if (rep_) __syncthreads(); PHASE_ENV(); pg8::DenseSched S; S.init(ws + WS_YC, ws + WS_WCOUT, NT, 1024, 1024, G, bx); pg8::EpiOutBf E{(bf16*)(ws + WS_O), DM, 0, 1.f};
                pg8::gemm_phase<pg8::EpiOutBf, pg8::DenseSched, false, true>(ldsp, 2048, S, E); } SEAM(12);

    moe_block<1>(a, lds);
#undef IN
#undef SEAM
}
#if HYBRID
template <typename TA, bool BNT, typename Epi>
static void gemm(hipStream_t st, const TA* A, int lda, const void* B, int ldb, int M, int N, int K, const float* ascale, Epi epi) {
    dim3 g((N + 63) / 64, (M + 63) / 64);
    hipLaunchKernelGGL((n_gemm<TA, BNT, Epi>), g, dim3(256), 0, st, A, B, ascale, epi, lda, ldb, M, N, K, 0);
}
#endif

extern "C" void kernel_launch(void* const* d_in, const int* in_sizes, int n_in, void* d_out, int out_size, void* d_ws, size_t ws_size, hipStream_t stream) {
    static int inited = 0; static int grid = 0;
    if (!inited) {
        if (ws_size < WS_END2 || n_in != 27) { fprintf(stderr, "kernel_launch: workspace too small (%zu < %zu) or n_in %d != 27\n", ws_size, (size_t)WS_END2, n_in); inited = -1; return; }
#if HYBRID
        (void)hipFuncSetAttribute((const void*)k_rp_b, hipFuncAttributeMaxDynamicSharedMemorySize, RP_LDS_BYTES);
#endif
        if (hipFuncSetAttribute((const void*)mk_fwd, hipFuncAttributeMaxDynamicSharedMemorySize, LDS_BYTES) != hipSuccess) { fprintf(stderr, "kernel_launch: hipFuncSetAttribute(mk_fwd) failed\n"); inited = -1; return; }
        int dev = 0, cus = 0;
        if (hipGetDevice(&dev) != hipSuccess || hipDeviceGetAttribute(&cus, hipDeviceAttributeMultiprocessorCount, dev) != hipSuccess) { inited = -1; return; }
        int per_cu = 0;
        if (hipOccupancyMaxActiveBlocksPerMultiprocessor(&per_cu, (const void*)mk_fwd, 512, LDS_BYTES) != hipSuccess || per_cu < 1) { fprintf(stderr, "kernel_launch: occupancy query says %d blocks per CU\n", per_cu); }
        (void)hipGetLastError();
        grid = cus;
        inited = 1;
    }
    if (inited < 0) return;
    const float* x = (const float*)d_in[0]; const float* c = (const float*)d_in[1]; const int* positions = (const int*)d_in[2];
    const float* ada_w = (const float*)d_in[3]; const float* ada_b = (const float*)d_in[4];
    const float* ln_mix_g = (const float*)d_in[5]; const float* ln_mix_b = (const float*)d_in[6]; const float* ln_ffn_g = (const float*)d_in[7]; const float* ln_ffn_b = (const float*)d_in[8];
    const float* mla_w_in = (const float*)d_in[9]; const float* q_norm_g = (const float*)d_in[10]; const float* kv_norm_g = (const float*)d_in[11];
    const float* w_uq = (const float*)d_in[12]; const float* w_uk = (const float*)d_in[13]; const float* w_uv = (const float*)d_in[14]; const float* mix_a_w_out = (const float*)d_in[15];
    const float* conv_w_in = (const float*)d_in[16]; const float* conv_w = (const float*)d_in[17]; const float* conv_w_out = (const float*)d_in[18];
    const float* w_router = (const float*)d_in[19]; const float* b_router = (const float*)d_in[20];
    const float* w_glu = (const float*)d_in[21]; const float* b_glu = (const float*)d_in[22]; const float* w_lin = (const float*)d_in[23]; const float* b_lin = (const float*)d_in[24];
    const float* w_down = (const float*)d_in[25]; const float* b_down = (const float*)d_in[26];
    char* ws = (char*)d_ws;
    unsigned* ctl = (unsigned*)(ws + WS_CTL);
    float* MOD = (float*)(ws + WS_MOD); float* ROPE = (float*)(ws + WS_ROPE); float* RQ = (float*)(ws + WS_RQ); float* RKV = RQ + NT;
    int* TOPI = (int*)(ws + WS_TOPI); int* TPOS = (int*)(ws + WS_TPOS); float* GATE = (float*)(ws + WS_GATE); int* LIST = (int*)(ws + WS_LIST);
    bf16* H = (bf16*)(ws + WS_H); bf16* CQ = (bf16*)(ws + WS_CQ); bf16* CKV = (bf16*)(ws + WS_CKV); bf16* KPE = (bf16*)(ws + WS_KPE); bf16* UF = (bf16*)(ws + WS_UF);
    bf16* Qb = (bf16*)(ws + WS_Q); bf16* Kb = (bf16*)(ws + WS_K); bf16* Vb = (bf16*)(ws + WS_V); bf16* UCS = (bf16*)(ws + WS_UCS); bf16* DMAT = (bf16*)(ws + WS_DMAT);
    bf16* OCAT = (bf16*)(ws + WS_OCAT); float* O = (float*)(ws + WS_O); float* XA = (float*)(ws + WS_XA); float* XB = (float*)(ws + WS_XB);
    float* TMP = (float*)(ws + WS_TMP); bf16* PC = (bf16*)(ws + WS_PC); bf16* YC = (bf16*)(ws + WS_YC); bf16* AACT = (bf16*)(ws + WS_AACT); bf16* Yb = (bf16*)(ws + WS_Y);
    float* KR = TMP + (size_t)NT * 768;
    const float* MOD0 = MOD; const float* MOD1 = MOD + 4 * 6144;
    const size_t EW = (size_t)NE * DM * DM, EB = (size_t)NE * DM;

    (void)hipMemsetAsync(ws + WS_CTL, 0, CTL_BYTES, stream);
    FastArgs fa{};
    for (int i = 0; i < 27; ++i) fa.in[i] = (const float*)d_in[i];
    fa.out = (float*)d_out; fa.ws = (unsigned char*)d_ws;
    int region = 0;
    auto fast = [&](int lo, int hi) { fa.ph_lo = lo; fa.ph_hi = hi; fa.bar_region = region++; hipLaunchKernelGGL(mk_fwd, dim3(grid), dim3(512), LDS_BYTES, stream, fa); };
    constexpr bool F_GEMM = (MODE & 1) != 0, F_MOE = (MODE & 2) != 0, F_ATT = (MODE & 4) != 0, F_P3 = (MODE & 8) != 0, F_ONE = (MODE & 16) != 0;
    if (F_ONE) { fast(0, N_PHASES); return; }
#if HYBRID

    if (F_GEMM) fast(0, 3);
    else {
        hipLaunchKernelGGL(n_mod, dim3(6144 / 256, 2), dim3(256), 0, stream, c, ada_w, ada_b, MOD);
        hipLaunchKernelGGL(n_rope, dim3(NT * 16 / 256), dim3(256), 0, stream, positions, ROPE);
        hipLaunchKernelGGL(n_dmat, dim3(4096 * 8192 / 256), dim3(256), 0, stream, DMAT);
        { RowArgs a{}; a.xin = x; a.h = H; a.mod = MOD0; hipLaunchKernelGGL(k_rp_a, dim3(256), dim3(512), 0, stream, a); }
        gemm<bf16, false>(stream, H, DM, mla_w_in, PROJ_A, NT, PROJ_A, DM, nullptr, EpiP2{CQ, CKV, KR, UF});
        hipLaunchKernelGGL(n_kpe, dim3(NT * 16 / 256), dim3(256), 0, stream, KR, ROPE, KPE);
    }
    if (F_P3) fast(3, 4);
    else {
        hipLaunchKernelGGL(n_rms, dim3(NT / 256), dim3(256), 0, stream, CQ, CKV, RQ, RKV);
        gemm<bf16, false>(stream, CQ, 256, w_uq, 768, NT, 768, 256, q_norm_g, EpiQ{TMP, RQ});
        hipLaunchKernelGGL(n_qfin, dim3(NT * 768 / 256), dim3(256), 0, stream, TMP, ROPE, Qb);
        gemm<bf16, false>(stream, CKV, 128, w_uk, 512, NT, 512, 128, kv_norm_g, EpiKV{Kb, RKV, QKD});
        gemm<bf16, false>(stream, CKV, 128, w_uv, 512, NT, 512, 128, kv_norm_g, EpiKV{Vb, RKV, VH});
        hipLaunchKernelGGL(n_kcopy, dim3(NT * NH * 32 / 256), dim3(256), 0, stream, KPE, Kb);
        hipLaunchKernelGGL(n_fnet_ch, dim3(NS / 256, 512, NB), dim3(256), 0, stream, UF, UCS);
    }
    if (F_ATT) fast(4, 5);
    else {
        hipLaunchKernelGGL(n_attn, dim3(NS / 256, NH, NB), dim3(256), 0, stream, Qb, Kb, Vb, OCAT);
        gemm<bf16, true>(stream, DMAT, 8192, UCS, 8192, NS, NB * 512, 8192, nullptr, EpiFnet{OCAT});
    }
    if (F_GEMM) fast(5, 6);
    else gemm<bf16, false>(stream, OCAT, DM, mix_a_w_out, DM, NT, DM, DM, nullptr, EpiF32{O, DM});
    for (int L = 0; L < 2; ++L) {
        unsigned* cntL = ctl + CW_CNT + 32 * L;
        const int p0 = L == 0 ? 6 : 13;
        if (F_MOE) fast(p0, p0 + 4);
        else {
            { RowArgs a{}; a.xin = L == 0 ? x : XB; a.o = O; a.xout = XA; a.h = H; a.mod = L == 0 ? MOD0 : MOD1; a.gamma = ln_mix_g + L * DM; a.beta = ln_mix_b + L * DM;
              a.wr = w_router + (size_t)L * DM * NE; a.br = b_router + L * NE; a.topi = TOPI; a.tpos = TPOS; a.gate = GATE; a.list = LIST; a.cnt = cntL;
              hipLaunchKernelGGL(k_rp_b, dim3(256), dim3(512), RP_LDS_BYTES, stream, a); }
            hipLaunchKernelGGL(n_moe_up, dim3(16, NT / 64, NE), dim3(256), 0, stream, H, w_glu + L * EW, b_glu + L * EB, w_lin + L * EW, b_lin + L * EB, LIST, cntL, AACT);
            hipLaunchKernelGGL(n_moe_down, dim3(16, NT / 64, NE), dim3(256), 0, stream, AACT, w_down + L * EW, b_down + L * EB, cntL, Yb);
            { RowArgs a{}; a.xin = XA; a.xout = L == 0 ? XB : (float*)d_out; a.h = H; a.mod = L == 0 ? MOD0 : MOD1; a.mod_next = MOD1; a.gamma = ln_ffn_g + L * DM; a.beta = ln_ffn_b + L * DM;
              a.topi = TOPI; a.tpos = TPOS; a.gate = GATE; a.y = Yb; a.cntc = cntL; a.final_ = L;
              hipLaunchKernelGGL(k_rp_c, dim3(256), dim3(512), 0, stream, a); }
        }
        if (L == 0) {
            if (F_GEMM) fast(10, 13);
            else {
                gemm<bf16, false>(stream, H, DM, conv_w_in, 3072, NT, 3072, DM, nullptr, EpiBf{PC, 3072});
                hipLaunchKernelGGL(n_conv, dim3(NT * DM / 256), dim3(256), 0, stream, PC, conv_w, YC);
                gemm<bf16, false>(stream, YC, DM, conv_w_out, DM, NT, DM, DM, nullptr, EpiF32{O, DM});
            }
        }
    }
#endif
}
```
